# Optimizing an MI355X kernel written in HIP

```python
import math
import jax, jax.numpy as jnp
from jax import lax
import numpy as np

D_MODEL = 1024
BATCH = 4
SEQ = 4096
DEPTH = 2

CHUNK = 64
Q_BLOCK = 128
LRU_WIDTH = 256
LRU_BLOCKS = 4
LRU_BLOCK_W = LRU_WIDTH // LRU_BLOCKS
CONV_WIDTH = 4
RG_C = 8.0
DIFF_HEADS = 6
DIFF_HEAD_DIM = 32
DIFF_V_DIM = 2 * DIFF_HEAD_DIM
DIFF_QK_WIDTH = DIFF_HEADS * 2 * DIFF_HEAD_DIM
DIFF_WIDTH = DIFF_HEADS * DIFF_V_DIM
ALIBI_MAX_BIAS = 8.0
MLA_HEADS = 6
MLA_Q_RANK = 192
MLA_KV_RANK = 128
MLA_NOPE_DIM = 64
MLA_ROPE_DIM = 32
MLA_V_DIM = 64
MLA_QK_DIM = MLA_NOPE_DIM + MLA_ROPE_DIM
MLA_WIDTH = MLA_HEADS * MLA_V_DIM
ROPE_THETA = 10000.0
D_MIX = LRU_WIDTH + DIFF_WIDTH + MLA_WIDTH
IN_SIZES = (LRU_WIDTH, LRU_WIDTH, DIFF_QK_WIDTH, DIFF_QK_WIDTH, DIFF_WIDTH, MLA_Q_RANK, MLA_KV_RANK, MLA_ROPE_DIM)
D_IN = 2 * LRU_WIDTH + 2 * DIFF_QK_WIDTH + DIFF_WIDTH + MLA_Q_RANK + MLA_KV_RANK + MLA_ROPE_DIM
N_GROUPS = 4
EXPERTS_PER_GROUP = 8
N_EXPERTS = N_GROUPS * EXPERTS_PER_GROUP
TOP_K = 2
D_EXPERT = 256
ROW_BLOCK = 128
EPS = 1e-6

kernel_name = "hymba_lru_diffattn_mla_hmoe"


def rms_norm(x, g):
    xf = x.astype(jnp.float32)
    y = xf * lax.rsqrt(jnp.mean(xf * xf, axis=-1, keepdims=True) + EPS)
    return (y * g.astype(jnp.float32)).astype(x.dtype)


def rotary_tables(seq):
    half = MLA_ROPE_DIM // 2
    inv_freq = ROPE_THETA ** (-jnp.arange(half, dtype=jnp.float32) / half)
    ang = jnp.arange(seq, dtype=jnp.float32)[:, None] * inv_freq[None, :]
    return jnp.cos(ang), jnp.sin(ang)


def apply_rotary(x, cos, sin):
    half = x.shape[-1] // 2
    x1 = x[..., :half].astype(jnp.float32)
    x2 = x[..., half:].astype(jnp.float32)
    c = cos[None, :, None, :]
    s = sin[None, :, None, :]
    return jnp.concatenate([x1 * c - x2 * s, x1 * s + x2 * c], axis=-1).astype(x.dtype)


def chunk_allowed(q0, q1, kv_end):
    qpos = jnp.arange(q0, q1)
    kpos = jnp.arange(kv_end)
    return (kpos[None, :] // CHUNK) <= (qpos[:, None] // CHUNK)


def sweep_query_blocks(block_fn, seq):
    outs = []
    for q0 in range(0, seq, Q_BLOCK):
        q1 = q0 + Q_BLOCK
        kv_end = min(seq, -(-q1 // CHUNK) * CHUNK)
        outs.append(block_fn(q0, q1, kv_end))
    return jnp.concatenate(outs, axis=1)


def alibi_slopes(n_heads):
    return jnp.asarray([2.0 ** (-ALIBI_MAX_BIAS * (h + 1) / n_heads) for h in range(n_heads)], dtype=jnp.float32)


def rg_lru_mixer(u, gate, conv_w, conv_b, wa, ba, wx, bx, lam, out_g):
    B, S, W = u.shape
    xc = lax.conv_general_dilated(u, conv_w[:, None, :], window_strides=(1,), padding=[(CONV_WIDTH - 1, 0)],
                                  dimension_numbers=('NWC', 'WIO', 'NWC'), feature_group_count=W) + conv_b
    xb = xc.reshape(B, S, LRU_BLOCKS, LRU_BLOCK_W)
    r = jax.nn.sigmoid((jnp.einsum('bsni,nij->bsnj', xb, wa).reshape(B, S, W) + ba).astype(jnp.float32))
    i = jax.nn.sigmoid((jnp.einsum('bsni,nij->bsnj', xb, wx).reshape(B, S, W) + bx).astype(jnp.float32))
    log_a = -RG_C * r * jax.nn.softplus(-lam.astype(jnp.float32))
    a = jnp.exp(log_a)
    b = jnp.sqrt(-jnp.expm1(2.0 * log_a)) * i * xc.astype(jnp.float32)

    def combine(left, right):
        a1, b1 = left
        a2, b2 = right
        return a1 * a2, a2 * b1 + b2

    _, h = lax.associative_scan(combine, (a, b), axis=1)
    y = h * jax.nn.gelu(gate.astype(jnp.float32))
    return rms_norm(y.astype(u.dtype), out_g)


def diff_attention_mixer(q, k, v, q_g, k_g, lq1, lk1, lq2, lk2, sub_g, lambda_init):
    B, S, _ = q.shape
    q = rms_norm(q.reshape(B, S, DIFF_HEADS, 2, DIFF_HEAD_DIM), q_g)
    k = rms_norm(k.reshape(B, S, DIFF_HEADS, 2, DIFF_HEAD_DIM), k_g)
    v = v.reshape(B, S, DIFF_HEADS, DIFF_V_DIM)
    f32 = jnp.float32
    lam = (jnp.exp(jnp.sum(lq1.astype(f32) * lk1.astype(f32)))
           - jnp.exp(jnp.sum(lq2.astype(f32) * lk2.astype(f32))) + lambda_init)
    slopes = alibi_slopes(DIFF_HEADS)
    scale = DIFF_HEAD_DIM ** -0.5

    def block(q0, q1, kv_end):
        allowed = chunk_allowed(q0, q1, kv_end)
        dist = jnp.abs(jnp.arange(q0, q1)[:, None] - jnp.arange(kv_end)[None, :]).astype(f32)
        bias = jnp.where(allowed[None], -slopes[:, None, None] * dist[None], -jnp.inf)
        s = jnp.einsum('bqhmd,bkhmd->bmhqk', q[:, q0:q1], k[:, :kv_end]).astype(f32) * scale + bias
        p = jax.nn.softmax(s, axis=-1)
        p_diff = p[:, 0] - lam * p[:, 1]
        return jnp.einsum('bhqk,bkhd->bqhd', p_diff.astype(v.dtype), v[:, :kv_end])

    o = sweep_query_blocks(block, S)
    o = rms_norm(o, sub_g) * (1.0 - lambda_init)
    return o.reshape(B, S, DIFF_WIDTH)


def mla_mixer(c_q, c_kv, k_rope, cq_g, ckv_g, w_uq, w_ukv, q_g, k_g, out_g, cos, sin):
    B, S, _ = c_q.shape
    q = (rms_norm(c_q, cq_g) @ w_uq).reshape(B, S, MLA_HEADS, MLA_QK_DIM)
    kv = (rms_norm(c_kv, ckv_g) @ w_ukv).reshape(B, S, MLA_HEADS, MLA_NOPE_DIM + MLA_V_DIM)
    k_nope, v = kv[..., :MLA_NOPE_DIM], kv[..., MLA_NOPE_DIM:]
    k_r = jnp.broadcast_to(k_rope[:, :, None, :], (B, S, MLA_HEADS, MLA_ROPE_DIM))
    k = jnp.concatenate([k_nope, k_r], axis=-1)
    q = rms_norm(q, q_g)
    k = rms_norm(k, k_g)
    q = jnp.concatenate([q[..., :MLA_NOPE_DIM], apply_rotary(q[..., MLA_NOPE_DIM:], cos, sin)], axis=-1)
    k = jnp.concatenate([k[..., :MLA_NOPE_DIM], apply_rotary(k[..., MLA_NOPE_DIM:], cos, sin)], axis=-1)
    scale = MLA_QK_DIM ** -0.5

    def block(q0, q1, kv_end):
        allowed = chunk_allowed(q0, q1, kv_end)
        s = jnp.einsum('bqhd,bkhd->bhqk', q[:, q0:q1], k[:, :kv_end]).astype(jnp.float32) * scale
        p = jax.nn.softmax(jnp.where(allowed, s, -jnp.inf), axis=-1)
        return jnp.einsum('bhqk,bkhd->bqhd', p.astype(v.dtype), v[:, :kv_end])

    o = sweep_query_blocks(block, S)
    return rms_norm(o.reshape(B, S, MLA_WIDTH), out_g)


def hierarchical_moe(h, wg, bg, we, be, w1, w3, w2):
    B, S, D = h.shape
    N = B * S
    f32 = jnp.float32
    hf = h.reshape(N, D)
    g_logits = (hf @ wg).astype(f32) + bg.astype(f32)
    pg = jax.nn.softmax(g_logits, axis=-1)
    g_idx = jnp.argmax(g_logits, axis=-1)
    pg_top = jnp.take_along_axis(pg, g_idx[:, None], axis=-1)
    e_logits = ((hf @ we).astype(f32) + be.astype(f32)).reshape(N, N_GROUPS, EXPERTS_PER_GROUP)
    e_in = jnp.take_along_axis(e_logits, g_idx[:, None, None], axis=1)[:, 0]
    top_p, top_i = lax.top_k(jax.nn.softmax(e_in, axis=-1), TOP_K)
    gate = pg_top * top_p / jnp.sum(top_p, axis=-1, keepdims=True)
    expert_id = g_idx[:, None] * EXPERTS_PER_GROUP + top_i

    NK = N * TOP_K
    flat_e = expert_id.reshape(NK).astype(jnp.int32)
    flat_t = jnp.repeat(jnp.arange(N, dtype=jnp.int32), TOP_K)
    flat_w = gate.reshape(NK)
    order = jnp.argsort(flat_e)
    se, st, sw = flat_e[order], flat_t[order], flat_w[order]
    counts = jnp.bincount(flat_e, length=N_EXPERTS)
    starts = jnp.cumsum(counts) - counts
    padded = (counts + ROW_BLOCK - 1) // ROW_BLOCK * ROW_BLOCK
    pad_ends = jnp.cumsum(padded)
    pad_starts = pad_ends - padded
    dest = pad_starts[se] + (jnp.arange(NK, dtype=jnp.int32) - starts[se])
    n_rows = (-(-NK // ROW_BLOCK) + N_EXPERTS) * ROW_BLOCK
    n_blk = n_rows // ROW_BLOCK
    row_tok = jnp.full((n_rows,), N, jnp.int32).at[dest].set(st)
    row_w = jnp.zeros((n_rows,), hf.dtype).at[dest].set(sw.astype(hf.dtype))
    blk_expert = jnp.minimum(jnp.searchsorted(pad_ends, jnp.arange(n_blk, dtype=jnp.int32) * ROW_BLOCK, side='right'),
                             N_EXPERTS - 1)
    x_pad = jnp.concatenate([hf, jnp.zeros((1, D), hf.dtype)], axis=0)
    x_rows = x_pad[row_tok].reshape(n_blk, ROW_BLOCK, D)

    def expert_block(args):
        xb, e = args
        return (jax.nn.silu(xb @ w1[e]) * (xb @ w3[e])) @ w2[e]

    y_rows = lax.map(expert_block, (x_rows, blk_expert)).reshape(n_rows, D)
    y = jax.ops.segment_sum(y_rows * row_w[:, None], row_tok, num_segments=N + 1)[:N]
    return y.reshape(B, S, D)


def setup_inputs(seed: int = 0) -> dict:
    key = jax.random.key(seed)
    ks = jax.random.split(key, 40)
    counter = [0]
    f32 = jnp.float32
    L = DEPTH

    def nxt():
        k = ks[counter[0]]
        counter[0] += 1
        return k

    def normal(shape, scale):
        return jax.random.normal(nxt(), shape, f32) * scale

    def gain(width):
        return 1.0 + normal((L, width), 0.02)

    x = normal((BATCH, SEQ, D_MODEL), 1.0)
    norm1_g = gain(D_MODEL)
    w_in = normal((L, D_MODEL, D_IN), D_MODEL ** -0.5)
    lru_conv_w = normal((L, CONV_WIDTH, LRU_WIDTH), CONV_WIDTH ** -0.5)
    lru_conv_b = normal((L, LRU_WIDTH), 0.01)
    lru_wa = normal((L, LRU_BLOCKS, LRU_BLOCK_W, LRU_BLOCK_W), LRU_BLOCK_W ** -0.5)
    lru_ba = normal((L, LRU_WIDTH), 0.01)
    lru_wx = normal((L, LRU_BLOCKS, LRU_BLOCK_W, LRU_BLOCK_W), LRU_BLOCK_W ** -0.5)
    lru_bx = normal((L, LRU_WIDTH), 0.01)
    u = jax.random.uniform(nxt(), (L, LRU_WIDTH), f32, minval=0.9, maxval=0.999)
    s = u ** (1.0 / RG_C)
    lru_lambda = jnp.log(s) - jnp.log1p(-s)
    lru_out_g = gain(LRU_WIDTH)
    diff_q_g = gain(DIFF_HEAD_DIM)
    diff_k_g = gain(DIFF_HEAD_DIM)
    diff_lq1 = normal((L, DIFF_HEAD_DIM), 0.1)
    diff_lk1 = normal((L, DIFF_HEAD_DIM), 0.1)
    diff_lq2 = normal((L, DIFF_HEAD_DIM), 0.1)
    diff_lk2 = normal((L, DIFF_HEAD_DIM), 0.1)
    diff_sub_g = gain(DIFF_V_DIM)
    mla_cq_g = gain(MLA_Q_RANK)
    mla_ckv_g = gain(MLA_KV_RANK)
    mla_w_uq = normal((L, MLA_Q_RANK, MLA_HEADS * MLA_QK_DIM), MLA_Q_RANK ** -0.5)
    mla_w_ukv = normal((L, MLA_KV_RANK, MLA_HEADS * (MLA_NOPE_DIM + MLA_V_DIM)), MLA_KV_RANK ** -0.5)
    mla_q_g = gain(MLA_QK_DIM)
    mla_k_g = gain(MLA_QK_DIM)
    mla_out_g = gain(MLA_WIDTH)
    w_out = normal((L, D_MIX, D_MODEL), D_MIX ** -0.5)
    norm2_g = gain(D_MODEL)
    router_g_w = normal((L, D_MODEL, N_GROUPS), D_MODEL ** -0.5)
    router_g_b = normal((L, N_GROUPS), 0.01)
    router_e_w = normal((L, D_MODEL, N_EXPERTS), D_MODEL ** -0.5)
    router_e_b = normal((L, N_EXPERTS), 0.01)
    exp_w1 = normal((L, N_EXPERTS, D_MODEL, D_EXPERT), D_MODEL ** -0.5)
    exp_w3 = normal((L, N_EXPERTS, D_MODEL, D_EXPERT), D_MODEL ** -0.5)
    exp_w2 = normal((L, N_EXPERTS, D_EXPERT, D_MODEL), D_EXPERT ** -0.5)
    return {"x": x, "norm1_g": norm1_g, "w_in": w_in, "lru_conv_w": lru_conv_w, "lru_conv_b": lru_conv_b,
            "lru_wa": lru_wa, "lru_ba": lru_ba, "lru_wx": lru_wx, "lru_bx": lru_bx, "lru_lambda": lru_lambda,
            "lru_out_g": lru_out_g, "diff_q_g": diff_q_g, "diff_k_g": diff_k_g, "diff_lq1": diff_lq1,
            "diff_lk1": diff_lk1, "diff_lq2": diff_lq2, "diff_lk2": diff_lk2, "diff_sub_g": diff_sub_g,
            "mla_cq_g": mla_cq_g, "mla_ckv_g": mla_ckv_g, "mla_w_uq": mla_w_uq, "mla_w_ukv": mla_w_ukv,
            "mla_q_g": mla_q_g, "mla_k_g": mla_k_g, "mla_out_g": mla_out_g, "w_out": w_out, "norm2_g": norm2_g,
            "router_g_w": router_g_w, "router_g_b": router_g_b, "router_e_w": router_e_w, "router_e_b": router_e_b,
            "exp_w1": exp_w1, "exp_w3": exp_w3, "exp_w2": exp_w2}


def reference(x, norm1_g, w_in, lru_conv_w, lru_conv_b, lru_wa, lru_ba, lru_wx, lru_bx, lru_lambda, lru_out_g,
              diff_q_g, diff_k_g, diff_lq1, diff_lk1, diff_lq2, diff_lk2, diff_sub_g,
              mla_cq_g, mla_ckv_g, mla_w_uq, mla_w_ukv, mla_q_g, mla_k_g, mla_out_g, w_out, norm2_g,
              router_g_w, router_g_b, router_e_w, router_e_b, exp_w1, exp_w3, exp_w2):
    B, S, _ = x.shape
    cos, sin = rotary_tables(S)
    split_at = [int(v) for v in np.cumsum(IN_SIZES)[:-1]]
    for l in range(DEPTH):
        hn = rms_norm(x, norm1_g[l])
        proj = hn @ w_in[l]
        lru_x, lru_gate, dq, dk, dv, c_q, c_kv, k_rope = jnp.split(proj, split_at, axis=-1)
        y_lru = rg_lru_mixer(lru_x, lru_gate, lru_conv_w[l], lru_conv_b[l], lru_wa[l], lru_ba[l],
                             lru_wx[l], lru_bx[l], lru_lambda[l], lru_out_g[l])
        lambda_init = 0.8 - 0.6 * math.exp(-0.3 * l)
        y_diff = diff_attention_mixer(dq, dk, dv, diff_q_g[l], diff_k_g[l], diff_lq1[l], diff_lk1[l],
                                      diff_lq2[l], diff_lk2[l], diff_sub_g[l], lambda_init)
        y_mla = mla_mixer(c_q, c_kv, k_rope, mla_cq_g[l], mla_ckv_g[l], mla_w_uq[l], mla_w_ukv[l],
                          mla_q_g[l], mla_k_g[l], mla_out_g[l], cos, sin)
        x = x + jnp.concatenate([y_lru, y_diff, y_mla], axis=-1) @ w_out[l]
        x = x + hierarchical_moe(rms_norm(x, norm2_g[l]), router_g_w[l], router_g_b[l], router_e_w[l],
                                 router_e_b[l], exp_w1[l], exp_w3[l], exp_w2[l])
    return x
```

```cpp
#include <hip/hip_runtime.h>
#include <cstdio>
#include <cstdint>

#define DI __device__ __forceinline__
typedef unsigned short bf;

constexpr int NB = 4, S = 4096, D = 1024, NT = NB * S, NPROJ = 2048;
constexpr float EPS = 1e-6f;
enum { I_X = 0, I_N1G, I_WIN, I_CONVW, I_CONVB, I_WA, I_BA, I_WX, I_BX, I_LAM, I_LOUTG, I_DQG, I_DKG, I_LQ1, I_LK1, I_LQ2, I_LK2,
       I_SUBG, I_CQG, I_CKVG, I_WUQ, I_WUKV, I_MQG, I_MKG, I_MOUTG, I_WOUT, I_N2G, I_RGW, I_RGB, I_REW, I_REB, I_W1, I_W3, I_W2, N_IN };

struct Params { const float* in[N_IN]; float* out; unsigned char* ws; };

constexpr size_t AL(size_t x) { return (x + 255) & ~(size_t)255; }
constexpr size_t OFF_WIN = 0;
constexpr size_t OFF_WOUT = OFF_WIN + (size_t)2 * 2048 * 1024 * 2;
constexpr size_t OFF_WUQ = OFF_WOUT + (size_t)2 * 1024 * 1024 * 2;
constexpr size_t OFF_WUKV = OFF_WUQ + (size_t)2 * 576 * 192 * 2;
constexpr size_t OFF_WAX = OFF_WUKV + (size_t)2 * 768 * 128 * 2;
constexpr size_t OFF_WR = OFF_WAX + (size_t)2 * 2 * 4 * 64 * 64 * 2;
constexpr size_t OFF_ROPE = AL(OFF_WR + (size_t)2 * 36 * 1024 * 4);
constexpr size_t OFF_CTL = OFF_ROPE + (size_t)4096 * 32 * 4;
constexpr size_t OFF_RINV1 = OFF_CTL + 65536;
constexpr size_t OFF_RINV2 = OFF_RINV1 + (size_t)NT * 4;
constexpr size_t OFF_SSQM = OFF_RINV2 + (size_t)NT * 4;
constexpr size_t OFF_TOT = OFF_SSQM + (size_t)NT * 8 * 4;
constexpr size_t OFF_GATEW = OFF_TOT + (size_t)4 * 64 * 2 * 256 * 4;
constexpr size_t OFF_LIST = OFF_GATEW + (size_t)NT * 2 * 4;
constexpr size_t OFF_XFA = OFF_LIST + (size_t)32 * 16384 * 4;
constexpr size_t OFF_XB = OFF_XFA + (size_t)NT * D * 4;
constexpr size_t OFF_MIX = OFF_XB + (size_t)NT * D * 2;
constexpr size_t OFF_STAGE = OFF_MIX + (size_t)NT * D * 2;
constexpr size_t OFF_LX = OFF_STAGE;
constexpr size_t OFF_GG = OFF_LX + (size_t)NT * 256 * 2;
constexpr size_t OFF_DQ = OFF_GG + (size_t)NT * 256 * 2;
constexpr size_t OFF_DK = OFF_DQ + (size_t)NT * 384 * 2;
constexpr size_t OFF_DVT = OFF_DK + (size_t)NT * 384 * 2;
constexpr size_t OFF_CQ = OFF_DVT + (size_t)NT * 384 * 2;
constexpr size_t OFF_CKV = OFF_CQ + (size_t)NT * 192 * 2;
constexpr size_t OFF_KR = OFF_CKV + (size_t)NT * 128 * 2;
constexpr size_t OFF_MQ = OFF_KR + (size_t)NT * 32 * 2;
constexpr size_t OFF_MK = OFF_MQ + (size_t)NT * 576 * 2;
constexpr size_t OFF_MVT = OFF_MK + (size_t)NT * 576 * 2;
constexpr size_t OFF_STAGE_END = OFF_MVT + (size_t)NT * 384 * 2;
constexpr size_t OFF_Y = OFF_STAGE;
constexpr size_t OFF_ACT = OFF_Y + (size_t)2 * NT * D * 2;
constexpr size_t OFF_H13 = OFF_Y;
constexpr size_t WS_TOTAL = OFF_STAGE_END;
static_assert(OFF_ACT + (size_t)(32768 + 128) * 256 * 2 <= OFF_STAGE_END, "alias");
constexpr int CTL_CNT = 0;

#define WSP(T, off) ((T*)(p.ws + (off)))

DI float bf2f(bf v) { return __uint_as_float(((unsigned)v) << 16); }
DI bf f2bf(float f) { unsigned u = __float_as_uint(f); u += 0x7fffu + ((u >> 16) & 1u); return (bf)(u >> 16); }
DI unsigned pack2(float a, float b) { return (unsigned)f2bf(a) | ((unsigned)f2bf(b) << 16); }
DI float lo16(unsigned u) { return __uint_as_float(u << 16); }
DI float hi16(unsigned u) { return __uint_as_float(u & 0xffff0000u); }
DI float wave_sum(float v) { for (int o = 32; o > 0; o >>= 1) v += __shfl_xor(v, o); return v; }
DI float wave_max(float v) { for (int o = 32; o > 0; o >>= 1) v = fmaxf(v, __shfl_xor(v, o)); return v; }
DI float gelu_tanh(float x) { return 0.5f * x * (1.f + tanhf(0.7978845608028654f * (x + 0.044715f * x * x * x))); }
DI float sigmoidf_(float x) { return 1.f / (1.f + __expf(-x)); }
DI float lambda_init(int l) { return l == 0 ? 0.2f : 0.35550906757f; }
DI void store8(bf* dst, const float* v) { uint4 u; u.x = pack2(v[0], v[1]); u.y = pack2(v[2], v[3]); u.z = pack2(v[4], v[5]); u.w = pack2(v[6], v[7]); *(uint4*)dst = u; }

template <class SCOL, class GAIN>
DI void tr_tile(const float* src, int lds_, bf* dst, int K, int n0, int k0, SCOL scol, GAIN gain, float* tile) {
    const int tid = threadIdx.x;
    const int nn = tid & 63;
    const int sc = scol(n0 + nn);
#pragma unroll
    for (int i = 0; i < 16; ++i) {
        const int kk = (tid >> 6) + 4 * i;
        float v = 0.f;
        if (sc >= 0) v = src[(size_t)(k0 + kk) * lds_ + sc] * gain(k0 + kk);
        tile[kk * 65 + nn] = v;
    }
    __syncthreads();
#pragma unroll
    for (int i = 0; i < 2; ++i) {
        const int id = tid + 256 * i, n = id >> 3, kc = (id & 7) * 8;
        float v[8];
#pragma unroll
        for (int j = 0; j < 8; ++j) v[j] = tile[(kc + j) * 65 + n];
        store8(dst + (size_t)(n0 + n) * K + k0 + kc, v);
    }
    __syncthreads();
}

DI int win_col(int n) {
    if (n < 1856) return n;
    if (n < 1888) return 1984 + (n - 1856);
    if (n < 1920) return -1;
    return 1856 + (n - 1920);
}

constexpr int PW_WIN = 2 * 32 * 16;
constexpr int PW_WOUT = 2 * 16 * 16;
constexpr int PW_WUQ = 2 * 9 * 3;
constexpr int PW_WUKV = 2 * 12 * 2;
constexpr int PW_WAX = 2 * 2 * 4;
constexpr int PW_TOTAL = PW_WIN + PW_WOUT + PW_WUQ + PW_WUKV + PW_WAX;

DI void prep_weights_unit(const Params& p, int u, float* tile) {
    if (u < PW_WIN) {
        const int l = u / 512, r = u % 512, nt = r / 16, kt = r % 16;
        const float* g = p.in[I_N1G] + l * 1024;
        tr_tile(p.in[I_WIN] + (size_t)l * 1024 * 2016, 2016, WSP(bf, OFF_WIN) + (size_t)l * 2048 * 1024, 1024, nt * 64, kt * 64,
                [](int n) { return win_col(n); }, [g](int k) { return g[k]; }, tile);
        return;
    }
    u -= PW_WIN;
    if (u < PW_WOUT) {
        const int l = u / 256, r = u % 256, nt = r / 16, kt = r % 16;
        const float* g_lru = p.in[I_LOUTG] + l * 256; const float* g_sub = p.in[I_SUBG] + l * 64; const float* g_mla = p.in[I_MOUTG] + l * 384;
        const float li = 1.f - lambda_init(l);
        tr_tile(p.in[I_WOUT] + (size_t)l * 1024 * 1024, 1024, WSP(bf, OFF_WOUT) + (size_t)l * 1024 * 1024, 1024, nt * 64, kt * 64,
                [](int n) { return n; },
                [=](int k) { return k < 256 ? g_lru[k] : (k < 640 ? g_sub[(k - 256) & 63] * li : g_mla[k - 640]); }, tile);
        return;
    }
    u -= PW_WOUT;
    if (u < PW_WUQ) {
        const int l = u / 27, r = u % 27, nt = r / 3, kt = r % 3;
        const float* g = p.in[I_CQG] + l * 192;
        tr_tile(p.in[I_WUQ] + (size_t)l * 192 * 576, 576, WSP(bf, OFF_WUQ) + (size_t)l * 576 * 192, 192, nt * 64, kt * 64,
                [](int n) { return n; }, [g](int k) { return g[k]; }, tile);
        return;
    }
    u -= PW_WUQ;
    if (u < PW_WUKV) {
        const int l = u / 24, r = u % 24, nt = r / 2, kt = r % 2;
        const float* g = p.in[I_CKVG] + l * 128;
        tr_tile(p.in[I_WUKV] + (size_t)l * 128 * 768, 768, WSP(bf, OFF_WUKV) + (size_t)l * 768 * 128, 128, nt * 64, kt * 64,
                [](int n) { return n; }, [g](int k) { return g[k]; }, tile);
        return;
    }
    u -= PW_WUKV;
    {
        const int l = u / 8, which = (u / 4) & 1, blk = u & 3;
        const float* src = p.in[which ? I_WX : I_WA] + (size_t)(l * 4 + blk) * 4096;
        tr_tile(src, 64, WSP(bf, OFF_WAX) + (size_t)((l * 2 + which) * 4 + blk) * 4096, 64, 0, 0,
                [](int n) { return n; }, [](int) { return 1.f; }, tile);
    }
}

__global__ void __launch_bounds__(256) k_prep_weights(Params p) {
    __shared__ float tile[64 * 65];
    for (int u = blockIdx.x; u < PW_TOTAL; u += gridDim.x) prep_weights_unit(p, u, tile);
}

__global__ void __launch_bounds__(256) k_prep_misc(Params p) {
    const int gid = blockIdx.x * 256 + threadIdx.x, gsz = gridDim.x * 256;
    float* wr = WSP(float, OFF_WR);
    for (int i = gid; i < 2 * 36 * 1024; i += gsz) {
        const int l = i / (36 * 1024), r = i % (36 * 1024), j = r / 1024, k = r % 1024;
        const float g = p.in[I_N2G][l * 1024 + k];
        const float w = j < 4 ? p.in[I_RGW][(size_t)(l * 1024 + k) * 4 + j] : p.in[I_REW][(size_t)(l * 1024 + k) * 32 + (j - 4)];
        wr[i] = w * g;
    }
    float* rope = WSP(float, OFF_ROPE);
    for (int i = gid; i < 4096 * 16; i += gsz) {
        const int s = i >> 4, f = i & 15;
        const float inv_freq = (float)exp2(-(double)f / 16.0 * 13.287712379549449);
        const float angf = (float)s * inv_freq;
        double a = (double)angf;
        const double twopi = 6.283185307179586476925;
        a -= twopi * rint(a / twopi);
        const double hh = 0.5 * a, h2 = hh * hh;
        double sn = 1.0, cs = 1.0, ts = 1.0, tc = 1.0;
#pragma unroll
        for (int n = 1; n <= 10; ++n) {
            tc *= -h2 / (double)((2 * n - 1) * (2 * n));
            ts *= -h2 / (double)((2 * n) * (2 * n + 1));
            cs += tc; sn += ts;
        }
        sn *= hh;
        rope[s * 32 + f] = (float)(cs * cs - sn * sn);
        rope[s * 32 + 16 + f] = (float)(2.0 * sn * cs);
    }
    if (gid < 32) WSP(int, OFF_CTL)[CTL_CNT + gid] = 0;
}

__global__ void __launch_bounds__(256) k_prep_x(Params p) {
    const int lane = threadIdx.x & 63, gw = blockIdx.x * 4 + (threadIdx.x >> 6), nw = gridDim.x * 4;
    const float* x = p.in[I_X];
    bf* xb = WSP(bf, OFF_XB);
    float* rinv = WSP(float, OFF_RINV1);
    for (int t = gw; t < NT; t += nw) {
        float ss = 0.f;
#pragma unroll
        for (int i = 0; i < 2; ++i) {
            const int c = (lane + 64 * i) * 8;
            const float4 a = *(const float4*)(x + (size_t)t * D + c), b = *(const float4*)(x + (size_t)t * D + c + 4);
            float v[8] = {a.x, a.y, a.z, a.w, b.x, b.y, b.z, b.w};
#pragma unroll
            for (int j = 0; j < 8; ++j) ss += v[j] * v[j];
            store8(xb + (size_t)t * D + c, v);
        }
        ss = wave_sum(ss);
        if (lane == 0) rinv[t] = rsqrtf(ss * (1.f / 1024.f) + EPS);
    }
}

template <bool BT, class LA, class LB, class EPI>
DI void ngemm_tile(int K, LA la, LB lb, EPI epi, float* sA, float* sB) {
    const int tid = threadIdx.x, ty = tid >> 4, tx = tid & 15;
    float acc[4][4];
#pragma unroll
    for (int i = 0; i < 4; ++i)
#pragma unroll
        for (int j = 0; j < 4; ++j) acc[i][j] = 0.f;
    for (int k0 = 0; k0 < K; k0 += 16) {
#pragma unroll
        for (int i = 0; i < 4; ++i) {
            const int e = tid + 256 * i;
            sA[(e & 15) * 68 + (e >> 4)] = la(e >> 4, k0 + (e & 15));
            if (BT) sB[(e & 15) * 68 + (e >> 4)] = lb(k0 + (e & 15), e >> 4);
            else sB[(e >> 6) * 68 + (e & 63)] = lb(k0 + (e >> 6), e & 63);
        }
        __syncthreads();
#pragma unroll
        for (int kk = 0; kk < 16; ++kk) {
            const float4 a = *(const float4*)(sA + kk * 68 + ty * 4), b = *(const float4*)(sB + kk * 68 + tx * 4);
            const float av[4] = {a.x, a.y, a.z, a.w}, bv[4] = {b.x, b.y, b.z, b.w};
#pragma unroll
            for (int i = 0; i < 4; ++i)
#pragma unroll
                for (int j = 0; j < 4; ++j) acc[i][j] += av[i] * bv[j];
        }
        __syncthreads();
    }
#pragma unroll
    for (int i = 0; i < 4; ++i)
#pragma unroll
        for (int j = 0; j < 4; ++j) epi(ty * 4 + i, tx * 4 + j, acc[i][j]);
}

__global__ void __launch_bounds__(256) k_p1_gemm_naive(Params p, int l, int chunk) {
    __shared__ float sA[16 * 68], sB[16 * 68];
    const int mt = blockIdx.x / 8, nt = blockIdx.x % 8;
    const bf* A = WSP(bf, OFF_XB) + (size_t)mt * 64 * D;
    const bf* Bt = WSP(bf, OFF_WIN) + (size_t)l * 2048 * 1024 + (size_t)(chunk * 512 + nt * 64) * 1024;
    const float* rinv = WSP(float, OFF_RINV1) + mt * 64;
    float* C = WSP(float, OFF_MIX) + (size_t)mt * 64 * 512 + nt * 64;
    ngemm_tile<true>(1024, [=](int r, int k) { return bf2f(A[(size_t)r * D + k]); }, [=](int k, int c) { return bf2f(Bt[(size_t)c * 1024 + k]); },
               [=](int r, int c, float v) { C[(size_t)r * 512 + c] = v * rinv[r]; }, sA, sB);
}

template <class ACC>
DI void route_tile(const Params& p, int l, int mt, int nt, ACC T) {
    const int tid = threadIdx.x;
    const int t0 = mt * 128, b = t0 >> 12, s0 = t0 & 4095;
    if (nt < 4) {
        bf* dst = WSP(bf, nt < 2 ? OFF_LX : OFF_GG);
        const int cb = (nt & 1) * 128;
#pragma unroll 1
        for (int it = 0; it < 8; ++it) {
            const int id = it * 256 + tid, r = id >> 4, c8 = (id & 15) * 8;
            float v[8];
#pragma unroll
            for (int j = 0; j < 8; ++j) { v[j] = T(r, c8 + j); if (nt >= 2) v[j] = gelu_tanh(v[j]); }
            store8(dst + (size_t)(t0 + r) * 256 + cb + c8, v);
        }
    } else if (nt < 10) {
        const bool isk = nt >= 7;
        const int g0 = (nt - (isk ? 7 : 4)) * 128;
        const float* gain = p.in[isk ? I_DKG : I_DQG] + l * 32;
        bf* dst = WSP(bf, isk ? OFF_DK : OFF_DQ);
#pragma unroll 1
        for (int it = 0; it < 8; ++it) {
            const int id = it * 256 + tid, r = id >> 4, c8 = (id & 15) * 8;
            float v[8], ss = 0.f;
#pragma unroll
            for (int j = 0; j < 8; ++j) { v[j] = T(r, c8 + j); ss += v[j] * v[j]; }
            ss += __shfl_xor(ss, 1); ss += __shfl_xor(ss, 2);
            const float rn = rsqrtf(ss * (1.f / 32.f) + EPS);
            const int col = g0 + c8, h = col >> 6, m = (col >> 5) & 1, d0 = col & 31;
#pragma unroll
            for (int j = 0; j < 8; ++j) v[j] = v[j] * rn * gain[d0 + j];
            store8(dst + ((size_t)((b * 6 + h) * 2 + m) * S + s0 + r) * 32 + d0, v);
        }
    } else if (nt < 13) {
        const int g0 = (nt - 10) * 128;
        bf* dst = WSP(bf, OFF_DVT);
#pragma unroll 1
        for (int it = 0; it < 8; ++it) {
            const int id = it * 256 + tid, c = id & 127, rc = id >> 7;
            float v[8];
#pragma unroll
            for (int j = 0; j < 8; ++j) v[j] = T(8 * rc + j, c);
            const int col = g0 + c, h = col >> 6, d = col & 63;
            store8(dst + ((size_t)(b * 6 + h) * 64 + d) * S + s0 + 8 * rc, v);
        }
    } else {
#pragma unroll 1
        for (int it = 0; it < 8; ++it) {
            const int id = it * 256 + tid, r = id >> 4, c8 = (id & 15) * 8;
            float v[8];
#pragma unroll
            for (int j = 0; j < 8; ++j) v[j] = T(r, c8 + j);
            if (nt == 13) store8(WSP(bf, OFF_CQ) + (size_t)(t0 + r) * 192 + c8, v);
            else if (nt == 14) {
                if (c8 < 64) store8(WSP(bf, OFF_CQ) + (size_t)(t0 + r) * 192 + 128 + c8, v);
                else if (c8 < 96) store8(WSP(bf, OFF_KR) + (size_t)(t0 + r) * 32 + (c8 - 64), v);
            } else store8(WSP(bf, OFF_CKV) + (size_t)(t0 + r) * 128 + c8, v);
        }
    }
}

__global__ void __launch_bounds__(256) k_p1_route_naive(Params p, int l, int chunk) {
    const int mt = blockIdx.x / 4, ntl = blockIdx.x % 4;
    const float* C = WSP(float, OFF_MIX) + (size_t)mt * 128 * 512 + ntl * 128;
    route_tile(p, l, mt, chunk * 4 + ntl, [=](int r, int c) { return C[(size_t)r * 512 + c]; });
}

DI void lru_tile(const Params& p, int l, int b, int tile, int mode, float* sXC  , float* sRed  ) {
    const int c = threadIdx.x, blk = c >> 6, j = c & 63, lane = c & 63, wv = c >> 6;
    const bf* LX = WSP(bf, OFF_LX); const bf* GGp = WSP(bf, OFF_GG);
    const float cw0 = p.in[I_CONVW][(l * 4 + 0) * 256 + c], cw1 = p.in[I_CONVW][(l * 4 + 1) * 256 + c], cw2 = p.in[I_CONVW][(l * 4 + 2) * 256 + c],
                cw3 = p.in[I_CONVW][(l * 4 + 3) * 256 + c], cb = p.in[I_CONVB][l * 256 + c];
    const float ba = p.in[I_BA][l * 256 + c], bx = p.in[I_BX][l * 256 + c];
    const float lam = p.in[I_LAM][l * 256 + c];
    const float c8 = 8.f * log1pf(__expf(-lam));
    const uint4* wa4 = (const uint4*)(WSP(bf, OFF_WAX) + (size_t)(((l * 2 + 0) * 4 + blk) * 64 + j) * 64);
    const uint4* wx4 = (const uint4*)(WSP(bf, OFF_WAX) + (size_t)(((l * 2 + 1) * 4 + blk) * 64 + j) * 64);
    uint4 wa[8], wx[8];
#pragma unroll
    for (int i = 0; i < 8; ++i) { wa[i] = wa4[i]; wx[i] = wx4[i]; }
    const int tb = b * S + tile * 64;
    float xm3 = 0.f, xm2 = 0.f, xm1 = 0.f;
    if (tile > 0) { xm3 = bf2f(LX[(size_t)(tb - 3) * 256 + c]); xm2 = bf2f(LX[(size_t)(tb - 2) * 256 + c]); xm1 = bf2f(LX[(size_t)(tb - 1) * 256 + c]); }
    float h = 0.f, aprod = 1.f;
    if (mode == 1) {
        const float* TOT = WSP(float, OFF_TOT) + (size_t)(b * 64) * 512;
        for (int i = 0; i < tile; ++i) h = TOT[i * 512 + c] * h + TOT[i * 512 + 256 + c];
    }
    for (int g = 0; g < 4; ++g) {
        float xc[16];
#pragma unroll
        for (int tt = 0; tt < 16; ++tt) {
            const float x0 = bf2f(LX[(size_t)(tb + g * 16 + tt) * 256 + c]);
            xc[tt] = cw0 * xm3 + cw1 * xm2 + cw2 * xm1 + cw3 * x0 + cb;
            xm3 = xm2; xm2 = xm1; xm1 = x0;
            sXC[tt * 256 + c] = xc[tt];
        }
        __syncthreads();
        float yv[16];
#pragma unroll
        for (int tt = 0; tt < 16; ++tt) {
            float ra = ba, rx = bx;
            const float* xr = sXC + tt * 256 + blk * 64;
#pragma unroll
            for (int i = 0; i < 8; ++i) {
                const unsigned a4[4] = {wa[i].x, wa[i].y, wa[i].z, wa[i].w}, x4[4] = {wx[i].x, wx[i].y, wx[i].z, wx[i].w};
#pragma unroll
                for (int q = 0; q < 4; ++q) {
                    const float v0 = xr[i * 8 + q * 2], v1 = xr[i * 8 + q * 2 + 1];
                    ra += v0 * lo16(a4[q]) + v1 * hi16(a4[q]);
                    rx += v0 * lo16(x4[q]) + v1 * hi16(x4[q]);
                }
            }
            const float r = sigmoidf_(ra), ig = sigmoidf_(rx);
            const float log_a = -c8 * r;
            const float a = __expf(log_a);
            const float bb = sqrtf(-expm1f(2.f * log_a)) * ig * xc[tt];
            h = a * h + bb; aprod *= a;
            if (mode == 1) yv[tt] = h * bf2f(GGp[(size_t)(tb + g * 16 + tt) * 256 + c]);
        }
        if (mode == 1) {
#pragma unroll
            for (int tt = 0; tt < 16; ++tt) {
                const float ss = wave_sum(yv[tt] * yv[tt]);
                if (lane == 0) sRed[tt * 4 + wv] = ss;
            }
            __syncthreads();
            bf* MIX = WSP(bf, OFF_MIX);
#pragma unroll
            for (int tt = 0; tt < 16; ++tt) {
                const float ss = sRed[tt * 4] + sRed[tt * 4 + 1] + sRed[tt * 4 + 2] + sRed[tt * 4 + 3];
                MIX[(size_t)(tb + g * 16 + tt) * 1024 + c] = f2bf(yv[tt] * rsqrtf(ss * (1.f / 256.f) + EPS));
            }
        }
        __syncthreads();
    }
    if (mode == 0) {
        float* TOT = WSP(float, OFF_TOT) + (size_t)(b * 64 + tile) * 512;
        TOT[c] = aprod; TOT[256 + c] = h;
    }
}

__global__ void __launch_bounds__(256) k_lru(Params p, int l, int mode) {
    __shared__ float sXC[16 * 256]; __shared__ float sRed[64];
    for (int u = blockIdx.x; u < 256; u += gridDim.x) lru_tile(p, l, u >> 6, u & 63, mode, sXC, sRed);
}

__global__ void __launch_bounds__(256) k_mla_up_naive(Params p, int l) {
    __shared__ float sCQ[4][192], sCKV[4][128], sQ[4][576], sKV[4][768];
    const int tid = threadIdx.x, lane = tid & 63, wv = tid >> 6;
    const int t0 = blockIdx.x * 4;
    {
        const int t = t0 + wv;
        const bf* cq = WSP(bf, OFF_CQ) + (size_t)t * 192; const bf* ckv = WSP(bf, OFF_CKV) + (size_t)t * 128;
        float a0 = bf2f(cq[lane]), a1 = bf2f(cq[lane + 64]), a2 = bf2f(cq[lane + 128]);
        float ss = wave_sum(a0 * a0 + a1 * a1 + a2 * a2);
        float rn = rsqrtf(ss * (1.f / 192.f) + EPS);
        sCQ[wv][lane] = a0 * rn; sCQ[wv][lane + 64] = a1 * rn; sCQ[wv][lane + 128] = a2 * rn;
        float b0 = bf2f(ckv[lane]), b1 = bf2f(ckv[lane + 64]);
        ss = wave_sum(b0 * b0 + b1 * b1);
        rn = rsqrtf(ss * (1.f / 128.f) + EPS);
        sCKV[wv][lane] = b0 * rn; sCKV[wv][lane + 64] = b1 * rn;
    }
    __syncthreads();
    const bf* WUQ = WSP(bf, OFF_WUQ) + (size_t)l * 576 * 192;
    const bf* WUKV = WSP(bf, OFF_WUKV) + (size_t)l * 768 * 128;
    for (int n = tid; n < 576; n += 256) {
        float acc[4] = {0.f, 0.f, 0.f, 0.f};
        for (int k = 0; k < 192; ++k) { const float w = bf2f(WUQ[(size_t)n * 192 + k]);
#pragma unroll
            for (int q = 0; q < 4; ++q) acc[q] += sCQ[q][k] * w; }
#pragma unroll
        for (int q = 0; q < 4; ++q) sQ[q][n] = acc[q];
    }
    for (int n = tid; n < 768; n += 256) {
        float acc[4] = {0.f, 0.f, 0.f, 0.f};
        for (int k = 0; k < 128; ++k) { const float w = bf2f(WUKV[(size_t)n * 128 + k]);
#pragma unroll
            for (int q = 0; q < 4; ++q) acc[q] += sCKV[q][k] * w; }
#pragma unroll
        for (int q = 0; q < 4; ++q) sKV[q][n] = acc[q];
    }
    __syncthreads();
    if (tid < 48) {
        const int tok = tid / 12, h = (tid % 12) >> 1, which = tid & 1;
        const int t = t0 + tok, b = t >> 12, s = t & 4095;
        const float* rope = WSP(float, OFF_ROPE) + s * 32;
        const float* gain = p.in[which ? I_MKG : I_MQG] + l * 96;
        const bf* kr = WSP(bf, OFF_KR) + (size_t)t * 32;
        bf* dst = WSP(bf, which ? OFF_MK : OFF_MQ) + ((size_t)(b * 6 + h) * S + s) * 96;
        float ss = 0.f;
        for (int d = 0; d < 96; ++d) {
            const float v = which ? (d < 64 ? sKV[tok][h * 128 + d] : bf2f(kr[d - 64])) : sQ[tok][h * 96 + d];
            ss += v * v;
        }
        const float rn = rsqrtf(ss * (1.f / 96.f) + EPS);
        for (int d = 0; d < 64; ++d) {
            const float v = which ? sKV[tok][h * 128 + d] : sQ[tok][h * 96 + d];
            dst[d] = f2bf(v * rn * gain[d]);
        }
        for (int i = 0; i < 16; ++i) {
            const float x1 = (which ? bf2f(kr[i]) : sQ[tok][h * 96 + 64 + i]) * rn * gain[64 + i];
            const float x2 = (which ? bf2f(kr[16 + i]) : sQ[tok][h * 96 + 80 + i]) * rn * gain[80 + i];
            const float cs = rope[i], sn = rope[16 + i];
            dst[64 + i] = f2bf(x1 * cs - x2 * sn);
            dst[80 + i] = f2bf(x1 * sn + x2 * cs);
        }
    }
    bf* mvt = WSP(bf, OFF_MVT);
    for (int e = tid; e < 4 * 384; e += 256) {
        const int tok = e / 384, r = e % 384, h = r >> 6, d = r & 63;
        const int t = t0 + tok, b = t >> 12, s = t & 4095;
        mvt[((size_t)(b * 6 + h) * 64 + d) * S + s] = f2bf(sKV[tok][h * 128 + 64 + d]);
    }
}

DI float rdlane(float v, int j) { return __int_as_float(__builtin_amdgcn_readlane(__float_as_int(v), j)); }

__global__ void __launch_bounds__(256) k_diff_attn_naive(Params p, int l) {
    const int lane = threadIdx.x & 63, gw = blockIdx.x * 4 + (threadIdx.x >> 6);
    const int q = gw & 4095, bh = gw >> 12, h = bh % 6, b = bh / 6;
    const bf* DQ = WSP(bf, OFF_DQ); const bf* DK = WSP(bf, OFF_DK); const bf* DVT = WSP(bf, OFF_DVT);
    float lam;
    {
        float d1 = 0.f, d2 = 0.f;
        for (int i = 0; i < 32; ++i) { d1 += p.in[I_LQ1][l * 32 + i] * p.in[I_LK1][l * 32 + i]; d2 += p.in[I_LQ2][l * 32 + i] * p.in[I_LK2][l * 32 + i]; }
        lam = expf(d1) - expf(d2) + lambda_init(l);
    }
    const float slope = exp2f(-8.f * (float)(h + 1) / 6.f);
    const float scale = 0.17677669529663687f;
    float q0[32], q1[32];
    {
        const bf* a = DQ + ((size_t)(bh * 2 + 0) * S + q) * 32; const bf* c = DQ + ((size_t)(bh * 2 + 1) * S + q) * 32;
#pragma unroll
        for (int d = 0; d < 32; ++d) { q0[d] = bf2f(a[d]); q1[d] = bf2f(c[d]); }
    }
    float m0 = -INFINITY, m1 = -INFINITY, l0 = 0.f, l1 = 0.f, o0 = 0.f, o1 = 0.f;
    const int nkb = (q >> 6) + 1;
    for (int kb = 0; kb < nkb; ++kb) {
        const int k = kb * 64 + lane;
        const uint4* ka = (const uint4*)(DK + ((size_t)(bh * 2 + 0) * S + k) * 32);
        const uint4* kc = (const uint4*)(DK + ((size_t)(bh * 2 + 1) * S + k) * 32);
        float s0 = 0.f, s1 = 0.f;
#pragma unroll
        for (int i = 0; i < 4; ++i) {
            const uint4 u = ka[i], w = kc[i];
            const unsigned uu[4] = {u.x, u.y, u.z, u.w}, ww[4] = {w.x, w.y, w.z, w.w};
#pragma unroll
            for (int e = 0; e < 4; ++e) {
                s0 += q0[i * 8 + e * 2] * lo16(uu[e]) + q0[i * 8 + e * 2 + 1] * hi16(uu[e]);
                s1 += q1[i * 8 + e * 2] * lo16(ww[e]) + q1[i * 8 + e * 2 + 1] * hi16(ww[e]);
            }
        }
        const float bias = -slope * fabsf((float)(q - k));
        s0 = s0 * scale + bias; s1 = s1 * scale + bias;
        const float n0 = fmaxf(m0, wave_max(s0)), n1 = fmaxf(m1, wave_max(s1));
        const float a0 = __expf(m0 - n0), a1 = __expf(m1 - n1);
        const float p0 = __expf(s0 - n0), p1 = __expf(s1 - n1);
        l0 = l0 * a0 + p0; l1 = l1 * a1 + p1; o0 *= a0; o1 *= a1; m0 = n0; m1 = n1;
        const uint4* vp = (const uint4*)(DVT + ((size_t)bh * 64 + lane) * S + kb * 64);
        uint4 v[8];
#pragma unroll
        for (int i = 0; i < 8; ++i) v[i] = vp[i];
#pragma unroll
        for (int i = 0; i < 8; ++i) {
            const unsigned vv[4] = {v[i].x, v[i].y, v[i].z, v[i].w};
#pragma unroll
            for (int e = 0; e < 4; ++e) {
                const int j = i * 8 + e * 2;
                const float va = lo16(vv[e]), vb = hi16(vv[e]);
                o0 += rdlane(p0, j) * va + rdlane(p0, j + 1) * vb;
                o1 += rdlane(p1, j) * va + rdlane(p1, j + 1) * vb;
            }
        }
    }
    const float L0 = wave_sum(l0), L1 = wave_sum(l1);
    const float o = o0 / L0 - lam * (o1 / L1);
    const float ss = wave_sum(o * o);
    WSP(bf, OFF_MIX)[(size_t)(b * S + q) * 1024 + 256 + h * 64 + lane] = f2bf(o * rsqrtf(ss * (1.f / 64.f) + EPS));
}

__global__ void __launch_bounds__(256) k_mla_attn_naive(Params p, int l) {
    const int lane = threadIdx.x & 63, gw = blockIdx.x * 4 + (threadIdx.x >> 6);
    const int q = gw & 4095, bh = gw >> 12, h = bh % 6, b = bh / 6;
    const bf* MQ = WSP(bf, OFF_MQ); const bf* MK = WSP(bf, OFF_MK); const bf* MVT = WSP(bf, OFF_MVT);
    const float scale = 0.10206207261596575f;
    float qv[96];
    {
        const bf* a = MQ + ((size_t)bh * S + q) * 96;
#pragma unroll
        for (int d = 0; d < 96; ++d) qv[d] = bf2f(a[d]);
    }
    float m0 = -INFINITY, l0 = 0.f, o0 = 0.f;
    const int nkb = (q >> 6) + 1;
    for (int kb = 0; kb < nkb; ++kb) {
        const int k = kb * 64 + lane;
        const uint4* ka = (const uint4*)(MK + ((size_t)bh * S + k) * 96);
        float s0 = 0.f;
#pragma unroll
        for (int i = 0; i < 12; ++i) {
            const uint4 u = ka[i];
            const unsigned uu[4] = {u.x, u.y, u.z, u.w};
#pragma unroll
            for (int e = 0; e < 4; ++e) s0 += qv[i * 8 + e * 2] * lo16(uu[e]) + qv[i * 8 + e * 2 + 1] * hi16(uu[e]);
        }
        s0 *= scale;
        const float n0 = fmaxf(m0, wave_max(s0));
        const float a0 = __expf(m0 - n0), p0 = __expf(s0 - n0);
        l0 = l0 * a0 + p0; o0 *= a0; m0 = n0;
        const uint4* vp = (const uint4*)(MVT + ((size_t)bh * 64 + lane) * S + kb * 64);
        uint4 v[8];
#pragma unroll
        for (int i = 0; i < 8; ++i) v[i] = vp[i];
#pragma unroll
        for (int i = 0; i < 8; ++i) {
            const unsigned vv[4] = {v[i].x, v[i].y, v[i].z, v[i].w};
#pragma unroll
            for (int e = 0; e < 4; ++e) {
                const int j = i * 8 + e * 2;
                o0 += rdlane(p0, j) * lo16(vv[e]) + rdlane(p0, j + 1) * hi16(vv[e]);
            }
        }
    }
    const float o = o0 / wave_sum(l0);
    const float ss = wave_sum(o * o);
    const int t = b * S + q;
    WSP(bf, OFF_MIX)[(size_t)t * 1024 + 640 + h * 64 + lane] = f2bf(o);
    if (lane == 0) WSP(float, OFF_SSQM)[t * 8 + h] = ss;
}

__global__ void __launch_bounds__(256) k_mla_norm_fix(Params p) {
    const int gid = blockIdx.x * 256 + threadIdx.x;
    if (gid >= NT * 48) return;
    const int t = gid / 48, c8 = (gid % 48) * 8;
    const float* sq = WSP(float, OFF_SSQM) + t * 8;
    const float rn = rsqrtf((sq[0] + sq[1] + sq[2] + sq[3] + sq[4] + sq[5]) * (1.f / 384.f) + EPS);
    bf* m = WSP(bf, OFF_MIX) + (size_t)t * 1024 + 640 + c8;
    float v[8];
#pragma unroll
    for (int j = 0; j < 8; ++j) v[j] = bf2f(m[j]) * rn;
    store8(m, v);
}

__global__ void __launch_bounds__(256) k_p4_gemm_naive(Params p, int l) {
    __shared__ float sA[16 * 68], sB[16 * 68];
    const int mt = blockIdx.x / 16, nt = blockIdx.x % 16;
    const bf* A = WSP(bf, OFF_MIX) + (size_t)mt * 64 * D;
    const bf* Bt = WSP(bf, OFF_WOUT) + (size_t)l * 1024 * 1024 + (size_t)(nt * 64) * 1024;
    const float* xin = (l == 0 ? p.in[I_X] : WSP(float, OFF_XFA)) + (size_t)mt * 64 * D + nt * 64;
    float* x1 = p.out + (size_t)mt * 64 * D + nt * 64;
    bf* xb1 = WSP(bf, OFF_XB) + (size_t)mt * 64 * D + nt * 64;
    const float* g2 = p.in[I_N2G] + l * 1024 + nt * 64;
    ngemm_tile<true>(1024, [=](int r, int k) { return bf2f(A[(size_t)r * D + k]); }, [=](int k, int c) { return bf2f(Bt[(size_t)c * 1024 + k]); },
               [=](int r, int c, float v) { const float x = xin[(size_t)r * D + c] + v; x1[(size_t)r * D + c] = x; xb1[(size_t)r * D + c] = f2bf(x * g2[c]); }, sA, sB);
}

__global__ void __launch_bounds__(256) k_router(Params p, int l) {
    const int lane = threadIdx.x & 63, gw = blockIdx.x * 4 + (threadIdx.x >> 6), nw = gridDim.x * 4;
    const float* WR = WSP(float, OFF_WR) + (size_t)l * 36 * 1024;
    int* cnt = WSP(int, OFF_CTL) + CTL_CNT;
    int* list = WSP(int, OFF_LIST);
    float* gatew = WSP(float, OFF_GATEW);
    for (int t = gw; t < NT; t += nw) {
        const float* x = p.out + (size_t)t * D;
        float4 xv[4]; float ss = 0.f;
#pragma unroll
        for (int i = 0; i < 4; ++i) { xv[i] = *(const float4*)(x + lane * 4 + 256 * i); ss += xv[i].x * xv[i].x + xv[i].y * xv[i].y + xv[i].z * xv[i].z + xv[i].w * xv[i].w; }
        ss = wave_sum(ss);
        const float rinv = rsqrtf(ss * (1.f / 1024.f) + EPS);
        float lg[36];
#pragma unroll
        for (int j = 0; j < 36; ++j) {
            float a = 0.f;
#pragma unroll
            for (int i = 0; i < 4; ++i) { const float4 w = *(const float4*)(WR + (size_t)j * 1024 + lane * 4 + 256 * i); a += xv[i].x * w.x + xv[i].y * w.y + xv[i].z * w.z + xv[i].w * w.w; }
            lg[j] = wave_sum(a) * rinv + (j < 4 ? p.in[I_RGB][l * 4 + j] : p.in[I_REB][l * 32 + j - 4]);
        }
        int g = 0; float gm = lg[0];
#pragma unroll
        for (int j = 1; j < 4; ++j) if (lg[j] > gm) { gm = lg[j]; g = j; }
        float gs = 0.f;
#pragma unroll
        for (int j = 0; j < 4; ++j) gs += __expf(lg[j] - gm);
        const float pg_top = 1.f / gs;
        float e[8];
#pragma unroll
        for (int i = 0; i < 8; ++i) e[i] = g == 0 ? lg[4 + i] : (g == 1 ? lg[12 + i] : (g == 2 ? lg[20 + i] : lg[28 + i]));
        int i1 = 0; float v1 = e[0];
#pragma unroll
        for (int i = 1; i < 8; ++i) if (e[i] > v1) { v1 = e[i]; i1 = i; }
        int i2 = -1; float v2 = -INFINITY;
#pragma unroll
        for (int i = 0; i < 8; ++i) if (i != i1 && e[i] > v2) { v2 = e[i]; i2 = i; }
        const float p1 = 1.f, p2 = __expf(v2 - v1);
        const float g1 = pg_top * p1 / (p1 + p2), g2 = pg_top * p2 / (p1 + p2);
        if (lane == 0) {
            const int e1 = g * 8 + i1, e2 = g * 8 + i2;
            const int pos1 = atomicAdd(&cnt[e1], 1); list[e1 * 16384 + pos1] = t * 2;
            const int pos2 = atomicAdd(&cnt[e2], 1); list[e2 * 16384 + pos2] = t * 2 + 1;
            gatew[t * 2] = g1; gatew[t * 2 + 1] = g2;
            WSP(float, OFF_RINV2)[t] = rinv;
        }
    }
}

__global__ void __launch_bounds__(256) k_moe_up_naive(Params p, int l) {
    __shared__ float sA[16 * 68], sB[16 * 68]; __shared__ int sTok[64];
    const int nt = blockIdx.x & 7, rb = (blockIdx.x >> 3) & 255, e = blockIdx.x >> 11;
    const int* cnt = WSP(int, OFF_CTL) + CTL_CNT;
    const int n = cnt[e];
    if (rb * 64 >= n) return;
    int base = 0; for (int i = 0; i < e; ++i) base += cnt[i];
    if (threadIdx.x < 64) { const int r = rb * 64 + threadIdx.x; sTok[threadIdx.x] = r < n ? (WSP(int, OFF_LIST)[e * 16384 + r] >> 1) : -1; }
    __syncthreads();
    const bf* XB = WSP(bf, OFF_XB);
    const float* W = (nt < 4 ? p.in[I_W1] : p.in[I_W3]) + (size_t)(l * 32 + e) * 1024 * 256 + (nt & 3) * 64;
    const float* rinv2 = WSP(float, OFF_RINV2);
    float* H = WSP(float, OFF_H13) + (size_t)(base + rb * 64) * 512 + nt * 64;
    const int* tk = sTok;
    ngemm_tile<false>(1024, [=](int r, int k) { const int t = tk[r]; return t >= 0 ? bf2f(XB[(size_t)t * D + k]) : 0.f; }, [=](int k, int c) { return bf2f(f2bf(W[(size_t)k * 256 + c])); },
               [=](int r, int c, float v) { const int t = tk[r]; if (t >= 0) H[(size_t)r * 512 + c] = v * rinv2[t]; }, sA, sB);
}

__global__ void __launch_bounds__(256) k_moe_act_naive(Params p) {
    const int gid = blockIdx.x * 256 + threadIdx.x;
    const int row = gid >> 5, c8 = (gid & 31) * 8;
    const float* H = WSP(float, OFF_H13) + (size_t)row * 512;
    float v[8];
#pragma unroll
    for (int j = 0; j < 8; ++j) { const float a = H[c8 + j], b = H[256 + c8 + j]; v[j] = a * sigmoidf_(a) * b; }
    store8(WSP(bf, OFF_ACT) + (size_t)row * 256 + c8, v);
}

__global__ void __launch_bounds__(256) k_moe_down_naive(Params p, int l) {
    __shared__ float sA[16 * 68], sB[16 * 68]; __shared__ int sEnt[64];
    const int nt = blockIdx.x & 15, rb = (blockIdx.x >> 4) & 255, e = blockIdx.x >> 12;
    const int* cnt = WSP(int, OFF_CTL) + CTL_CNT;
    const int n = cnt[e];
    if (rb * 64 >= n) return;
    int base = 0; for (int i = 0; i < e; ++i) base += cnt[i];
    if (threadIdx.x < 64) { const int r = rb * 64 + threadIdx.x; sEnt[threadIdx.x] = r < n ? WSP(int, OFF_LIST)[e * 16384 + r] : -1; }
    __syncthreads();
    const bf* A = WSP(bf, OFF_ACT) + (size_t)(base + rb * 64) * 256;
    const float* W = p.in[I_W2] + (size_t)(l * 32 + e) * 256 * 1024 + nt * 64;
    const float* gatew = WSP(float, OFF_GATEW);
    bf* Y = WSP(bf, OFF_Y);
    const int* en = sEnt;
    ngemm_tile<false>(256, [=](int r, int k) { return en[r] >= 0 ? bf2f(A[(size_t)r * 256 + k]) : 0.f; }, [=](int k, int c) { return bf2f(f2bf(W[(size_t)k * 1024 + c])); },
               [=](int r, int c, float v) { const int en_ = en[r]; if (en_ >= 0) Y[((size_t)(en_ & 1) * NT + (en_ >> 1)) * D + nt * 64 + c] = f2bf(v * gatew[en_]); }, sA, sB);
}

__global__ void __launch_bounds__(256) k_combine(Params p, int last) {
    const int lane = threadIdx.x & 63, gw = blockIdx.x * 4 + (threadIdx.x >> 6), nw = gridDim.x * 4;
    const bf* Y = WSP(bf, OFF_Y);
    float* xo = last ? p.out : WSP(float, OFF_XFA);
    bf* xb = WSP(bf, OFF_XB);
    for (int t = gw; t < NT; t += nw) {
        float ss = 0.f;
#pragma unroll
        for (int i = 0; i < 2; ++i) {
            const int c = (lane + 64 * i) * 8;
            const float4 a = *(const float4*)(p.out + (size_t)t * D + c), b = *(const float4*)(p.out + (size_t)t * D + c + 4);
            const uint4 y0 = *(const uint4*)(Y + (size_t)t * D + c), y1 = *(const uint4*)(Y + ((size_t)NT + t) * D + c);
            float v[8] = {a.x, a.y, a.z, a.w, b.x, b.y, b.z, b.w};
            const unsigned u0[4] = {y0.x, y0.y, y0.z, y0.w}, u1[4] = {y1.x, y1.y, y1.z, y1.w};
#pragma unroll
            for (int e = 0; e < 4; ++e) { v[2 * e] += lo16(u0[e]) + lo16(u1[e]); v[2 * e + 1] += hi16(u0[e]) + hi16(u1[e]); }
#pragma unroll
            for (int j = 0; j < 8; ++j) ss += v[j] * v[j];
            *(float4*)(xo + (size_t)t * D + c) = make_float4(v[0], v[1], v[2], v[3]);
            *(float4*)(xo + (size_t)t * D + c + 4) = make_float4(v[4], v[5], v[6], v[7]);
            if (!last) store8(xb + (size_t)t * D + c, v);
        }
        ss = wave_sum(ss);
        if (!last && lane == 0) WSP(float, OFF_RINV1)[t] = rsqrtf(ss * (1.f / 1024.f) + EPS);
    }
}

__global__ void __launch_bounds__(256) k_zero_cnt(Params p) { if (threadIdx.x < 32) WSP(int, OFF_CTL)[CTL_CNT + threadIdx.x] = 0; }

extern "C" void kernel_launch(void* const* d_in, const int* in_sizes, int n_in, void* d_out, int out_size, void* d_ws, size_t ws_size, hipStream_t stream) {
    if (n_in != N_IN || ws_size < WS_TOTAL || out_size != NT * D) { fprintf(stderr, "kernel_launch: bad sizes n_in %d ws %zu (need %zu) out %d\n", n_in, ws_size, (size_t)WS_TOTAL, out_size); return; }
    Params p{};
    for (int i = 0; i < N_IN; ++i) p.in[i] = (const float*)d_in[i];
    p.out = (float*)d_out; p.ws = (unsigned char*)d_ws;
    k_prep_weights<<<1024, 256, 0, stream>>>(p);
    k_prep_misc<<<512, 256, 0, stream>>>(p);
    k_prep_x<<<1024, 256, 0, stream>>>(p);
    for (int l = 0; l < 2; ++l) {
        for (int ch = 0; ch < 4; ++ch) {
            k_p1_gemm_naive<<<256 * 8, 256, 0, stream>>>(p, l, ch);
            k_p1_route_naive<<<128 * 4, 256, 0, stream>>>(p, l, ch);
        }
        k_lru<<<256, 256, 0, stream>>>(p, l, 0);
        k_mla_up_naive<<<NT / 4, 256, 0, stream>>>(p, l);
        k_lru<<<256, 256, 0, stream>>>(p, l, 1);
        k_diff_attn_naive<<<NB * 6 * S / 4, 256, 0, stream>>>(p, l);
        k_mla_attn_naive<<<NB * 6 * S / 4, 256, 0, stream>>>(p, l);
        k_mla_norm_fix<<<NT * 48 / 256, 256, 0, stream>>>(p);
        k_p4_gemm_naive<<<256 * 16, 256, 0, stream>>>(p, l);
        k_zero_cnt<<<1, 64, 0, stream>>>(p);
        k_router<<<1024, 256, 0, stream>>>(p, l);
        k_moe_up_naive<<<32 * 256 * 8, 256, 0, stream>>>(p, l);
        k_moe_act_naive<<<32768 * 32 / 256, 256, 0, stream>>>(p);
        k_moe_down_naive<<<32 * 256 * 16, 256, 0, stream>>>(p, l);
        k_combine<<<1024, 256, 0, stream>>>(p, l == 1);
    }
}
```

```cpp
#include <hip/hip_runtime.h>
#include <hip/hip_cooperative_groups.h>
namespace cg = cooperative_groups;
#include <cstdio>
#include <cstdint>

#define DI __device__ __forceinline__
typedef unsigned short bf;

constexpr int NB = 4, S = 4096, D = 1024, NT = NB * S, NPROJ = 2048;
constexpr float EPS = 1e-6f;
enum { I_X = 0, I_N1G, I_WIN, I_CONVW, I_CONVB, I_WA, I_BA, I_WX, I_BX, I_LAM, I_LOUTG, I_DQG, I_DKG, I_LQ1, I_LK1, I_LQ2, I_LK2,
       I_SUBG, I_CQG, I_CKVG, I_WUQ, I_WUKV, I_MQG, I_MKG, I_MOUTG, I_WOUT, I_N2G, I_RGW, I_RGB, I_REW, I_REB, I_W1, I_W3, I_W2, N_IN };

struct Params { const float* in[N_IN]; float* out; unsigned char* ws; };

constexpr size_t AL(size_t x) { return (x + 255) & ~(size_t)255; }
constexpr size_t OFF_WIN = 0;
constexpr size_t OFF_WOUT = OFF_WIN + (size_t)2 * 2048 * 1024 * 2;
constexpr size_t OFF_WUQ = OFF_WOUT + (size_t)2 * 1024 * 1024 * 2;
constexpr size_t OFF_WUKV = OFF_WUQ + (size_t)2 * 576 * 192 * 2;
constexpr size_t OFF_WAX = OFF_WUKV + (size_t)2 * 768 * 128 * 2;
constexpr size_t OFF_WR = OFF_WAX + (size_t)2 * 2 * 4 * 64 * 64 * 2;
constexpr size_t OFF_ROPE = AL(OFF_WR + (size_t)2 * 36 * 1024 * 4);
constexpr size_t OFF_CTL = OFF_ROPE + (size_t)4096 * 32 * 4;
constexpr size_t OFF_RINV1 = OFF_CTL + 65536;
constexpr size_t OFF_RINV2 = OFF_RINV1 + (size_t)NT * 4;
constexpr size_t OFF_SSQM = OFF_RINV2 + (size_t)NT * 4;
constexpr size_t OFF_TOT = OFF_SSQM + (size_t)NT * 8 * 4;
constexpr size_t OFF_GATEW = OFF_TOT + (size_t)4 * 64 * 2 * 256 * 4;
constexpr size_t OFF_LIST = OFF_GATEW + (size_t)NT * 2 * 4;
constexpr size_t OFF_XFA = OFF_LIST + (size_t)32 * 16384 * 4;
constexpr size_t OFF_XB = OFF_XFA + (size_t)NT * D * 4;
constexpr size_t OFF_MIX = OFF_XB + (size_t)NT * D * 2;
constexpr size_t OFF_STAGE = OFF_MIX + (size_t)NT * D * 2;
constexpr size_t OFF_LX = OFF_STAGE;
constexpr size_t OFF_GG = OFF_LX + (size_t)NT * 256 * 2;
constexpr size_t OFF_DQ = OFF_GG + (size_t)NT * 256 * 2;
constexpr size_t OFF_DK = OFF_DQ + (size_t)NT * 384 * 2;
constexpr size_t OFF_DVT = OFF_DK + (size_t)NT * 384 * 2;
constexpr size_t OFF_CQ = OFF_DVT + (size_t)NT * 384 * 2;
constexpr size_t OFF_CKV = OFF_CQ + (size_t)NT * 192 * 2;
constexpr size_t OFF_KR = OFF_CKV + (size_t)NT * 128 * 2;
constexpr size_t OFF_MQ = OFF_KR + (size_t)NT * 32 * 2;
constexpr size_t OFF_MK = OFF_MQ + (size_t)NT * 576 * 2;
constexpr size_t OFF_MVT = OFF_MK + (size_t)NT * 576 * 2;
constexpr size_t OFF_STAGE_END = OFF_MVT + (size_t)NT * 384 * 2;
constexpr size_t OFF_Y = OFF_STAGE;
constexpr size_t OFF_ACT = OFF_Y + (size_t)2 * NT * D * 2;
constexpr size_t OFF_H13 = OFF_Y;
constexpr size_t WS_TOTAL = OFF_STAGE_END;
static_assert(OFF_ACT + (size_t)(32768 + 128) * 256 * 2 <= OFF_STAGE_END, "alias");
constexpr int CTL_CNT = 0;

#define WSP(T, off) ((T*)(p.ws + (off)))

DI float bf2f(bf v) { return __uint_as_float(((unsigned)v) << 16); }
DI bf f2bf(float f) { unsigned u = __float_as_uint(f); u += 0x7fffu + ((u >> 16) & 1u); return (bf)(u >> 16); }
DI unsigned pack2(float a, float b) { return (unsigned)f2bf(a) | ((unsigned)f2bf(b) << 16); }
DI float lo16(unsigned u) { return __uint_as_float(u << 16); }
DI float hi16(unsigned u) { return __uint_as_float(u & 0xffff0000u); }
DI float wave_sum(float v) { for (int o = 32; o > 0; o >>= 1) v += __shfl_xor(v, o); return v; }
DI float wave_max(float v) { for (int o = 32; o > 0; o >>= 1) v = fmaxf(v, __shfl_xor(v, o)); return v; }
DI float gelu_tanh(float x) { return 0.5f * x * (1.f + tanhf(0.7978845608028654f * (x + 0.044715f * x * x * x))); }
DI float sigmoidf_(float x) { return 1.f / (1.f + __expf(-x)); }
DI float lambda_init(int l) { return l == 0 ? 0.2f : 0.35550906757f; }
DI void store8(bf* dst, const float* v) { uint4 u; u.x = pack2(v[0], v[1]); u.y = pack2(v[2], v[3]); u.z = pack2(v[4], v[5]); u.w = pack2(v[6], v[7]); *(uint4*)dst = u; }

template <class SCOL, class GAIN>
DI void tr_tile(const float* src, int lds_, bf* dst, int K, int n0, int k0, SCOL scol, GAIN gain, float* tile) {
    const int tid = threadIdx.x;
    const int nn = tid & 63;
    const int sc = scol(n0 + nn);
#pragma unroll
    for (int i = 0; i < 16; ++i) {
        const int kk = (tid >> 6) + 4 * i;
        float v = 0.f;
        if (sc >= 0) v = src[(size_t)(k0 + kk) * lds_ + sc] * gain(k0 + kk);
        tile[kk * 65 + nn] = v;
    }
    __syncthreads();
#pragma unroll
    for (int i = 0; i < 2; ++i) {
        const int id = tid + 256 * i, n = id >> 3, kc = (id & 7) * 8;
        float v[8];
#pragma unroll
        for (int j = 0; j < 8; ++j) v[j] = tile[(kc + j) * 65 + n];
        store8(dst + (size_t)(n0 + n) * K + k0 + kc, v);
    }
    __syncthreads();
}

DI int win_col(int n) {
    if (n < 1856) return n;
    if (n < 1888) return 1984 + (n - 1856);
    if (n < 1920) return -1;
    return 1856 + (n - 1920);
}

constexpr int PW_WIN = 2 * 32 * 16;
constexpr int PW_WOUT = 2 * 16 * 16;
constexpr int PW_WUQ = 2 * 9 * 3;
constexpr int PW_WUKV = 2 * 12 * 2;
constexpr int PW_WAX = 2 * 2 * 4;
constexpr int PW_TOTAL = PW_WIN + PW_WOUT + PW_WUQ + PW_WUKV + PW_WAX;

DI void prep_weights_unit(const Params& p, int u, float* tile) {
    if (u < PW_WIN) {
        const int l = u / 512, r = u % 512, nt = r / 16, kt = r % 16;
        const float* g = p.in[I_N1G] + l * 1024;
        tr_tile(p.in[I_WIN] + (size_t)l * 1024 * 2016, 2016, WSP(bf, OFF_WIN) + (size_t)l * 2048 * 1024, 1024, nt * 64, kt * 64,
                [](int n) { return win_col(n); }, [g](int k) { return g[k]; }, tile);
        return;
    }
    u -= PW_WIN;
    if (u < PW_WOUT) {
        const int l = u / 256, r = u % 256, nt = r / 16, kt = r % 16;
        const float* g_lru = p.in[I_LOUTG] + l * 256; const float* g_sub = p.in[I_SUBG] + l * 64; const float* g_mla = p.in[I_MOUTG] + l * 384;
        const float li = 1.f - lambda_init(l);
        tr_tile(p.in[I_WOUT] + (size_t)l * 1024 * 1024, 1024, WSP(bf, OFF_WOUT) + (size_t)l * 1024 * 1024, 1024, nt * 64, kt * 64,
                [](int n) { return n; },
                [=](int k) { return k < 256 ? g_lru[k] : (k < 640 ? g_sub[(k - 256) & 63] * li : g_mla[k - 640]); }, tile);
        return;
    }
    u -= PW_WOUT;
    if (u < PW_WUQ) {
        const int l = u / 27, r = u % 27, nt = r / 3, kt = r % 3;
        const float* g = p.in[I_CQG] + l * 192;
        tr_tile(p.in[I_WUQ] + (size_t)l * 192 * 576, 576, WSP(bf, OFF_WUQ) + (size_t)l * 576 * 192, 192, nt * 64, kt * 64,
                [](int n) { return n; }, [g](int k) { return g[k]; }, tile);
        return;
    }
    u -= PW_WUQ;
    if (u < PW_WUKV) {
        const int l = u / 24, r = u % 24, nt = r / 2, kt = r % 2;
        const float* g = p.in[I_CKVG] + l * 128;
        tr_tile(p.in[I_WUKV] + (size_t)l * 128 * 768, 768, WSP(bf, OFF_WUKV) + (size_t)l * 768 * 128, 128, nt * 64, kt * 64,
                [](int n) { return n; }, [g](int k) { return g[k]; }, tile);
        return;
    }
    u -= PW_WUKV;
    {
        const int l = u / 8, which = (u / 4) & 1, blk = u & 3;
        const float* src = p.in[which ? I_WX : I_WA] + (size_t)(l * 4 + blk) * 4096;
        tr_tile(src, 64, WSP(bf, OFF_WAX) + (size_t)((l * 2 + which) * 4 + blk) * 4096, 64, 0, 0,
                [](int n) { return n; }, [](int) { return 1.f; }, tile);
    }
}

DI void ph_prep_weights(const Params& p, int bid, int nb, unsigned char* smem) {
    float* tile = (float*)smem;
    for (int u = bid; u < PW_TOTAL; u += nb) prep_weights_unit(p, u, tile);
}

DI void ph_prep_misc(const Params& p, int bid, int nb) {
    const int gid = bid * 256 + threadIdx.x, gsz = nb * 256;
    float* wr = WSP(float, OFF_WR);
    for (int i = gid; i < 2 * 36 * 1024; i += gsz) {
        const int l = i / (36 * 1024), r = i % (36 * 1024), j = r / 1024, k = r % 1024;
        const float g = p.in[I_N2G][l * 1024 + k];
        const float w = j < 4 ? p.in[I_RGW][(size_t)(l * 1024 + k) * 4 + j] : p.in[I_REW][(size_t)(l * 1024 + k) * 32 + (j - 4)];
        wr[i] = w * g;
    }
    float* rope = WSP(float, OFF_ROPE);
    for (int i = gid; i < 4096 * 16; i += gsz) {
        const int s = i >> 4, f = i & 15;
        const float inv_freq = (float)exp2(-(double)f / 16.0 * 13.287712379549449);
        const float angf = (float)s * inv_freq;
        double a = (double)angf;
        const double twopi = 6.283185307179586476925;
        a -= twopi * rint(a / twopi);
        const double hh = 0.5 * a, h2 = hh * hh;
        double sn = 1.0, cs = 1.0, ts = 1.0, tc = 1.0;
#pragma unroll
        for (int n = 1; n <= 10; ++n) {
            tc *= -h2 / (double)((2 * n - 1) * (2 * n));
            ts *= -h2 / (double)((2 * n) * (2 * n + 1));
            cs += tc; sn += ts;
        }
        sn *= hh;
        rope[s * 32 + f] = (float)(cs * cs - sn * sn);
        rope[s * 32 + 16 + f] = (float)(2.0 * sn * cs);
    }
    if (gid < 32) WSP(int, OFF_CTL)[CTL_CNT + gid] = 0;
}

DI void ph_prep_x(const Params& p, int bid, int nb) {
    const int lane = threadIdx.x & 63, gw = bid * 4 + (threadIdx.x >> 6), nw = nb * 4;
    const float* x = p.in[I_X];
    bf* xb = WSP(bf, OFF_XB);
    float* rinv = WSP(float, OFF_RINV1);
    for (int t = gw; t < NT; t += nw) {
        float ss = 0.f;
#pragma unroll
        for (int i = 0; i < 2; ++i) {
            const int c = (lane + 64 * i) * 8;
            const float4 a = *(const float4*)(x + (size_t)t * D + c), b = *(const float4*)(x + (size_t)t * D + c + 4);
            float v[8] = {a.x, a.y, a.z, a.w, b.x, b.y, b.z, b.w};
#pragma unroll
            for (int j = 0; j < 8; ++j) ss += v[j] * v[j];
            store8(xb + (size_t)t * D + c, v);
        }
        ss = wave_sum(ss);
        if (lane == 0) rinv[t] = rsqrtf(ss * (1.f / 1024.f) + EPS);
    }
}

template <bool BT, class LA, class LB, class EPI>
DI void ngemm_tile(int K, LA la, LB lb, EPI epi, float* sA, float* sB) {
    const int tid = threadIdx.x, ty = tid >> 4, tx = tid & 15;
    float acc[4][4];
#pragma unroll
    for (int i = 0; i < 4; ++i)
#pragma unroll
        for (int j = 0; j < 4; ++j) acc[i][j] = 0.f;
    for (int k0 = 0; k0 < K; k0 += 16) {
#pragma unroll
        for (int i = 0; i < 4; ++i) {
            const int e = tid + 256 * i;
            sA[(e & 15) * 68 + (e >> 4)] = la(e >> 4, k0 + (e & 15));
            if (BT) sB[(e & 15) * 68 + (e >> 4)] = lb(k0 + (e & 15), e >> 4);
            else sB[(e >> 6) * 68 + (e & 63)] = lb(k0 + (e >> 6), e & 63);
        }
        __syncthreads();
#pragma unroll
        for (int kk = 0; kk < 16; ++kk) {
            const float4 a = *(const float4*)(sA + kk * 68 + ty * 4), b = *(const float4*)(sB + kk * 68 + tx * 4);
            const float av[4] = {a.x, a.y, a.z, a.w}, bv[4] = {b.x, b.y, b.z, b.w};
#pragma unroll
            for (int i = 0; i < 4; ++i)
#pragma unroll
                for (int j = 0; j < 4; ++j) acc[i][j] += av[i] * bv[j];
        }
        __syncthreads();
    }
#pragma unroll
    for (int i = 0; i < 4; ++i)
#pragma unroll
        for (int j = 0; j < 4; ++j) epi(ty * 4 + i, tx * 4 + j, acc[i][j]);
}

DI void ph_p1_gemm_naive(const Params& p, int l, int chunk, int bid, int nb, unsigned char* smem) {
    float* sA = (float*)smem; float* sB = sA + 16 * 68;
    for (int u = bid; u < 2048; u += nb) {
    const int mt = u / 8, nt = u % 8;
    const bf* A = WSP(bf, OFF_XB) + (size_t)mt * 64 * D;
    const bf* Bt = WSP(bf, OFF_WIN) + (size_t)l * 2048 * 1024 + (size_t)(chunk * 512 + nt * 64) * 1024;
    const float* rinv = WSP(float, OFF_RINV1) + mt * 64;
    float* C = WSP(float, OFF_MIX) + (size_t)mt * 64 * 512 + nt * 64;
    ngemm_tile<true>(1024, [=](int r, int k) { return bf2f(A[(size_t)r * D + k]); }, [=](int k, int c) { return bf2f(Bt[(size_t)c * 1024 + k]); },
               [=](int r, int c, float v) { C[(size_t)r * 512 + c] = v * rinv[r]; }, sA, sB);
    }
}

template <class ACC>
DI void route_tile(const Params& p, int l, int mt, int nt, ACC T) {
    const int tid = threadIdx.x;
    const int t0 = mt * 128, b = t0 >> 12, s0 = t0 & 4095;
    if (nt < 4) {
        bf* dst = WSP(bf, nt < 2 ? OFF_LX : OFF_GG);
        const int cb = (nt & 1) * 128;
#pragma unroll 1
        for (int it = 0; it < 8; ++it) {
            const int id = it * 256 + tid, r = id >> 4, c8 = (id & 15) * 8;
            float v[8];
#pragma unroll
            for (int j = 0; j < 8; ++j) { v[j] = T(r, c8 + j); if (nt >= 2) v[j] = gelu_tanh(v[j]); }
            store8(dst + (size_t)(t0 + r) * 256 + cb + c8, v);
        }
    } else if (nt < 10) {
        const bool isk = nt >= 7;
        const int g0 = (nt - (isk ? 7 : 4)) * 128;
        const float* gain = p.in[isk ? I_DKG : I_DQG] + l * 32;
        bf* dst = WSP(bf, isk ? OFF_DK : OFF_DQ);
#pragma unroll 1
        for (int it = 0; it < 8; ++it) {
            const int id = it * 256 + tid, r = id >> 4, c8 = (id & 15) * 8;
            float v[8], ss = 0.f;
#pragma unroll
            for (int j = 0; j < 8; ++j) { v[j] = T(r, c8 + j); ss += v[j] * v[j]; }
            ss += __shfl_xor(ss, 1); ss += __shfl_xor(ss, 2);
            const float rn = rsqrtf(ss * (1.f / 32.f) + EPS);
            const int col = g0 + c8, h = col >> 6, m = (col >> 5) & 1, d0 = col & 31;
#pragma unroll
            for (int j = 0; j < 8; ++j) v[j] = v[j] * rn * gain[d0 + j];
            store8(dst + ((size_t)((b * 6 + h) * 2 + m) * S + s0 + r) * 32 + d0, v);
        }
    } else if (nt < 13) {
        const int g0 = (nt - 10) * 128;
        bf* dst = WSP(bf, OFF_DVT);
#pragma unroll 1
        for (int it = 0; it < 8; ++it) {
            const int id = it * 256 + tid, c = id & 127, rc = id >> 7;
            float v[8];
#pragma unroll
            for (int j = 0; j < 8; ++j) v[j] = T(8 * rc + j, c);
            const int col = g0 + c, h = col >> 6, d = col & 63;
            store8(dst + ((size_t)(b * 6 + h) * 64 + d) * S + s0 + 8 * rc, v);
        }
    } else {
#pragma unroll 1
        for (int it = 0; it < 8; ++it) {
            const int id = it * 256 + tid, r = id >> 4, c8 = (id & 15) * 8;
            float v[8];
#pragma unroll
            for (int j = 0; j < 8; ++j) v[j] = T(r, c8 + j);
            if (nt == 13) store8(WSP(bf, OFF_CQ) + (size_t)(t0 + r) * 192 + c8, v);
            else if (nt == 14) {
                if (c8 < 64) store8(WSP(bf, OFF_CQ) + (size_t)(t0 + r) * 192 + 128 + c8, v);
                else if (c8 < 96) store8(WSP(bf, OFF_KR) + (size_t)(t0 + r) * 32 + (c8 - 64), v);
            } else store8(WSP(bf, OFF_CKV) + (size_t)(t0 + r) * 128 + c8, v);
        }
    }
}

DI void ph_p1_route_naive(const Params& p, int l, int chunk, int bid, int nb) {
    for (int u = bid; u < 512; u += nb) {
    const int mt = u / 4, ntl = u % 4;
    const float* C = WSP(float, OFF_MIX) + (size_t)mt * 128 * 512 + ntl * 128;
    route_tile(p, l, mt, chunk * 4 + ntl, [=](int r, int c) { return C[(size_t)r * 512 + c]; });
    }
}

DI void lru_tile(const Params& p, int l, int b, int tile, int mode, float* sXC  , float* sY  ) {
    const int c = threadIdx.x, blk = c >> 6, j = c & 63, lane = c & 63, wv = c >> 6;
    const bf* LX = WSP(bf, OFF_LX); const bf* GGp = WSP(bf, OFF_GG);
    const float cw0 = p.in[I_CONVW][(l * 4 + 0) * 256 + c], cw1 = p.in[I_CONVW][(l * 4 + 1) * 256 + c], cw2 = p.in[I_CONVW][(l * 4 + 2) * 256 + c],
                cw3 = p.in[I_CONVW][(l * 4 + 3) * 256 + c], cb = p.in[I_CONVB][l * 256 + c];
    const float ba = p.in[I_BA][l * 256 + c], bx = p.in[I_BX][l * 256 + c];
    const float lam = p.in[I_LAM][l * 256 + c];
    const float c8 = 8.f * log1pf(__expf(-lam));
    const uint4* wa4 = (const uint4*)(WSP(bf, OFF_WAX) + (size_t)(((l * 2 + 0) * 4 + blk) * 64 + j) * 64);
    const uint4* wx4 = (const uint4*)(WSP(bf, OFF_WAX) + (size_t)(((l * 2 + 1) * 4 + blk) * 64 + j) * 64);
    const int tb = b * S + tile * 64;
    float xm3 = 0.f, xm2 = 0.f, xm1 = 0.f;
    if (tile > 0) { xm3 = bf2f(LX[(size_t)(tb - 3) * 256 + c]); xm2 = bf2f(LX[(size_t)(tb - 2) * 256 + c]); xm1 = bf2f(LX[(size_t)(tb - 1) * 256 + c]); }
    float h = 0.f, aprod = 1.f;
    if (mode == 1) {
        const float* TOT = WSP(float, OFF_TOT) + (size_t)(b * 64) * 512;
        for (int i = 0; i < tile; ++i) h = TOT[i * 512 + c] * h + TOT[i * 512 + 256 + c];
    }
#pragma unroll 1
    for (int g = 0; g < 4; ++g) {
#pragma unroll 1
        for (int tt = 0; tt < 16; ++tt) {
            const float x0 = bf2f(LX[(size_t)(tb + g * 16 + tt) * 256 + c]);
            sXC[tt * 256 + c] = cw0 * xm3 + cw1 * xm2 + cw2 * xm1 + cw3 * x0 + cb;
            xm3 = xm2; xm2 = xm1; xm1 = x0;
        }
        __syncthreads();
#pragma unroll 1
        for (int tt = 0; tt < 16; ++tt) {
            float ra = ba, rx = bx;
            const float* xr = sXC + tt * 256 + blk * 64;
#pragma unroll
            for (int i = 0; i < 8; ++i) {
                const uint4 wa = wa4[i], wx = wx4[i];
                const unsigned a4[4] = {wa.x, wa.y, wa.z, wa.w}, x4[4] = {wx.x, wx.y, wx.z, wx.w};
#pragma unroll
                for (int q = 0; q < 4; ++q) {
                    const float v0 = xr[i * 8 + q * 2], v1 = xr[i * 8 + q * 2 + 1];
                    ra += v0 * lo16(a4[q]) + v1 * hi16(a4[q]);
                    rx += v0 * lo16(x4[q]) + v1 * hi16(x4[q]);
                }
            }
            const float r = sigmoidf_(ra), ig = sigmoidf_(rx);
            const float log_a = -c8 * r;
            const float a = __expf(log_a);
            const float bb = sqrtf(-expm1f(2.f * log_a)) * ig * sXC[tt * 256 + c];
            h = a * h + bb; aprod *= a;
            if (mode == 1) sY[tt * 256 + c] = h * bf2f(GGp[(size_t)(tb + g * 16 + tt) * 256 + c]);
        }
        __syncthreads();
        if (mode == 1) {
            bf* MIX = WSP(bf, OFF_MIX);
#pragma unroll 1
            for (int q = 0; q < 4; ++q) {
                const int tt = wv * 4 + q;
                const float y0 = sY[tt * 256 + lane], y1 = sY[tt * 256 + 64 + lane], y2 = sY[tt * 256 + 128 + lane], y3 = sY[tt * 256 + 192 + lane];
                const float rn = rsqrtf(wave_sum(y0 * y0 + y1 * y1 + y2 * y2 + y3 * y3) * (1.f / 256.f) + EPS);
                bf* m = MIX + (size_t)(tb + g * 16 + tt) * 1024 + lane;
                m[0] = f2bf(y0 * rn); m[64] = f2bf(y1 * rn); m[128] = f2bf(y2 * rn); m[192] = f2bf(y3 * rn);
            }
            __syncthreads();
        }
    }
    if (mode == 0) {
        float* TOT = WSP(float, OFF_TOT) + (size_t)(b * 64 + tile) * 512;
        TOT[c] = aprod; TOT[256 + c] = h;
    }
}

DI void ph_lru(const Params& p, int l, int mode, int bid, int nb, unsigned char* smem) {
    float* sXC = (float*)smem; float* sY = sXC + 16 * 256;
    for (int u = bid; u < 256; u += nb) lru_tile(p, l, u >> 6, u & 63, mode, sXC, sY);
}

DI void ph_mla_up_naive(const Params& p, int l, int bid, int nb, unsigned char* smem) {
    float (*sCQ)[192] = (float (*)[192])smem; float (*sCKV)[128] = (float (*)[128])(smem + 4 * 192 * 4);
    float (*sQ)[576] = (float (*)[576])(smem + 4 * 320 * 4); float (*sKV)[768] = (float (*)[768])(smem + 4 * 896 * 4);
    const int tid = threadIdx.x, lane = tid & 63, wv = tid >> 6;
    for (int u = bid; u < NT / 4; u += nb) {
    const int t0 = u * 4;
    {
        const int t = t0 + wv;
        const bf* cq = WSP(bf, OFF_CQ) + (size_t)t * 192; const bf* ckv = WSP(bf, OFF_CKV) + (size_t)t * 128;
        float a0 = bf2f(cq[lane]), a1 = bf2f(cq[lane + 64]), a2 = bf2f(cq[lane + 128]);
        float ss = wave_sum(a0 * a0 + a1 * a1 + a2 * a2);
        float rn = rsqrtf(ss * (1.f / 192.f) + EPS);
        sCQ[wv][lane] = a0 * rn; sCQ[wv][lane + 64] = a1 * rn; sCQ[wv][lane + 128] = a2 * rn;
        float b0 = bf2f(ckv[lane]), b1 = bf2f(ckv[lane + 64]);
        ss = wave_sum(b0 * b0 + b1 * b1);
        rn = rsqrtf(ss * (1.f / 128.f) + EPS);
        sCKV[wv][lane] = b0 * rn; sCKV[wv][lane + 64] = b1 * rn;
    }
    __syncthreads();
    const bf* WUQ = WSP(bf, OFF_WUQ) + (size_t)l * 576 * 192;
    const bf* WUKV = WSP(bf, OFF_WUKV) + (size_t)l * 768 * 128;
    for (int n = tid; n < 576; n += 256) {
        float acc[4] = {0.f, 0.f, 0.f, 0.f};
        for (int k = 0; k < 192; ++k) { const float w = bf2f(WUQ[(size_t)n * 192 + k]);
#pragma unroll
            for (int q = 0; q < 4; ++q) acc[q] += sCQ[q][k] * w; }
#pragma unroll
        for (int q = 0; q < 4; ++q) sQ[q][n] = acc[q];
    }
    for (int n = tid; n < 768; n += 256) {
        float acc[4] = {0.f, 0.f, 0.f, 0.f};
        for (int k = 0; k < 128; ++k) { const float w = bf2f(WUKV[(size_t)n * 128 + k]);
#pragma unroll
            for (int q = 0; q < 4; ++q) acc[q] += sCKV[q][k] * w; }
#pragma unroll
        for (int q = 0; q < 4; ++q) sKV[q][n] = acc[q];
    }
    __syncthreads();
    if (tid < 48) {
        const int tok = tid / 12, h = (tid % 12) >> 1, which = tid & 1;
        const int t = t0 + tok, b = t >> 12, s = t & 4095;
        const float* rope = WSP(float, OFF_ROPE) + s * 32;
        const float* gain = p.in[which ? I_MKG : I_MQG] + l * 96;
        const bf* kr = WSP(bf, OFF_KR) + (size_t)t * 32;
        bf* dst = WSP(bf, which ? OFF_MK : OFF_MQ) + ((size_t)(b * 6 + h) * S + s) * 96;
        float ss = 0.f;
        for (int d = 0; d < 96; ++d) {
            const float v = which ? (d < 64 ? sKV[tok][h * 128 + d] : bf2f(kr[d - 64])) : sQ[tok][h * 96 + d];
            ss += v * v;
        }
        const float rn = rsqrtf(ss * (1.f / 96.f) + EPS);
        for (int d = 0; d < 64; ++d) {
            const float v = which ? sKV[tok][h * 128 + d] : sQ[tok][h * 96 + d];
            dst[d] = f2bf(v * rn * gain[d]);
        }
        for (int i = 0; i < 16; ++i) {
            const float x1 = (which ? bf2f(kr[i]) : sQ[tok][h * 96 + 64 + i]) * rn * gain[64 + i];
            const float x2 = (which ? bf2f(kr[16 + i]) : sQ[tok][h * 96 + 80 + i]) * rn * gain[80 + i];
            const float cs = rope[i], sn = rope[16 + i];
            dst[64 + i] = f2bf(x1 * cs - x2 * sn);
            dst[80 + i] = f2bf(x1 * sn + x2 * cs);
        }
    }
    bf* mvt = WSP(bf, OFF_MVT);
    for (int e = tid; e < 4 * 384; e += 256) {
        const int tok = e / 384, r = e % 384, h = r >> 6, d = r & 63;
        const int t = t0 + tok, b = t >> 12, s = t & 4095;
        mvt[((size_t)(b * 6 + h) * 64 + d) * S + s] = f2bf(sKV[tok][h * 128 + 64 + d]);
    }
    __syncthreads();
    }
}

DI float rdlane(float v, int j) { return __int_as_float(__builtin_amdgcn_readlane(__float_as_int(v), j)); }

DI void ph_diff_attn_naive(const Params& p, int l, int bid, int nb) {
    for (int u = bid; u < NB * 6 * S / 4; u += nb) {
    const int lane = threadIdx.x & 63, gw = u * 4 + (threadIdx.x >> 6);
    const int q = gw & 4095, bh = gw >> 12, h = bh % 6, b = bh / 6;
    const bf* DQ = WSP(bf, OFF_DQ); const bf* DK = WSP(bf, OFF_DK); const bf* DVT = WSP(bf, OFF_DVT);
    float lam;
    {
        float d1 = 0.f, d2 = 0.f;
        for (int i = 0; i < 32; ++i) { d1 += p.in[I_LQ1][l * 32 + i] * p.in[I_LK1][l * 32 + i]; d2 += p.in[I_LQ2][l * 32 + i] * p.in[I_LK2][l * 32 + i]; }
        lam = expf(d1) - expf(d2) + lambda_init(l);
    }
    const float slope = exp2f(-8.f * (float)(h + 1) / 6.f);
    const float scale = 0.17677669529663687f;
    float q0[32], q1[32];
    {
        const bf* a = DQ + ((size_t)(bh * 2 + 0) * S + q) * 32; const bf* c = DQ + ((size_t)(bh * 2 + 1) * S + q) * 32;
#pragma unroll
        for (int d = 0; d < 32; ++d) { q0[d] = bf2f(a[d]); q1[d] = bf2f(c[d]); }
    }
    float m0 = -INFINITY, m1 = -INFINITY, l0 = 0.f, l1 = 0.f, o0 = 0.f, o1 = 0.f;
    const int nkb = (q >> 6) + 1;
    for (int kb = 0; kb < nkb; ++kb) {
        const int k = kb * 64 + lane;
        const uint4* ka = (const uint4*)(DK + ((size_t)(bh * 2 + 0) * S + k) * 32);
        const uint4* kc = (const uint4*)(DK + ((size_t)(bh * 2 + 1) * S + k) * 32);
        float s0 = 0.f, s1 = 0.f;
#pragma unroll
        for (int i = 0; i < 4; ++i) {
            const uint4 u = ka[i], w = kc[i];
            const unsigned uu[4] = {u.x, u.y, u.z, u.w}, ww[4] = {w.x, w.y, w.z, w.w};
#pragma unroll
            for (int e = 0; e < 4; ++e) {
                s0 += q0[i * 8 + e * 2] * lo16(uu[e]) + q0[i * 8 + e * 2 + 1] * hi16(uu[e]);
                s1 += q1[i * 8 + e * 2] * lo16(ww[e]) + q1[i * 8 + e * 2 + 1] * hi16(ww[e]);
            }
        }
        const float bias = -slope * fabsf((float)(q - k));
        s0 = s0 * scale + bias; s1 = s1 * scale + bias;
        const float n0 = fmaxf(m0, wave_max(s0)), n1 = fmaxf(m1, wave_max(s1));
        const float a0 = __expf(m0 - n0), a1 = __expf(m1 - n1);
        const float p0 = __expf(s0 - n0), p1 = __expf(s1 - n1);
        l0 = l0 * a0 + p0; l1 = l1 * a1 + p1; o0 *= a0; o1 *= a1; m0 = n0; m1 = n1;
        const uint4* vp = (const uint4*)(DVT + ((size_t)bh * 64 + lane) * S + kb * 64);
        uint4 v[8];
#pragma unroll
        for (int i = 0; i < 8; ++i) v[i] = vp[i];
#pragma unroll
        for (int i = 0; i < 8; ++i) {
            const unsigned vv[4] = {v[i].x, v[i].y, v[i].z, v[i].w};
#pragma unroll
            for (int e = 0; e < 4; ++e) {
                const int j = i * 8 + e * 2;
                const float va = lo16(vv[e]), vb = hi16(vv[e]);
                o0 += rdlane(p0, j) * va + rdlane(p0, j + 1) * vb;
                o1 += rdlane(p1, j) * va + rdlane(p1, j + 1) * vb;
            }
        }
    }
    const float L0 = wave_sum(l0), L1 = wave_sum(l1);
    const float o = o0 / L0 - lam * (o1 / L1);
    const float ss = wave_sum(o * o);
    WSP(bf, OFF_MIX)[(size_t)(b * S + q) * 1024 + 256 + h * 64 + lane] = f2bf(o * rsqrtf(ss * (1.f / 64.f) + EPS));
    }
}

DI void ph_mla_attn_naive(const Params& p, int l, int bid, int nb) {
    for (int u = bid; u < NB * 6 * S / 4; u += nb) {
    const int lane = threadIdx.x & 63, gw = u * 4 + (threadIdx.x >> 6);
    const int q = gw & 4095, bh = gw >> 12, h = bh % 6, b = bh / 6;
    const bf* MQ = WSP(bf, OFF_MQ); const bf* MK = WSP(bf, OFF_MK); const bf* MVT = WSP(bf, OFF_MVT);
    const float scale = 0.10206207261596575f;
    float qv[96];
    {
        const bf* a = MQ + ((size_t)bh * S + q) * 96;
#pragma unroll
        for (int d = 0; d < 96; ++d) qv[d] = bf2f(a[d]);
    }
    float m0 = -INFINITY, l0 = 0.f, o0 = 0.f;
    const int nkb = (q >> 6) + 1;
    for (int kb = 0; kb < nkb; ++kb) {
        const int k = kb * 64 + lane;
        const uint4* ka = (const uint4*)(MK + ((size_t)bh * S + k) * 96);
        float s0 = 0.f;
#pragma unroll
        for (int i = 0; i < 12; ++i) {
            const uint4 u = ka[i];
            const unsigned uu[4] = {u.x, u.y, u.z, u.w};
#pragma unroll
            for (int e = 0; e < 4; ++e) s0 += qv[i * 8 + e * 2] * lo16(uu[e]) + qv[i * 8 + e * 2 + 1] * hi16(uu[e]);
        }
        s0 *= scale;
        const float n0 = fmaxf(m0, wave_max(s0));
        const float a0 = __expf(m0 - n0), p0 = __expf(s0 - n0);
        l0 = l0 * a0 + p0; o0 *= a0; m0 = n0;
        const uint4* vp = (const uint4*)(MVT + ((size_t)bh * 64 + lane) * S + kb * 64);
        uint4 v[8];
#pragma unroll
        for (int i = 0; i < 8; ++i) v[i] = vp[i];
#pragma unroll
        for (int i = 0; i < 8; ++i) {
            const unsigned vv[4] = {v[i].x, v[i].y, v[i].z, v[i].w};
#pragma unroll
            for (int e = 0; e < 4; ++e) {
                const int j = i * 8 + e * 2;
                o0 += rdlane(p0, j) * lo16(vv[e]) + rdlane(p0, j + 1) * hi16(vv[e]);
            }
        }
    }
    const float o = o0 / wave_sum(l0);
    const float ss = wave_sum(o * o);
    const int t = b * S + q;
    WSP(bf, OFF_MIX)[(size_t)t * 1024 + 640 + h * 64 + lane] = f2bf(o);
    if (lane == 0) WSP(float, OFF_SSQM)[t * 8 + h] = ss;
    }
}

DI void ph_mla_norm_fix(const Params& p, int bid, int nb) {
    for (int gid = bid * 256 + threadIdx.x; gid < NT * 48; gid += nb * 256) {
    const int t = gid / 48, c8 = (gid % 48) * 8;
    const float* sq = WSP(float, OFF_SSQM) + t * 8;
    const float rn = rsqrtf((sq[0] + sq[1] + sq[2] + sq[3] + sq[4] + sq[5]) * (1.f / 384.f) + EPS);
    bf* m = WSP(bf, OFF_MIX) + (size_t)t * 1024 + 640 + c8;
    float v[8];
#pragma unroll
    for (int j = 0; j < 8; ++j) v[j] = bf2f(m[j]) * rn;
    store8(m, v);
    }
}

DI void ph_p4_gemm_naive(const Params& p, int l, int bid, int nb, unsigned char* smem) {
    float* sA = (float*)smem; float* sB = sA + 16 * 68;
    if (bid == 0 && threadIdx.x < 32) WSP(int, OFF_CTL)[CTL_CNT + threadIdx.x] = 0;
    for (int u = bid; u < 4096; u += nb) {
    const int mt = u / 16, nt = u % 16;
    const bf* A = WSP(bf, OFF_MIX) + (size_t)mt * 64 * D;
    const bf* Bt = WSP(bf, OFF_WOUT) + (size_t)l * 1024 * 1024 + (size_t)(nt * 64) * 1024;
    const float* xin = (l == 0 ? p.in[I_X] : WSP(float, OFF_XFA)) + (size_t)mt * 64 * D + nt * 64;
    float* x1 = p.out + (size_t)mt * 64 * D + nt * 64;
    bf* xb1 = WSP(bf, OFF_XB) + (size_t)mt * 64 * D + nt * 64;
    const float* g2 = p.in[I_N2G] + l * 1024 + nt * 64;
    ngemm_tile<true>(1024, [=](int r, int k) { return bf2f(A[(size_t)r * D + k]); }, [=](int k, int c) { return bf2f(Bt[(size_t)c * 1024 + k]); },
               [=](int r, int c, float v) { const float x = xin[(size_t)r * D + c] + v; x1[(size_t)r * D + c] = x; xb1[(size_t)r * D + c] = f2bf(x * g2[c]); }, sA, sB);
    }
}

DI void ph_router(const Params& p, int l, int bid, int nb) {
    const int lane = threadIdx.x & 63, gw = bid * 4 + (threadIdx.x >> 6), nw = nb * 4;
    const float* WR = WSP(float, OFF_WR) + (size_t)l * 36 * 1024;
    int* cnt = WSP(int, OFF_CTL) + CTL_CNT;
    int* list = WSP(int, OFF_LIST);
    float* gatew = WSP(float, OFF_GATEW);
    for (int t = gw; t < NT; t += nw) {
        const float* x = p.out + (size_t)t * D;
        float4 xv[4]; float ss = 0.f;
#pragma unroll
        for (int i = 0; i < 4; ++i) { xv[i] = *(const float4*)(x + lane * 4 + 256 * i); ss += xv[i].x * xv[i].x + xv[i].y * xv[i].y + xv[i].z * xv[i].z + xv[i].w * xv[i].w; }
        ss = wave_sum(ss);
        const float rinv = rsqrtf(ss * (1.f / 1024.f) + EPS);
        float lg[4];
#pragma unroll
        for (int j = 0; j < 4; ++j) {
            float a = 0.f;
#pragma unroll
            for (int i = 0; i < 4; ++i) { const float4 w = *(const float4*)(WR + (size_t)j * 1024 + lane * 4 + 256 * i); a += xv[i].x * w.x + xv[i].y * w.y + xv[i].z * w.z + xv[i].w * w.w; }
            lg[j] = wave_sum(a) * rinv + p.in[I_RGB][l * 4 + j];
        }
        int g = 0; float gm = lg[0];
#pragma unroll
        for (int j = 1; j < 4; ++j) if (lg[j] > gm) { gm = lg[j]; g = j; }
        float gs = 0.f;
#pragma unroll
        for (int j = 0; j < 4; ++j) gs += __expf(lg[j] - gm);
        const float pg_top = 1.f / gs;
        float e[8];
#pragma unroll
        for (int j = 0; j < 8; ++j) {
            const float* wrow = WR + (size_t)(4 + g * 8 + j) * 1024;
            float a = 0.f;
#pragma unroll
            for (int i = 0; i < 4; ++i) { const float4 w = *(const float4*)(wrow + lane * 4 + 256 * i); a += xv[i].x * w.x + xv[i].y * w.y + xv[i].z * w.z + xv[i].w * w.w; }
            e[j] = wave_sum(a) * rinv + p.in[I_REB][l * 32 + g * 8 + j];
        }
        int i1 = 0; float v1 = e[0];
#pragma unroll
        for (int i = 1; i < 8; ++i) if (e[i] > v1) { v1 = e[i]; i1 = i; }
        int i2 = -1; float v2 = -INFINITY;
#pragma unroll
        for (int i = 0; i < 8; ++i) if (i != i1 && e[i] > v2) { v2 = e[i]; i2 = i; }
        const float p1 = 1.f, p2 = __expf(v2 - v1);
        const float g1 = pg_top * p1 / (p1 + p2), g2 = pg_top * p2 / (p1 + p2);
        if (lane == 0) {
            const int e1 = g * 8 + i1, e2 = g * 8 + i2;
            const int pos1 = atomicAdd(&cnt[e1], 1); list[e1 * 16384 + pos1] = t * 2;
            const int pos2 = atomicAdd(&cnt[e2], 1); list[e2 * 16384 + pos2] = t * 2 + 1;
            gatew[t * 2] = g1; gatew[t * 2 + 1] = g2;
            WSP(float, OFF_RINV2)[t] = rinv;
        }
    }
}

DI void ph_moe_up_naive(const Params& p, int l, int bid, int nb, unsigned char* smem) {
    float* sA = (float*)smem; float* sB = sA + 16 * 68; int* sTok = (int*)(sB + 16 * 68);
    for (int u = bid; u < 32 * 256 * 8; u += nb) {
    const int nt = u & 7, rb = (u >> 3) & 255, e = u >> 11;
    const int* cnt = WSP(int, OFF_CTL) + CTL_CNT;
    const int n = cnt[e];
    if (rb * 64 >= n) continue;
    int base = 0; for (int i = 0; i < e; ++i) base += cnt[i];
    if (threadIdx.x < 64) { const int r = rb * 64 + threadIdx.x; sTok[threadIdx.x] = r < n ? (WSP(int, OFF_LIST)[e * 16384 + r] >> 1) : -1; }
    __syncthreads();
    const bf* XB = WSP(bf, OFF_XB);
    const float* W = (nt < 4 ? p.in[I_W1] : p.in[I_W3]) + (size_t)(l * 32 + e) * 1024 * 256 + (nt & 3) * 64;
    const float* rinv2 = WSP(float, OFF_RINV2);
    float* H = WSP(float, OFF_H13) + (size_t)(base + rb * 64) * 512 + nt * 64;
    const int* tk = sTok;
    ngemm_tile<false>(1024, [=](int r, int k) { const int t = tk[r]; return t >= 0 ? bf2f(XB[(size_t)t * D + k]) : 0.f; }, [=](int k, int c) { return bf2f(f2bf(W[(size_t)k * 256 + c])); },
               [=](int r, int c, float v) { const int t = tk[r]; if (t >= 0) H[(size_t)r * 512 + c] = v * rinv2[t]; }, sA, sB);
    }
}

DI void ph_moe_act_naive(const Params& p, int bid, int nb) {
    for (int gid = bid * 256 + threadIdx.x; gid < 32768 * 32; gid += nb * 256) {
    const int row = gid >> 5, c8 = (gid & 31) * 8;
    const float* H = WSP(float, OFF_H13) + (size_t)row * 512;
    float v[8];
#pragma unroll
    for (int j = 0; j < 8; ++j) { const float a = H[c8 + j], b = H[256 + c8 + j]; v[j] = a * sigmoidf_(a) * b; }
    store8(WSP(bf, OFF_ACT) + (size_t)row * 256 + c8, v);
    }
}

DI void ph_moe_down_naive(const Params& p, int l, int bid, int nb, unsigned char* smem) {
    float* sA = (float*)smem; float* sB = sA + 16 * 68; int* sEnt = (int*)(sB + 16 * 68);
    for (int u = bid; u < 32 * 256 * 16; u += nb) {
    const int nt = u & 15, rb = (u >> 4) & 255, e = u >> 12;
    const int* cnt = WSP(int, OFF_CTL) + CTL_CNT;
    const int n = cnt[e];
    if (rb * 64 >= n) continue;
    int base = 0; for (int i = 0; i < e; ++i) base += cnt[i];
    if (threadIdx.x < 64) { const int r = rb * 64 + threadIdx.x; sEnt[threadIdx.x] = r < n ? WSP(int, OFF_LIST)[e * 16384 + r] : -1; }
    __syncthreads();
    const bf* A = WSP(bf, OFF_ACT) + (size_t)(base + rb * 64) * 256;
    const float* W = p.in[I_W2] + (size_t)(l * 32 + e) * 256 * 1024 + nt * 64;
    const float* gatew = WSP(float, OFF_GATEW);
    bf* Y = WSP(bf, OFF_Y);
    const int* en = sEnt;
    ngemm_tile<false>(256, [=](int r, int k) { return en[r] >= 0 ? bf2f(A[(size_t)r * 256 + k]) : 0.f; }, [=](int k, int c) { return bf2f(f2bf(W[(size_t)k * 1024 + c])); },
               [=](int r, int c, float v) { const int en_ = en[r]; if (en_ >= 0) Y[((size_t)(en_ & 1) * NT + (en_ >> 1)) * D + nt * 64 + c] = f2bf(v * gatew[en_]); }, sA, sB);
    }
}

DI void ph_combine(const Params& p, int last, int bid, int nb) {
    const int lane = threadIdx.x & 63, gw = bid * 4 + (threadIdx.x >> 6), nw = nb * 4;
    const bf* Y = WSP(bf, OFF_Y);
    float* xo = last ? p.out : WSP(float, OFF_XFA);
    bf* xb = WSP(bf, OFF_XB);
    for (int t = gw; t < NT; t += nw) {
        float ss = 0.f;
#pragma unroll
        for (int i = 0; i < 2; ++i) {
            const int c = (lane + 64 * i) * 8;
            const float4 a = *(const float4*)(p.out + (size_t)t * D + c), b = *(const float4*)(p.out + (size_t)t * D + c + 4);
            const uint4 y0 = *(const uint4*)(Y + (size_t)t * D + c), y1 = *(const uint4*)(Y + ((size_t)NT + t) * D + c);
            float v[8] = {a.x, a.y, a.z, a.w, b.x, b.y, b.z, b.w};
            const unsigned u0[4] = {y0.x, y0.y, y0.z, y0.w}, u1[4] = {y1.x, y1.y, y1.z, y1.w};
#pragma unroll
            for (int e = 0; e < 4; ++e) { v[2 * e] += lo16(u0[e]) + lo16(u1[e]); v[2 * e + 1] += hi16(u0[e]) + hi16(u1[e]); }
#pragma unroll
            for (int j = 0; j < 8; ++j) ss += v[j] * v[j];
            *(float4*)(xo + (size_t)t * D + c) = make_float4(v[0], v[1], v[2], v[3]);
            *(float4*)(xo + (size_t)t * D + c + 4) = make_float4(v[4], v[5], v[6], v[7]);
            if (!last) store8(xb + (size_t)t * D + c, v);
        }
        ss = wave_sum(ss);
        if (!last && lane == 0) WSP(float, OFF_RINV1)[t] = rsqrtf(ss * (1.f / 1024.f) + EPS);
    }
}

constexpr int SMEM_BYTES = 32768;
#define GRID_SYNC() grid.sync()

__global__ void __launch_bounds__(256) mega_fwd(Params p) {
    extern __shared__ __attribute__((aligned(16))) unsigned char smem[];
    cg::grid_group grid = cg::this_grid();
    const int bid = blockIdx.x, nb = gridDim.x;
    ph_prep_weights(p, bid, nb, smem);
    ph_prep_misc(p, bid, nb);
    ph_prep_x(p, bid, nb);
    GRID_SYNC();
    for (int l = 0; l < 2; ++l) {
        for (int ch = 0; ch < 4; ++ch) {
            ph_p1_gemm_naive(p, l, ch, bid, nb, smem);
            GRID_SYNC();
            ph_p1_route_naive(p, l, ch, bid, nb);
            GRID_SYNC();
        }
        ph_lru(p, l, 0, bid, nb, smem);
        ph_mla_up_naive(p, l, bid, nb, smem);
        GRID_SYNC();
        ph_lru(p, l, 1, bid, nb, smem);
        ph_diff_attn_naive(p, l, bid, nb);
        ph_mla_attn_naive(p, l, bid, nb);
        GRID_SYNC();
        ph_mla_norm_fix(p, bid, nb);
        GRID_SYNC();
        ph_p4_gemm_naive(p, l, bid, nb, smem);
        GRID_SYNC();
        ph_router(p, l, bid, nb);
        GRID_SYNC();
        ph_moe_up_naive(p, l, bid, nb, smem);
        GRID_SYNC();
        ph_moe_act_naive(p, bid, nb);
        GRID_SYNC();
        ph_moe_down_naive(p, l, bid, nb, smem);
        GRID_SYNC();
        ph_combine(p, l == 1, bid, nb);
        GRID_SYNC();
    }
}

extern "C" void kernel_launch(void* const* d_in, const int* in_sizes, int n_in, void* d_out, int out_size, void* d_ws, size_t ws_size, hipStream_t stream) {
    if (n_in != N_IN || ws_size < WS_TOTAL || out_size != NT * D) { fprintf(stderr, "kernel_launch: bad sizes n_in %d ws %zu (need %zu) out %d\n", n_in, ws_size, (size_t)WS_TOTAL, out_size); return; }
    static int grid_blocks = 0;
    if (!grid_blocks) {
        int dev = 0, cus = 0, per_cu = 0;
        (void)hipGetDevice(&dev);
        (void)hipDeviceGetAttribute(&cus, hipDeviceAttributeMultiprocessorCount, dev);
        (void)hipFuncSetAttribute((const void*)mega_fwd, hipFuncAttributeMaxDynamicSharedMemorySize, SMEM_BYTES);
        (void)hipOccupancyMaxActiveBlocksPerMultiprocessor(&per_cu, (const void*)mega_fwd, 256, SMEM_BYTES);
        if (per_cu < 1) { fprintf(stderr, "kernel_launch: occupancy query says %d blocks per CU\n", per_cu); return; }
        if (per_cu > 2) per_cu = 2;
        grid_blocks = cus * per_cu;
    }
    Params p{};
    for (int i = 0; i < N_IN; ++i) p.in[i] = (const float*)d_in[i];
    p.out = (float*)d_out; p.ws = (unsigned char*)d_ws;
    void* args[] = {&p};
    hipError_t e = hipLaunchCooperativeKernel((const void*)mega_fwd, dim3(grid_blocks), dim3(256), args, SMEM_BYTES, stream);
    if (e != hipSuccess) fprintf(stderr, "cooperative launch failed: %s (grid %d)\n", hipGetErrorString(e), grid_blocks);
}
```

```cpp
#include <hip/hip_runtime.h>
#include <hip/hip_cooperative_groups.h>
namespace cg = cooperative_groups;
#include <cstdio>
#include <cstdint>

#define DI __device__ __forceinline__
typedef unsigned short bf;

constexpr int NB = 4, S = 4096, D = 1024, NT = NB * S, NPROJ = 2048;
constexpr float EPS = 1e-6f;
enum { I_X = 0, I_N1G, I_WIN, I_CONVW, I_CONVB, I_WA, I_BA, I_WX, I_BX, I_LAM, I_LOUTG, I_DQG, I_DKG, I_LQ1, I_LK1, I_LQ2, I_LK2,
       I_SUBG, I_CQG, I_CKVG, I_WUQ, I_WUKV, I_MQG, I_MKG, I_MOUTG, I_WOUT, I_N2G, I_RGW, I_RGB, I_REW, I_REB, I_W1, I_W3, I_W2, N_IN };

struct Params { const float* in[N_IN]; float* out; unsigned char* ws; };

constexpr size_t AL(size_t x) { return (x + 255) & ~(size_t)255; }
constexpr size_t OFF_WIN = 0;
constexpr size_t OFF_WOUT = OFF_WIN + (size_t)2 * 2048 * 1024 * 2;
constexpr size_t OFF_WUQ = OFF_WOUT + (size_t)2 * 1024 * 1024 * 2;
constexpr size_t OFF_WUKV = OFF_WUQ + (size_t)2 * 768 * 192 * 2;
constexpr size_t OFF_WAX = OFF_WUKV + (size_t)2 * 768 * 128 * 2;
constexpr size_t OFF_WR = OFF_WAX + (size_t)2 * 2 * 4 * 64 * 64 * 2;
constexpr size_t OFF_ROPE = AL(OFF_WR + (size_t)2 * 36 * 1024 * 4);
constexpr size_t OFF_CTL = OFF_ROPE + (size_t)4096 * 32 * 4;
constexpr size_t OFF_RINV1 = OFF_CTL + 65536;
constexpr size_t OFF_RINV2 = OFF_RINV1 + (size_t)NT * 4;
constexpr size_t OFF_SSQM = OFF_RINV2 + (size_t)NT * 4;
constexpr size_t OFF_TOT = OFF_SSQM + (size_t)NT * 8 * 4;
constexpr size_t OFF_GATEW = OFF_TOT + (size_t)4 * 64 * 2 * 256 * 4;
constexpr size_t OFF_LIST = OFF_GATEW + (size_t)NT * 2 * 4;
constexpr size_t OFF_XFA = OFF_LIST + (size_t)32 * 16384 * 4;
constexpr size_t OFF_XB = OFF_XFA + (size_t)NT * D * 4;
constexpr size_t OFF_MIX = OFF_XB + (size_t)NT * D * 2;
constexpr size_t OFF_STAGE = OFF_MIX + (size_t)NT * D * 2;
constexpr size_t OFF_LX = OFF_STAGE;
constexpr size_t OFF_GG = OFF_LX + (size_t)NT * 256 * 2;
constexpr size_t OFF_DQ = OFF_GG + (size_t)NT * 256 * 2;
constexpr size_t OFF_DK = OFF_DQ + (size_t)NT * 384 * 2;
constexpr size_t OFF_DVT = OFF_DK + (size_t)NT * 384 * 2;
constexpr size_t OFF_CQ = OFF_DVT + (size_t)NT * 384 * 2;
constexpr size_t OFF_CKV = OFF_CQ + (size_t)NT * 192 * 2;
constexpr size_t OFF_KR = OFF_CKV + (size_t)NT * 128 * 2;
constexpr size_t OFF_MQ = OFF_KR + (size_t)NT * 32 * 2;
constexpr size_t OFF_MK = OFF_MQ + (size_t)NT * 576 * 2;
constexpr size_t OFF_MVT = OFF_MK + (size_t)NT * 576 * 2;
constexpr size_t OFF_STAGE_END = OFF_MVT + (size_t)NT * 384 * 2;
constexpr size_t OFF_Y = OFF_STAGE;
constexpr size_t OFF_ACT = OFF_Y + (size_t)2 * NT * D * 2;
constexpr size_t OFF_H13 = OFF_Y;
constexpr size_t WS_TOTAL = OFF_STAGE_END;
static_assert(OFF_ACT + (size_t)(32768 + 128) * 256 * 2 <= OFF_STAGE_END, "alias");
constexpr int CTL_CNT = 0;
constexpr int CTL_LAM = 72;
constexpr int CTL_Q = 64;

#define WSP(T, off) ((T*)(p.ws + (off)))

DI float bf2f(bf v) { return __uint_as_float(((unsigned)v) << 16); }
DI bf f2bf(float f) { unsigned u = __float_as_uint(f); u += 0x7fffu + ((u >> 16) & 1u); return (bf)(u >> 16); }
typedef __bf16 hwbf16x2 __attribute__((ext_vector_type(2)));
typedef float f32x2 __attribute__((ext_vector_type(2)));
DI unsigned pack2(float a, float b) { f32x2 v = {a, b}; return __builtin_bit_cast(unsigned, __builtin_convertvector(v, hwbf16x2)); }
DI float lo16(unsigned u) { return __uint_as_float(u << 16); }
DI float hi16(unsigned u) { return __uint_as_float(u & 0xffff0000u); }
DI float wave_sum(float v) { for (int o = 32; o > 0; o >>= 1) v += __shfl_xor(v, o); return v; }
DI float wave_max(float v) { for (int o = 32; o > 0; o >>= 1) v = fmaxf(v, __shfl_xor(v, o)); return v; }
DI float gelu_tanh(float x) { return 0.5f * x * (1.f + tanhf(0.7978845608028654f * (x + 0.044715f * x * x * x))); }
DI float sigmoidf_(float x) { return 1.f / (1.f + __expf(-x)); }
DI float lambda_init(int l) { return l == 0 ? 0.2f : 0.35550906757f; }
DI void store8(bf* dst, const float* v) { uint4 u; u.x = pack2(v[0], v[1]); u.y = pack2(v[2], v[3]); u.z = pack2(v[4], v[5]); u.w = pack2(v[6], v[7]); *(uint4*)dst = u; }

template <class SCOL, class GAIN>
DI void tr_tile(const float* src, int lds_, bf* dst, int K, int n0, int k0, SCOL scol, GAIN gain, float* tile) {
    const int tid = threadIdx.x;
    const int nn = tid & 63;
    const int sc = scol(n0 + nn);
#pragma unroll
    for (int i = 0; i < 16; ++i) {
        const int kk = (tid >> 6) + 4 * i;
        float v = 0.f;
        if (sc >= 0) v = src[(size_t)(k0 + kk) * lds_ + sc] * gain(k0 + kk);
        tile[kk * 65 + nn] = v;
    }
    __syncthreads();
#pragma unroll
    for (int i = 0; i < 2; ++i) {
        const int id = tid + 256 * i, n = id >> 3, kc = (id & 7) * 8;
        float v[8];
#pragma unroll
        for (int j = 0; j < 8; ++j) v[j] = tile[(kc + j) * 65 + n];
        store8(dst + (size_t)(n0 + n) * K + k0 + kc, v);
    }
    __syncthreads();
}

DI int win_col(int n) {
    if (n < 1856) return n;
    if (n < 1888) return 1984 + (n - 1856);
    if (n < 1920) return -1;
    return 1856 + (n - 1920);
}

constexpr int PW_WIN = 2 * 32 * 16;
constexpr int PW_WOUT = 2 * 16 * 16;
constexpr int PW_WUQ = 2 * 12 * 3;
constexpr int PW_WUKV = 2 * 12 * 2;
constexpr int PW_WAX = 2 * 2 * 4;
constexpr int PW_TOTAL = PW_WIN + PW_WOUT + PW_WUQ + PW_WUKV + PW_WAX;

DI void prep_weights_unit(const Params& p, int u, float* tile) {
    if (u < PW_WIN) {
        const int l = u / 512, r = u % 512, nt = r / 16, kt = r % 16;
        const float* g = p.in[I_N1G] + l * 1024;
        tr_tile(p.in[I_WIN] + (size_t)l * 1024 * 2016, 2016, WSP(bf, OFF_WIN) + (size_t)l * 2048 * 1024, 1024, nt * 64, kt * 64,
                [](int n) { return win_col(n); }, [g](int k) { return g[k]; }, tile);
        return;
    }
    u -= PW_WIN;
    if (u < PW_WOUT) {
        const int l = u / 256, r = u % 256, nt = r / 16, kt = r % 16;
        const float* g_lru = p.in[I_LOUTG] + l * 256; const float* g_sub = p.in[I_SUBG] + l * 64; const float* g_mla = p.in[I_MOUTG] + l * 384;
        const float li = 1.f - lambda_init(l);
        tr_tile(p.in[I_WOUT] + (size_t)l * 1024 * 1024, 1024, WSP(bf, OFF_WOUT) + (size_t)l * 1024 * 1024, 1024, nt * 64, kt * 64,
                [](int n) { return n; },
                [=](int k) { return k < 256 ? g_lru[k] : (k < 640 ? g_sub[(k - 256) & 63] * li : g_mla[k - 640]); }, tile);
        return;
    }
    u -= PW_WOUT;
    if (u < PW_WUQ) {
        const int l = u / 36, r = u % 36, nt = r / 3, kt = r % 3;
        const float* g = p.in[I_CQG] + l * 192;
        tr_tile(p.in[I_WUQ] + (size_t)l * 192 * 576, 576, WSP(bf, OFF_WUQ) + (size_t)l * 768 * 192, 192, nt * 64, kt * 64,
                [](int n) { return (n & 127) < 96 ? (n >> 7) * 96 + (n & 127) : -1; }, [g](int k) { return g[k]; }, tile);
        return;
    }
    u -= PW_WUQ;
    if (u < PW_WUKV) {
        const int l = u / 24, r = u % 24, nt = r / 2, kt = r % 2;
        const float* g = p.in[I_CKVG] + l * 128;
        tr_tile(p.in[I_WUKV] + (size_t)l * 128 * 768, 768, WSP(bf, OFF_WUKV) + (size_t)l * 768 * 128, 128, nt * 64, kt * 64,
                [](int n) { return n; }, [g](int k) { return g[k]; }, tile);
        return;
    }
    u -= PW_WUKV;
    {
        const int l = u / 8, which = (u / 4) & 1, blk = u & 3;
        const float* src = (which ? p.in[I_WX] : p.in[I_WA]) + (size_t)(l * 4 + blk) * 4096;
        tr_tile(src, 64, WSP(bf, OFF_WAX) + (size_t)((l * 2 + which) * 4 + blk) * 4096, 64, 0, 0,
                [](int n) { return n; }, [](int) { return 1.f; }, tile);
    }
}

DI void ph_prep_weights(const Params& p, int bid, int nb, unsigned char* smem) {
    float* tile = (float*)smem;
    for (int u = bid; u < PW_TOTAL; u += nb) prep_weights_unit(p, u, tile);
}

DI void ph_prep_misc(const Params& p, int bid, int nb) {
    const int gid = bid * 256 + threadIdx.x, gsz = nb * 256;
    float* wr = WSP(float, OFF_WR);
    for (int i = gid; i < 2 * 36 * 1024; i += gsz) {
        const int l = i / (36 * 1024), r = i % (36 * 1024), j = r / 1024, k = r % 1024;
        const float g = p.in[I_N2G][l * 1024 + k];
        const float w = j < 4 ? p.in[I_RGW][(size_t)(l * 1024 + k) * 4 + j] : p.in[I_REW][(size_t)(l * 1024 + k) * 32 + (j - 4)];
        wr[i] = w * g;
    }
    float* rope = WSP(float, OFF_ROPE);
    for (int i = gid; i < 4096 * 16; i += gsz) {
        const int s = i >> 4, f = i & 15;
        const float inv_freq = (float)exp2(-(double)f / 16.0 * 13.287712379549449);
        const float angf = (float)s * inv_freq;
        double a = (double)angf;
        const double twopi = 6.283185307179586476925;
        a -= twopi * rint(a / twopi);
        const double hh = 0.5 * a, h2 = hh * hh;
        double sn = 1.0, cs = 1.0, ts = 1.0, tc = 1.0;
#pragma unroll
        for (int n = 1; n <= 10; ++n) {
            tc *= -h2 / (double)((2 * n - 1) * (2 * n));
            ts *= -h2 / (double)((2 * n) * (2 * n + 1));
            cs += tc; sn += ts;
        }
        sn *= hh;
        rope[s * 32 + f] = (float)(cs * cs - sn * sn);
        rope[s * 32 + 16 + f] = (float)(2.0 * sn * cs);
    }
    if (gid < 32) WSP(int, OFF_CTL)[CTL_CNT + gid] = 0;
    if (gid < 2) {
        WSP(int, OFF_CTL)[CTL_Q + gid] = 0;
        float d1 = 0.f, d2 = 0.f;
        for (int i = 0; i < 32; ++i) { d1 += p.in[I_LQ1][gid * 32 + i] * p.in[I_LK1][gid * 32 + i]; d2 += p.in[I_LQ2][gid * 32 + i] * p.in[I_LK2][gid * 32 + i]; }
        WSP(float, OFF_CTL)[CTL_LAM + gid] = expf(d1) - expf(d2) + lambda_init(gid);
    }
}

DI void ph_prep_x(const Params& p, int bid, int nb) {
    const int lane = threadIdx.x & 63, gw = bid * 4 + (threadIdx.x >> 6), nw = nb * 4;
    const float* x = p.in[I_X];
    bf* xb = WSP(bf, OFF_XB);
    float* rinv = WSP(float, OFF_RINV1);
    for (int t = gw; t < NT; t += nw) {
        float ss = 0.f;
#pragma unroll
        for (int i = 0; i < 2; ++i) {
            const int c = (lane + 64 * i) * 8;
            const float4 a = *(const float4*)(x + (size_t)t * D + c), b = *(const float4*)(x + (size_t)t * D + c + 4);
            float v[8] = {a.x, a.y, a.z, a.w, b.x, b.y, b.z, b.w};
#pragma unroll
            for (int j = 0; j < 8; ++j) ss += v[j] * v[j];
            store8(xb + (size_t)t * D + c, v);
        }
        ss = wave_sum(ss);
        if (lane == 0) rinv[t] = rsqrtf(ss * (1.f / 1024.f) + EPS);
    }
}

template <bool BT, class LA, class LB, class EPI>
DI void ngemm_tile(int K, LA la, LB lb, EPI epi, float* sA, float* sB) {
    const int tid = threadIdx.x, ty = tid >> 4, tx = tid & 15;
    float acc[4][4];
#pragma unroll
    for (int i = 0; i < 4; ++i)
#pragma unroll
        for (int j = 0; j < 4; ++j) acc[i][j] = 0.f;
    for (int k0 = 0; k0 < K; k0 += 16) {
#pragma unroll
        for (int i = 0; i < 4; ++i) {
            const int e = tid + 256 * i;
            sA[(e & 15) * 68 + (e >> 4)] = la(e >> 4, k0 + (e & 15));
            if (BT) sB[(e & 15) * 68 + (e >> 4)] = lb(k0 + (e & 15), e >> 4);
            else sB[(e >> 6) * 68 + (e & 63)] = lb(k0 + (e >> 6), e & 63);
        }
        __syncthreads();
#pragma unroll
        for (int kk = 0; kk < 16; ++kk) {
            const float4 a = *(const float4*)(sA + kk * 68 + ty * 4), b = *(const float4*)(sB + kk * 68 + tx * 4);
            const float av[4] = {a.x, a.y, a.z, a.w}, bv[4] = {b.x, b.y, b.z, b.w};
#pragma unroll
            for (int i = 0; i < 4; ++i)
#pragma unroll
                for (int j = 0; j < 4; ++j) acc[i][j] += av[i] * bv[j];
        }
        __syncthreads();
    }
#pragma unroll
    for (int i = 0; i < 4; ++i)
#pragma unroll
        for (int j = 0; j < 4; ++j) epi(ty * 4 + i, tx * 4 + j, acc[i][j]);
}

DI void ph_p1_gemm_naive(const Params& p, int l, int chunk, int bid, int nb, unsigned char* smem) {
    float* sA = (float*)smem; float* sB = sA + 16 * 68;
    for (int u = bid; u < 2048; u += nb) {
    const int mt = u / 8, nt = u % 8;
    const bf* A = WSP(bf, OFF_XB) + (size_t)mt * 64 * D;
    const bf* Bt = WSP(bf, OFF_WIN) + (size_t)l * 2048 * 1024 + (size_t)(chunk * 512 + nt * 64) * 1024;
    const float* rinv = WSP(float, OFF_RINV1) + mt * 64;
    float* C = WSP(float, OFF_MIX) + (size_t)mt * 64 * 512 + nt * 64;
    ngemm_tile<true>(1024, [=](int r, int k) { return bf2f(A[(size_t)r * D + k]); }, [=](int k, int c) { return bf2f(Bt[(size_t)c * 1024 + k]); },
               [=](int r, int c, float v) { C[(size_t)r * 512 + c] = v * rinv[r]; }, sA, sB);
    }
}

template <class ACC>
DI void route_tile(const Params& p, int l, int mt, int nt, ACC T) {
    const int tid = threadIdx.x;
    const int t0 = mt * 128, b = t0 >> 12, s0 = t0 & 4095;
    if (nt < 4) {
        bf* dst = WSP(bf, nt < 2 ? OFF_LX : OFF_GG);
        const int cb = (nt & 1) * 128;
#pragma unroll 1
        for (int it = 0; it < 8; ++it) {
            const int id = it * 256 + tid, r = id >> 4, c8 = (id & 15) * 8;
            float v[8];
#pragma unroll
            for (int j = 0; j < 8; ++j) { v[j] = T(r, c8 + j); if (nt >= 2) v[j] = gelu_tanh(v[j]); }
            store8(dst + (size_t)(t0 + r) * 256 + cb + c8, v);
        }
    } else if (nt < 10) {
        const bool isk = nt >= 7;
        const int g0 = (nt - (isk ? 7 : 4)) * 128;
        const float* gain = (isk ? p.in[I_DKG] : p.in[I_DQG]) + l * 32;
        bf* dst = WSP(bf, isk ? OFF_DK : OFF_DQ);
#pragma unroll 1
        for (int it = 0; it < 8; ++it) {
            const int id = it * 256 + tid, r = id >> 4, c8 = (id & 15) * 8;
            float v[8], ss = 0.f;
#pragma unroll
            for (int j = 0; j < 8; ++j) { v[j] = T(r, c8 + j); ss += v[j] * v[j]; }
            ss += __shfl_xor(ss, 1); ss += __shfl_xor(ss, 2);
            const float rn = rsqrtf(ss * (1.f / 32.f) + EPS);
            const int col = g0 + c8, h = col >> 6, m = (col >> 5) & 1, d0 = col & 31;
#pragma unroll
            for (int j = 0; j < 8; ++j) v[j] = v[j] * rn * gain[d0 + j];
            store8(dst + ((size_t)((b * 6 + h) * 2 + m) * S + s0 + r) * 32 + d0, v);
        }
    } else if (nt < 13) {
        const int g0 = (nt - 10) * 128;
        bf* dst = WSP(bf, OFF_DVT);
#pragma unroll 1
        for (int it = 0; it < 8; ++it) {
            const int id = it * 256 + tid, c = id & 127, rc = id >> 7;
            float v[8];
#pragma unroll
            for (int j = 0; j < 8; ++j) v[j] = T(8 * rc + j, c);
            const int col = g0 + c, h = col >> 6, d = col & 63;
            store8(dst + ((size_t)(b * 6 + h) * 64 + d) * S + s0 + 8 * rc, v);
        }
    } else {
#pragma unroll 1
        for (int it = 0; it < 8; ++it) {
            const int id = it * 256 + tid, r = id >> 4, c8 = (id & 15) * 8;
            float v[8];
#pragma unroll
            for (int j = 0; j < 8; ++j) v[j] = T(r, c8 + j);
            if (nt == 13) store8(WSP(bf, OFF_CQ) + (size_t)(t0 + r) * 192 + c8, v);
            else if (nt == 14) {
                if (c8 < 64) store8(WSP(bf, OFF_CQ) + (size_t)(t0 + r) * 192 + 128 + c8, v);
                else if (c8 < 96) store8(WSP(bf, OFF_KR) + (size_t)(t0 + r) * 32 + (c8 - 64), v);
            } else store8(WSP(bf, OFF_CKV) + (size_t)(t0 + r) * 128 + c8, v);
        }
    }
}

DI void ph_p1_route_naive(const Params& p, int l, int chunk, int bid, int nb) {
    for (int u = bid; u < 512; u += nb) {
    const int mt = u / 4, ntl = u % 4;
    const float* C = WSP(float, OFF_MIX) + (size_t)mt * 128 * 512 + ntl * 128;
    route_tile(p, l, mt, chunk * 4 + ntl, [=](int r, int c) { return C[(size_t)r * 512 + c]; });
    }
}


typedef short bf16x8 __attribute__((ext_vector_type(8)));
typedef short s16x4 __attribute__((ext_vector_type(4)));
typedef float f32x16 __attribute__((ext_vector_type(16)));
typedef __attribute__((address_space(3))) s16x4 lds_s16x4;
#define MFMA32(a, b, c) __builtin_amdgcn_mfma_f32_32x32x16_bf16((a), (b), (c), 0, 0, 0)
constexpr int G_A_BYTES = 16384, G_B_BYTES = 20480;
constexpr int G_OFF_B = 2 * G_A_BYTES;
constexpr int G_LOOP_BYTES = 2 * G_A_BYTES + 2 * G_B_BYTES;
constexpr int G_OFF_AUX = G_LOOP_BYTES;
constexpr int GEMM_SMEM = G_LOOP_BYTES + 1024;

DI unsigned cvt_pk_bf16(float a, float b) { return pack2(a, b); }

struct RowLoader {
    const bf* base; size_t ld;
    DI uint4 load(int i, int kt) const { return *(const uint4*)(base + (size_t)(32 * i) * ld + kt * 64); }
};
struct GatherLoader {
    const bf* rp[4];
    DI uint4 load(int i, int kt) const { return rp[i] ? *(const uint4*)(rp[i] + kt * 64) : make_uint4(0, 0, 0, 0); }
};
struct TrLoader {
    const float* base; size_t ldn;
    DI float4 load(int i, int kt) const { return *(const float4*)(base + (size_t)(kt * 64 + 8 * i) * ldn); }
};

template <int BMODE, class AL, class BL>
DI void gemm_mainloop(f32x16 (&acc)[2][2], int nk, const AL& al, const BL& bl, unsigned char* smem) {
    const int tid = threadIdx.x, lane = tid & 63, wv = tid >> 6, wr = wv >> 1, wc = wv & 1;
    const int r31 = lane & 31, h = lane >> 5, sw = (r31 >> 1) & 7;
    const int a_wr = (tid >> 3) * 128 + (((tid & 7) ^ ((tid >> 4) & 7)) << 4);
    const int b_wr1 = (tid >> 5) * 320 + (tid & 31) * 8;
    const int a_rd = (wr * 64 + r31) * 128, b_rd0 = (wc * 64 + r31) * 128;
    const int b_rd1 = (8 * h + ((lane & 15) >> 2)) * 320 + (wc * 64 + 16 * ((lane >> 4) & 1) + 4 * (lane & 3)) * 2;
    uint4 ra[4]; uint4 rb0[4]; float4 rb1[8];
#pragma unroll
    for (int i = 0; i < 4; ++i) ra[i] = al.load(i, 0);
    if constexpr (BMODE == 0) {
#pragma unroll
        for (int i = 0; i < 4; ++i) rb0[i] = bl.load(i, 0);
    } else {
#pragma unroll
        for (int i = 0; i < 8; ++i) rb1[i] = bl.load(i, 0);
    }
#pragma unroll
    for (int i = 0; i < 4; ++i) *(uint4*)(smem + a_wr + i * 4096) = ra[i];
    if constexpr (BMODE == 0) {
#pragma unroll
        for (int i = 0; i < 4; ++i) *(uint4*)(smem + G_OFF_B + a_wr + i * 4096) = rb0[i];
    } else {
#pragma unroll
        for (int i = 0; i < 8; ++i) *(uint2*)(smem + G_OFF_B + b_wr1 + i * 2560) = make_uint2(cvt_pk_bf16(rb1[i].x, rb1[i].y), cvt_pk_bf16(rb1[i].z, rb1[i].w));
    }
    __syncthreads();
#pragma unroll 1
    for (int kt = 0; kt < nk; ++kt) {
        const int cur = kt & 1;
        const bool more = kt + 1 < nk;
        if (more) {
#pragma unroll
            for (int i = 0; i < 4; ++i) ra[i] = al.load(i, kt + 1);
            if constexpr (BMODE == 0) {
#pragma unroll
                for (int i = 0; i < 4; ++i) rb0[i] = bl.load(i, kt + 1);
            } else {
#pragma unroll
                for (int i = 0; i < 8; ++i) rb1[i] = bl.load(i, kt + 1);
            }
        }
        const unsigned char* sA = smem + cur * G_A_BYTES;
        const unsigned char* sB = smem + G_OFF_B + cur * G_B_BYTES;
#pragma unroll
        for (int ks = 0; ks < 4; ++ks) {
            const int co = ((2 * ks + h) ^ sw) << 4;
            bf16x8 a[2], b[2];
#pragma unroll
            for (int mi = 0; mi < 2; ++mi) a[mi] = *(const bf16x8*)(sA + a_rd + mi * 4096 + co);
            if constexpr (BMODE == 0) {
#pragma unroll
                for (int ni = 0; ni < 2; ++ni) b[ni] = *(const bf16x8*)(sB + b_rd0 + ni * 4096 + co);
            } else {
#pragma unroll
                for (int ni = 0; ni < 2; ++ni) {
                    const s16x4 lo = __builtin_amdgcn_ds_read_tr16_b64_v4i16((lds_s16x4*)(sB + b_rd1 + ks * 5120 + ni * 64));
                    const s16x4 hi = __builtin_amdgcn_ds_read_tr16_b64_v4i16((lds_s16x4*)(sB + b_rd1 + ks * 5120 + 1280 + ni * 64));
                    b[ni] = __builtin_shufflevector(lo, hi, 0, 1, 2, 3, 4, 5, 6, 7);
                }
            }
#pragma unroll
            for (int mi = 0; mi < 2; ++mi)
#pragma unroll
                for (int ni = 0; ni < 2; ++ni) acc[mi][ni] = MFMA32(a[mi], b[ni], acc[mi][ni]);
        }
        if (more) {
            unsigned char* dA = smem + (cur ^ 1) * G_A_BYTES;
            unsigned char* dB = smem + G_OFF_B + (cur ^ 1) * G_B_BYTES;
#pragma unroll
            for (int i = 0; i < 4; ++i) *(uint4*)(dA + a_wr + i * 4096) = ra[i];
            if constexpr (BMODE == 0) {
#pragma unroll
                for (int i = 0; i < 4; ++i) *(uint4*)(dB + a_wr + i * 4096) = rb0[i];
            } else {
#pragma unroll
                for (int i = 0; i < 8; ++i) *(uint2*)(dB + b_wr1 + i * 2560) = make_uint2(cvt_pk_bf16(rb1[i].x, rb1[i].y), cvt_pk_bf16(rb1[i].z, rb1[i].w));
            }
        }
        __syncthreads();
    }
}

DI void acc_zero(f32x16 (&acc)[2][2]) {
#pragma unroll
    for (int mi = 0; mi < 2; ++mi)
#pragma unroll
        for (int ni = 0; ni < 2; ++ni)
#pragma unroll
            for (int r = 0; r < 16; ++r) acc[mi][ni][r] = 0.f;
}
DI void acc_stage(const f32x16 (&acc)[2][2], float* sC) {
    const int lane = threadIdx.x & 63, wv = threadIdx.x >> 6, wr = wv >> 1, wc = wv & 1, r31 = lane & 31, h = lane >> 5;
#pragma unroll
    for (int mi = 0; mi < 2; ++mi)
#pragma unroll
        for (int ni = 0; ni < 2; ++ni)
#pragma unroll
            for (int r = 0; r < 16; ++r)
                sC[(wr * 64 + mi * 32 + (r & 3) + 8 * (r >> 2) + 4 * h) * 128 + wc * 64 + ni * 32 + r31] = acc[mi][ni][r];
    __syncthreads();
}

DI void ph_p1(const Params& p, int l, int bid, int nb, unsigned char* smem) {
    const int tid = threadIdx.x;
    const bf* XB = WSP(bf, OFF_XB);
    const bf* W = WSP(bf, OFF_WIN) + (size_t)l * 2048 * 1024;
    const float* rinv = WSP(float, OFF_RINV1);
    float* sC = (float*)smem;
    for (int u = bid; u < 2048; u += nb) {
        const int mt = u >> 4, nt = u & 15;
        RowLoader al{XB + (size_t)(mt * 128 + (tid >> 3)) * 1024 + (tid & 7) * 8, 1024};
        RowLoader bl{W + (size_t)(nt * 128 + (tid >> 3)) * 1024 + (tid & 7) * 8, 1024};
        f32x16 acc[2][2];
        acc_zero(acc);
        gemm_mainloop<0>(acc, 16, al, bl, smem);
        acc_stage(acc, sC);
        const float* rv = rinv + mt * 128;
        route_tile(p, l, mt, nt, [=](int r, int c) { return sC[r * 128 + c] * rv[r]; });
        __syncthreads();
    }
}


DI void ph_p4(const Params& p, int l, int bid, int nb, unsigned char* smem) {
    const int tid = threadIdx.x, lane = tid & 63, wv = tid >> 6, wr = wv >> 1, h = lane >> 5;
    if (bid == 0 && tid < 32) WSP(int, OFF_CTL)[CTL_CNT + tid] = 0;
    const bf* MIX = WSP(bf, OFF_MIX);
    const bf* W = WSP(bf, OFF_WOUT) + (size_t)l * 1024 * 1024;
    const float* xin = l == 0 ? p.in[I_X] : WSP(float, OFF_XFA);
    const float* g2 = p.in[I_N2G] + l * 1024;
    bf* xb1 = WSP(bf, OFF_XB);
    float* sC = (float*)smem; float* sRN = (float*)(smem + G_OFF_AUX);
    for (int u = bid; u < 1024; u += nb) {
        const int mt = u >> 3, nt = u & 7;
        if (tid < 128) { const float* sq = WSP(float, OFF_SSQM) + (size_t)(mt * 128 + tid) * 8; sRN[tid] = rsqrtf((sq[0] + sq[1] + sq[2] + sq[3] + sq[4] + sq[5]) * (1.f / 384.f) + EPS); }
        const bf* abase = MIX + (size_t)(mt * 128 + (tid >> 3)) * 1024 + (tid & 7) * 8;
        const bf* bbase = W + (size_t)(nt * 128 + (tid >> 3)) * 1024 + (tid & 7) * 8;
        f32x16 acc[2][2];
        acc_zero(acc);
        { RowLoader al{abase + 640, 1024}, bl{bbase + 640, 1024}; gemm_mainloop<0>(acc, 6, al, bl, smem); }
#pragma unroll
        for (int mi = 0; mi < 2; ++mi)
#pragma unroll
            for (int r = 0; r < 16; ++r) {
                const float sc = sRN[wr * 64 + mi * 32 + (r & 3) + 8 * (r >> 2) + 4 * h];
                acc[mi][0][r] *= sc; acc[mi][1][r] *= sc;
            }
        { RowLoader al{abase, 1024}, bl{bbase, 1024}; gemm_mainloop<0>(acc, 10, al, bl, smem); }
        acc_stage(acc, sC);
#pragma unroll 1
        for (int it = 0; it < 8; ++it) {
            const int id = it * 256 + tid, r = id >> 4, c8 = (id & 15) * 8;
            const size_t o = (size_t)(mt * 128 + r) * 1024 + nt * 128 + c8;
            const float4 x0 = *(const float4*)(xin + o), x1 = *(const float4*)(xin + o + 4);
            const float4 c0 = *(const float4*)(sC + r * 128 + c8), c1 = *(const float4*)(sC + r * 128 + c8 + 4);
            const float4 ga = *(const float4*)(g2 + nt * 128 + c8), gb = *(const float4*)(g2 + nt * 128 + c8 + 4);
            float v[8] = {x0.x + c0.x, x0.y + c0.y, x0.z + c0.z, x0.w + c0.w, x1.x + c1.x, x1.y + c1.y, x1.z + c1.z, x1.w + c1.w};
            *(float4*)(p.out + o) = make_float4(v[0], v[1], v[2], v[3]);
            *(float4*)(p.out + o + 4) = make_float4(v[4], v[5], v[6], v[7]);
            const float gg[8] = {ga.x, ga.y, ga.z, ga.w, gb.x, gb.y, gb.z, gb.w};
#pragma unroll
            for (int j = 0; j < 8; ++j) v[j] *= gg[j];
            store8(xb1 + o, v);
        }
        __syncthreads();
    }
}

DI void moe_sched_init(const Params& p, int* aux) {
    if (threadIdx.x == 0) {
        const int* cnt = WSP(int, OFF_CTL) + CTL_CNT;
        int rb = 0, base = 0;
        for (int e = 0; e < 32; ++e) { const int c = cnt[e]; aux[e] = c; aux[32 + e] = rb; aux[65 + e] = base; rb += (c + 127) >> 7; base += c; }
        aux[64] = rb; aux[97] = base;
    }
    __syncthreads();
}
struct MoeUnit { int e, base; };
DI MoeUnit moe_unit(const Params& p, const int* aux, int rbg, int* sEnt) {
    int e = 0;
    while (aux[33 + e] <= rbg) ++e;
    const int rb = rbg - aux[32 + e];
    const int n = aux[e] - rb * 128;
    if (threadIdx.x < 128) sEnt[threadIdx.x] = (int)threadIdx.x < n ? WSP(int, OFF_LIST)[e * 16384 + rb * 128 + threadIdx.x] : -1;
    __syncthreads();
    MoeUnit mu; mu.e = e; mu.base = aux[65 + e] + rb * 128;
    return mu;
}

DI void ph_moe_up(const Params& p, int l, int bid, int nb, unsigned char* smem) {
    const int tid = threadIdx.x;
    int* aux = (int*)(smem + G_OFF_AUX); int* sEnt = aux + 128;
    float* sC = (float*)smem;
    moe_sched_init(p, aux);
    const int units = aux[64] * 4;
    const bf* XB = WSP(bf, OFF_XB);
    const float* rinv2 = WSP(float, OFF_RINV2);
    bf* ACT = WSP(bf, OFF_ACT);
    for (int u = bid; u < units; u += nb) {
        const int q = u & 3;
        const MoeUnit mu = moe_unit(p, aux, u >> 2, sEnt);
        const int e = mu.e, base = mu.base;
        GatherLoader al;
#pragma unroll
        for (int i = 0; i < 4; ++i) { const int en = sEnt[(tid >> 3) + 32 * i]; al.rp[i] = en >= 0 ? XB + (size_t)(en >> 1) * 1024 + (tid & 7) * 8 : nullptr; }
        const int n4 = tid & 31;
        TrLoader bl{(n4 < 16 ? p.in[I_W1] : p.in[I_W3]) + (size_t)(l * 32 + e) * 262144 + (size_t)(tid >> 5) * 256 + q * 64 + (n4 & 15) * 4, 256};
        f32x16 acc[2][2];
        acc_zero(acc);
        gemm_mainloop<1>(acc, 16, al, bl, smem);
        acc_stage(acc, sC);
#pragma unroll 1
        for (int it = 0; it < 4; ++it) {
            const int id = it * 256 + tid, r = id >> 3, c8 = (id & 7) * 8;
            const int en = sEnt[r];
            if (en >= 0) {
                const float rs = rinv2[en >> 1];
                float v[8];
#pragma unroll
                for (int j = 0; j < 8; ++j) { const float a = sC[r * 128 + c8 + j] * rs, b = sC[r * 128 + 64 + c8 + j] * rs; v[j] = a * sigmoidf_(a) * b; }
                store8(ACT + (size_t)(base + r) * 256 + q * 64 + c8, v);
            }
        }
        __syncthreads();
    }
}

DI void ph_moe_down(const Params& p, int l, int bid, int nb, unsigned char* smem) {
    const int tid = threadIdx.x;
    int* aux = (int*)(smem + G_OFF_AUX); int* sEnt = aux + 128;
    float* sC = (float*)smem;
    moe_sched_init(p, aux);
    const int units = aux[64] * 8;
    const bf* ACT = WSP(bf, OFF_ACT);
    const float* gatew = WSP(float, OFF_GATEW);
    bf* Y = WSP(bf, OFF_Y);
    for (int u = bid; u < units; u += nb) {
        const int nt = u & 7;
        const MoeUnit mu = moe_unit(p, aux, u >> 3, sEnt);
        const int e = mu.e, base = mu.base;
        RowLoader al{ACT + (size_t)(base + (tid >> 3)) * 256 + (tid & 7) * 8, 256};
        TrLoader bl{p.in[I_W2] + (size_t)(l * 32 + e) * 262144 + (size_t)(tid >> 5) * 1024 + nt * 128 + (tid & 31) * 4, 1024};
        f32x16 acc[2][2];
        acc_zero(acc);
        gemm_mainloop<1>(acc, 4, al, bl, smem);
        acc_stage(acc, sC);
#pragma unroll 1
        for (int it = 0; it < 8; ++it) {
            const int id = it * 256 + tid, r = id >> 4, c8 = (id & 15) * 8;
            const int en = sEnt[r];
            if (en >= 0) {
                const float gw = gatew[en];
                float v[8];
#pragma unroll
                for (int j = 0; j < 8; ++j) v[j] = sC[r * 128 + c8 + j] * gw;
                store8(Y + ((size_t)(en & 1) * NT + (en >> 1)) * 1024 + nt * 128 + c8, v);
            }
        }
        __syncthreads();
    }
}

DI void ph_mla_up(const Params& p, int l, int bid, int nb, unsigned char* smem) {
    const int tid = threadIdx.x;
    float* sC = (float*)smem; float* sRN = (float*)(smem + G_OFF_AUX);
    const float* ropet = WSP(float, OFF_ROPE);
    for (int u = bid; u < 128 * 12; u += nb) {
        const int mt = u / 12, j = u % 12, isq = j < 6, hd = isq ? j : j - 6;
        const int t0 = mt * 128, b = t0 >> 12, s0 = t0 & 4095;
        const int KD = isq ? 192 : 128;
        const bf* Asrc = isq ? WSP(bf, OFF_CQ) : WSP(bf, OFF_CKV);
        {
            const int r = tid >> 1, half = tid & 1, nch = KD / 16;
            const uint4* src = (const uint4*)(Asrc + (size_t)(t0 + r) * KD + half * (KD / 2));
            float ss = 0.f;
            for (int i = 0; i < nch; ++i) { const uint4 v = src[i]; const unsigned w[4] = {v.x, v.y, v.z, v.w};
#pragma unroll
                for (int e = 0; e < 4; ++e) { const float a = lo16(w[e]), c = hi16(w[e]); ss += a * a + c * c; } }
            ss += __shfl_xor(ss, 1);
            if (!half) sRN[r] = rsqrtf(ss / (float)KD + EPS);
        }
        RowLoader al{Asrc + (size_t)(t0 + (tid >> 3)) * KD + (tid & 7) * 8, (size_t)KD};
        const bf* Bsrc = isq ? WSP(bf, OFF_WUQ) + (size_t)l * 768 * 192 + (size_t)hd * 128 * 192 : WSP(bf, OFF_WUKV) + (size_t)l * 768 * 128 + (size_t)hd * 128 * 128;
        RowLoader bl{Bsrc + (size_t)(tid >> 3) * KD + (tid & 7) * 8, (size_t)KD};
        f32x16 acc[2][2];
        acc_zero(acc);
        gemm_mainloop<0>(acc, KD / 64, al, bl, smem);
        acc_stage(acc, sC);
        const float* gain = (isq ? p.in[I_MQG] : p.in[I_MKG]) + l * 96;
        const bf* KR = WSP(bf, OFF_KR);
        bf* dst = WSP(bf, isq ? OFF_MQ : OFF_MK);
#pragma unroll 1
        for (int it = 0; it < 8; ++it) {
            const int id = it * 256 + tid, r = id >> 4, c8 = (id & 15) * 8;
            const int t = t0 + r;
            const float rl = sRN[r];
            float v[8], w[8];
            const int pc = c8 < 80 ? c8 + 16 : c8 - 16;
#pragma unroll
            for (int jj = 0; jj < 8; ++jj) {
                float a = 0.f, bq = 0.f;
                if (c8 < 96) {
                    if (isq || c8 < 64) { a = sC[r * 128 + c8 + jj] * rl; if (c8 >= 64) bq = sC[r * 128 + pc + jj] * rl; }
                    else { a = bf2f(KR[(size_t)t * 32 + c8 - 64 + jj]); bq = bf2f(KR[(size_t)t * 32 + pc - 64 + jj]); }
                }
                v[jj] = a; w[jj] = bq;
            }
            float ss = 0.f;
#pragma unroll
            for (int jj = 0; jj < 8; ++jj) ss += v[jj] * v[jj];
            ss += __shfl_xor(ss, 1); ss += __shfl_xor(ss, 2); ss += __shfl_xor(ss, 4); ss += __shfl_xor(ss, 8);
            const float rn = rsqrtf(ss * (1.f / 96.f) + EPS);
            if (c8 < 96) {
                float o[8];
                if (c8 < 64) {
#pragma unroll
                    for (int jj = 0; jj < 8; ++jj) o[jj] = v[jj] * rn * gain[c8 + jj];
                } else {
                    const float* rp_ = ropet + (size_t)(s0 + r) * 32;
                    const bool first = c8 < 80;
#pragma unroll
                    for (int jj = 0; jj < 8; ++jj) {
                        const int i = (c8 & 15) + jj;
                        const float mine = v[jj] * rn * gain[c8 + jj], other = w[jj] * rn * gain[pc + jj];
                        const float cs = rp_[i], sn = rp_[16 + i];
                        o[jj] = first ? mine * cs - other * sn : other * sn + mine * cs;
                    }
                }
                store8(dst + ((size_t)(b * 6 + hd) * S + s0 + r) * 96 + c8, o);
            }
        }
        if (!isq) {
            bf* mvt = WSP(bf, OFF_MVT);
#pragma unroll 1
            for (int it = 0; it < 4; ++it) {
                const int id = it * 256 + tid, c = id & 63, rc = id >> 6;
                float v[8];
#pragma unroll
                for (int jj = 0; jj < 8; ++jj) v[jj] = sC[(8 * rc + jj) * 128 + 64 + c] * sRN[8 * rc + jj];
                store8(mvt + ((size_t)(b * 6 + hd) * 64 + c) * S + s0 + 8 * rc, v);
            }
        }
        __syncthreads();
    }
}

DI void lru_tile(const Params& p, int l, int b, int tile, int mode, float* sXC  , float* sY  ) {
    const int c = threadIdx.x, blk = c >> 6, j = c & 63, lane = c & 63, wv = c >> 6;
    const bf* LX = WSP(bf, OFF_LX); const bf* GGp = WSP(bf, OFF_GG);
    const float cw0 = p.in[I_CONVW][(l * 4 + 0) * 256 + c], cw1 = p.in[I_CONVW][(l * 4 + 1) * 256 + c], cw2 = p.in[I_CONVW][(l * 4 + 2) * 256 + c],
                cw3 = p.in[I_CONVW][(l * 4 + 3) * 256 + c], cb = p.in[I_CONVB][l * 256 + c];
    const float ba = p.in[I_BA][l * 256 + c], bx = p.in[I_BX][l * 256 + c];
    const float lam = p.in[I_LAM][l * 256 + c];
    const float c8 = 8.f * log1pf(__expf(-lam));
    const uint4* wa4 = (const uint4*)(WSP(bf, OFF_WAX) + (size_t)(((l * 2 + 0) * 4 + blk) * 64 + j) * 64);
    const uint4* wx4 = (const uint4*)(WSP(bf, OFF_WAX) + (size_t)(((l * 2 + 1) * 4 + blk) * 64 + j) * 64);
    const int tb = b * S + tile * 64;
    float xm3 = 0.f, xm2 = 0.f, xm1 = 0.f;
    if (tile > 0) { xm3 = bf2f(LX[(size_t)(tb - 3) * 256 + c]); xm2 = bf2f(LX[(size_t)(tb - 2) * 256 + c]); xm1 = bf2f(LX[(size_t)(tb - 1) * 256 + c]); }
    float h = 0.f, aprod = 1.f;
    if (mode == 1) {
        const float* TOT = WSP(float, OFF_TOT) + (size_t)(b * 64) * 512;
        for (int i = 0; i < tile; ++i) h = TOT[i * 512 + c] * h + TOT[i * 512 + 256 + c];
    }
#pragma unroll 1
    for (int g = 0; g < 4; ++g) {
#pragma unroll 1
        for (int tt = 0; tt < 16; ++tt) {
            const float x0 = bf2f(LX[(size_t)(tb + g * 16 + tt) * 256 + c]);
            sXC[tt * 256 + c] = cw0 * xm3 + cw1 * xm2 + cw2 * xm1 + cw3 * x0 + cb;
            xm3 = xm2; xm2 = xm1; xm1 = x0;
        }
        __syncthreads();
#pragma unroll 1
        for (int tt = 0; tt < 16; ++tt) {
            float ra = ba, rx = bx;
            const float* xr = sXC + tt * 256 + blk * 64;
#pragma unroll
            for (int i = 0; i < 8; ++i) {
                const uint4 wa = wa4[i], wx = wx4[i];
                const unsigned a4[4] = {wa.x, wa.y, wa.z, wa.w}, x4[4] = {wx.x, wx.y, wx.z, wx.w};
#pragma unroll
                for (int q = 0; q < 4; ++q) {
                    const float v0 = xr[i * 8 + q * 2], v1 = xr[i * 8 + q * 2 + 1];
                    ra += v0 * lo16(a4[q]) + v1 * hi16(a4[q]);
                    rx += v0 * lo16(x4[q]) + v1 * hi16(x4[q]);
                }
            }
            const float r = sigmoidf_(ra), ig = sigmoidf_(rx);
            const float log_a = -c8 * r;
            const float a = __expf(log_a);
            const float bb = sqrtf(-expm1f(2.f * log_a)) * ig * sXC[tt * 256 + c];
            h = a * h + bb; aprod *= a;
            if (mode == 1) sY[tt * 256 + c] = h * bf2f(GGp[(size_t)(tb + g * 16 + tt) * 256 + c]);
        }
        __syncthreads();
        if (mode == 1) {
            bf* MIX = WSP(bf, OFF_MIX);
#pragma unroll 1
            for (int q = 0; q < 4; ++q) {
                const int tt = wv * 4 + q;
                const float y0 = sY[tt * 256 + lane], y1 = sY[tt * 256 + 64 + lane], y2 = sY[tt * 256 + 128 + lane], y3 = sY[tt * 256 + 192 + lane];
                const float rn = rsqrtf(wave_sum(y0 * y0 + y1 * y1 + y2 * y2 + y3 * y3) * (1.f / 256.f) + EPS);
                bf* m = MIX + (size_t)(tb + g * 16 + tt) * 1024 + lane;
                m[0] = f2bf(y0 * rn); m[64] = f2bf(y1 * rn); m[128] = f2bf(y2 * rn); m[192] = f2bf(y3 * rn);
            }
            __syncthreads();
        }
    }
    if (mode == 0) {
        float* TOT = WSP(float, OFF_TOT) + (size_t)(b * 64 + tile) * 512;
        TOT[c] = aprod; TOT[256 + c] = h;
    }
}

DI void ph_lru(const Params& p, int l, int mode, int bid, int nb, unsigned char* smem) {
    float* sXC = (float*)smem; float* sY = sXC + 16 * 256;
    for (int u = bid; u < 256; u += nb) lru_tile(p, l, u >> 6, u & 63, mode, sXC, sY);
}


DI int pi_row(int r) { return (r & 0x13) | ((r & 4) << 1) | ((r & 8) >> 1); }
DI float fexp2(float x) { return __builtin_amdgcn_exp2f(x); }


template <int KD>
DI void att_issue(uint4& k0r, uint4& k1r, uint4& k2r, uint4& v0r, uint4& v1r, const bf* Kg, const bf* Vg, int j) {
    const int tid = threadIdx.x, k0 = j * 64;
    const bf* src = Kg + (size_t)k0 * KD + tid * 8;
    k0r = *(const uint4*)(src);
    if (KD == 96) { k1r = *(const uint4*)(src + 2048); k2r = *(const uint4*)(src + 4096); }
    const bf* vs = Vg + (size_t)(tid >> 3) * S + k0 + (tid & 7) * 8;
    v0r = *(const uint4*)(vs); v1r = *(const uint4*)(vs + (size_t)32 * S);
}
template <int KD>
DI void att_commit(const uint4& k0r, const uint4& k1r, const uint4& k2r, const uint4& v0r, const uint4& v1r, unsigned char* base) {
    constexpr int KRS = KD == 96 ? 208 : 80, KOFF_V = 64 * KRS;
    const int tid = threadIdx.x;
    if (KD == 96) {
        const int i0 = tid, i1 = tid + 256, i2 = tid + 512;
        *(uint4*)(base + (i0 / 12) * 208 + (i0 % 12) * 16) = k0r;
        *(uint4*)(base + (i1 / 12) * 208 + (i1 % 12) * 16) = k1r;
        *(uint4*)(base + (i2 / 12) * 208 + (i2 % 12) * 16) = k2r;
    } else {
        *(uint4*)(base + (tid >> 2) * 80 + (tid & 3) * 16) = k0r;
    }
    const int d = tid >> 3, ch = tid & 7;
    const int voff = KOFF_V + d * 128 + ((ch ^ ((d >> 1) & 7)) << 4);
    *(uint4*)(base + voff) = v0r;
    *(uint4*)(base + voff + 4096) = v1r;
}

template <int KD, bool BIAS>
DI void attn_pass(const bf* Kg, const bf* Vg, const bf* qrow, float sl2, int qb, unsigned char* smem, f32x16 (&O)[2], float& lsum) {
    constexpr int KRS = KD == 96 ? 208 : 80, KOFF_V = 64 * KRS, BUF = KOFF_V + 8192, NKS = KD / 16;
    constexpr float LOG2E = 1.4426950408889634f;
    constexpr float C = (KD == 96 ? 0.10206207261596575f : 0.17677669529663687f) * LOG2E;
    const int tid = threadIdx.x, lane = tid & 63, w = tid >> 6, r31 = lane & 31, h = lane >> 5;
    const int mychunk = 2 * qb + (w >> 1), nt = 2 * qb + 2;
    bf16x8 qf[NKS];
#pragma unroll
    for (int ks = 0; ks < NKS; ++ks) qf[ks] = *(const bf16x8*)(qrow + 16 * ks);
    float mrun = -1e30f, lrun = 0.f;
#pragma unroll
    for (int db = 0; db < 2; ++db)
#pragma unroll
        for (int r = 0; r < 16; ++r) O[db][r] = 0.f;
    uint4 rk0, rk1, rk2, rv0, rv1;
    rk1 = make_uint4(0, 0, 0, 0); rk2 = rk1;
    att_issue<KD>(rk0, rk1, rk2, rv0, rv1, Kg, Vg, 0);
    att_commit<KD>(rk0, rk1, rk2, rv0, rv1, smem);
    __syncthreads();
    const int krow = pi_row(r31) * KRS + h * 16;
    const int vsw = (r31 >> 1) & 7;
    const float slc = sl2 * (1.f / C);
#pragma unroll 1
    for (int j = 0; j < nt; ++j) {
        const bool more = j + 1 < nt;
        att_issue<KD>(rk0, rk1, rk2, rv0, rv1, Kg, Vg, more ? j + 1 : j);
        if (j <= mychunk) {
            const unsigned char* base = smem + (j & 1) * BUF;
            const bool diag = (j == mychunk);
            const float T = BIAS ? -sl2 * 64.f * (float)(mychunk - j) : 0.f;
            f32x16 sc[2];
#pragma unroll
            for (int kb2 = 0; kb2 < 2; ++kb2) {
#pragma unroll
                for (int r = 0; r < 16; ++r) sc[kb2][r] = 0.f;
                const unsigned char* kr = base + kb2 * 32 * KRS + krow;
#pragma unroll
                for (int ks = 0; ks < NKS; ++ks) sc[kb2] = MFMA32(*(const bf16x8*)(kr + ks * 32), qf[ks], sc[kb2]);
            }
            if (BIAS) {
                const int ql2 = diag ? 2 * ((w & 1) * 32 + r31) : 4096;
#pragma unroll
                for (int kb2 = 0; kb2 < 2; ++kb2)
#pragma unroll
                    for (int r = 0; r < 16; ++r) {
                        const int kl = 32 * kb2 + 16 * (r >> 3) + 8 * h + (r & 7);
                        sc[kb2][r] = fmaf(slc, (float)min(kl, ql2 - kl), sc[kb2][r]);
                    }
            }
            float mx = sc[0][0];
#pragma unroll
            for (int kb2 = 0; kb2 < 2; ++kb2)
#pragma unroll
                for (int r = 0; r < 16; ++r) mx = fmaxf(mx, sc[kb2][r]);
            mx = fmaxf(mx, __shfl_xor(mx, 32));
            const float mnew = fmaxf(mrun, mx * C + T);
            const float alpha = fexp2(mrun - mnew), off = T - mnew;
            float ls = 0.f;
            bf16x8 pf[4];
#pragma unroll
            for (int kb2 = 0; kb2 < 2; ++kb2)
#pragma unroll
                for (int s2 = 0; s2 < 2; ++s2) {
                    float pv[8];
#pragma unroll
                    for (int jj = 0; jj < 8; ++jj) { pv[jj] = fexp2(fmaf(sc[kb2][8 * s2 + jj], C, off)); ls += pv[jj]; }
                    uint4 pk; pk.x = pack2(pv[0], pv[1]); pk.y = pack2(pv[2], pv[3]); pk.z = pack2(pv[4], pv[5]); pk.w = pack2(pv[6], pv[7]);
                    pf[2 * kb2 + s2] = __builtin_bit_cast(bf16x8, pk);
                }
            mrun = mnew; lrun = lrun * alpha + ls;
#pragma unroll
            for (int db = 0; db < 2; ++db) {
#pragma unroll
                for (int r = 0; r < 16; ++r) O[db][r] *= alpha;
                const unsigned char* vr = base + KOFF_V + (32 * db + r31) * 128;
#pragma unroll
                for (int s4 = 0; s4 < 4; ++s4) O[db] = MFMA32(*(const bf16x8*)(vr + (((2 * s4 + h) ^ vsw) << 4)), pf[s4], O[db]);
            }
        }
        att_commit<KD>(rk0, rk1, rk2, rv0, rv1, smem + ((j + 1) & 1) * BUF);
        __syncthreads();
    }
    lsum = lrun + __shfl_xor(lrun, 32);
}

DI void attn_store(const f32x16 (&o)[2], float osc, unsigned char* stg, bf* dst  ) {
    const int lane = threadIdx.x & 63, r31 = lane & 31, h = lane >> 5;
#pragma unroll
    for (int db = 0; db < 2; ++db)
#pragma unroll
        for (int g = 0; g < 4; ++g) {
            uint2 pk; pk.x = pack2(o[db][4 * g] * osc, o[db][4 * g + 1] * osc); pk.y = pack2(o[db][4 * g + 2] * osc, o[db][4 * g + 3] * osc);
            *(uint2*)(stg + r31 * 144 + (32 * db + 8 * g + 4 * h) * 2) = pk;
        }
#pragma unroll
    for (int i = 0; i < 4; ++i) {
        const int id = lane + 64 * i, row = id >> 3, ch = id & 7;
        *(uint4*)(dst + (size_t)row * 1024 + ch * 8) = *(const uint4*)(stg + row * 144 + ch * 16);
    }
}
constexpr int ATT_STG = 2 * (64 * 208 + 8192);

DI void mla_unit(const Params& p, int l, int bh, int qb, unsigned char* smem) {
    const int lane = threadIdx.x & 63, w = threadIdx.x >> 6, r31 = lane & 31, h = lane >> 5;
    const int b = bh / 6, hd = bh % 6, q = qb * 128 + 32 * w + r31;
    f32x16 O[2]; float lsum;
    attn_pass<96, false>(WSP(bf, OFF_MK) + (size_t)bh * S * 96, WSP(bf, OFF_MVT) + (size_t)bh * 64 * S,
                         WSP(bf, OFF_MQ) + ((size_t)bh * S + q) * 96 + 8 * h, 0.f, qb, smem, O, lsum);
    const float inv = 1.f / lsum;
    float ss = 0.f;
#pragma unroll
    for (int db = 0; db < 2; ++db)
#pragma unroll
        for (int r = 0; r < 16; ++r) { O[db][r] *= inv; ss += O[db][r] * O[db][r]; }
    ss += __shfl_xor(ss, 32);
    const int trow = b * S + qb * 128 + 32 * w;
    if (h == 0) WSP(float, OFF_SSQM)[(size_t)(trow + r31) * 8 + hd] = ss;
    attn_store(O, 1.f, smem + ATT_STG + w * (32 * 144), WSP(bf, OFF_MIX) + (size_t)trow * 1024 + 640 + hd * 64);
}

DI void diff_unit(const Params& p, int l, int bh, int qb, unsigned char* smem) {
    const int lane = threadIdx.x & 63, w = threadIdx.x >> 6, r31 = lane & 31, h = lane >> 5;
    const int b = bh / 6, hd = bh % 6, q = qb * 128 + 32 * w + r31;
    const float sl2 = exp2f(-8.f * (float)(hd + 1) / 6.f) * 1.4426950408889634f;
    const bf* Vg = WSP(bf, OFF_DVT) + (size_t)bh * 64 * S;
    f32x16 O0[2], O1[2]; float l0, l1;
    attn_pass<32, true>(WSP(bf, OFF_DK) + (size_t)(bh * 2) * S * 32, Vg, WSP(bf, OFF_DQ) + ((size_t)(bh * 2) * S + q) * 32 + 8 * h, sl2, qb, smem, O0, l0);
    {
        const float inv = 1.f / l0;
#pragma unroll
        for (int db = 0; db < 2; ++db)
#pragma unroll
            for (int r = 0; r < 16; ++r) O0[db][r] *= inv;
    }
    attn_pass<32, true>(WSP(bf, OFF_DK) + (size_t)(bh * 2 + 1) * S * 32, Vg, WSP(bf, OFF_DQ) + ((size_t)(bh * 2 + 1) * S + q) * 32 + 8 * h, sl2, qb, smem, O1, l1);
    const float lam1 = WSP(float, OFF_CTL)[CTL_LAM + l] / l1;
    float ss = 0.f;
#pragma unroll
    for (int db = 0; db < 2; ++db)
#pragma unroll
        for (int r = 0; r < 16; ++r) { const float v = O0[db][r] - lam1 * O1[db][r]; O0[db][r] = v; ss += v * v; }
    ss += __shfl_xor(ss, 32);
    const int trow = b * S + qb * 128 + 32 * w;
    attn_store(O0, rsqrtf(ss * (1.f / 64.f) + EPS), smem + ATT_STG + w * (32 * 144), WSP(bf, OFF_MIX) + (size_t)trow * 1024 + 256 + hd * 64);
}

DI void ph_p3(const Params& p, int l, unsigned char* smem) {
    int* qhead = WSP(int, OFF_CTL) + CTL_Q + l;
    int* sU = (int*)(smem + GEMM_SMEM - 16);
    float* sXC = (float*)smem; float* sY = sXC + 16 * 256;
    for (;;) {
        if (threadIdx.x == 0) *sU = atomicAdd(qhead, 1);
        __syncthreads();
        const int u = *sU;
        __syncthreads();
        if (u >= 1536 + 256) break;
        if (u < 1536) {
            const int qb = 31 - u / 48, k = u % 48;
            if (k < 24) diff_unit(p, l, k, qb, smem);
            else mla_unit(p, l, k - 24, qb, smem);
        } else {
            const int v = u - 1536;
            lru_tile(p, l, v >> 6, v & 63, 1, sXC, sY);
        }
    }
}

DI void ph_mla_up_naive(const Params& p, int l, int bid, int nb, unsigned char* smem) {
    float (*sCQ)[192] = (float (*)[192])smem; float (*sCKV)[128] = (float (*)[128])(smem + 4 * 192 * 4);
    float (*sQ)[576] = (float (*)[576])(smem + 4 * 320 * 4); float (*sKV)[768] = (float (*)[768])(smem + 4 * 896 * 4);
    const int tid = threadIdx.x, lane = tid & 63, wv = tid >> 6;
    for (int u = bid; u < NT / 4; u += nb) {
    const int t0 = u * 4;
    {
        const int t = t0 + wv;
        const bf* cq = WSP(bf, OFF_CQ) + (size_t)t * 192; const bf* ckv = WSP(bf, OFF_CKV) + (size_t)t * 128;
        float a0 = bf2f(cq[lane]), a1 = bf2f(cq[lane + 64]), a2 = bf2f(cq[lane + 128]);
        float ss = wave_sum(a0 * a0 + a1 * a1 + a2 * a2);
        float rn = rsqrtf(ss * (1.f / 192.f) + EPS);
        sCQ[wv][lane] = a0 * rn; sCQ[wv][lane + 64] = a1 * rn; sCQ[wv][lane + 128] = a2 * rn;
        float b0 = bf2f(ckv[lane]), b1 = bf2f(ckv[lane + 64]);
        ss = wave_sum(b0 * b0 + b1 * b1);
        rn = rsqrtf(ss * (1.f / 128.f) + EPS);
        sCKV[wv][lane] = b0 * rn; sCKV[wv][lane + 64] = b1 * rn;
    }
    __syncthreads();
    const bf* WUQ = WSP(bf, OFF_WUQ) + (size_t)l * 768 * 192;
    const bf* WUKV = WSP(bf, OFF_WUKV) + (size_t)l * 768 * 128;
    for (int n = tid; n < 576; n += 256) {
        float acc[4] = {0.f, 0.f, 0.f, 0.f};
        for (int k = 0; k < 192; ++k) { const float w = bf2f(WUQ[(size_t)((n / 96) * 128 + n % 96) * 192 + k]);
#pragma unroll
            for (int q = 0; q < 4; ++q) acc[q] += sCQ[q][k] * w; }
#pragma unroll
        for (int q = 0; q < 4; ++q) sQ[q][n] = acc[q];
    }
    for (int n = tid; n < 768; n += 256) {
        float acc[4] = {0.f, 0.f, 0.f, 0.f};
        for (int k = 0; k < 128; ++k) { const float w = bf2f(WUKV[(size_t)n * 128 + k]);
#pragma unroll
            for (int q = 0; q < 4; ++q) acc[q] += sCKV[q][k] * w; }
#pragma unroll
        for (int q = 0; q < 4; ++q) sKV[q][n] = acc[q];
    }
    __syncthreads();
    if (tid < 48) {
        const int tok = tid / 12, h = (tid % 12) >> 1, which = tid & 1;
        const int t = t0 + tok, b = t >> 12, s = t & 4095;
        const float* rope = WSP(float, OFF_ROPE) + s * 32;
        const float* gain = (which ? p.in[I_MKG] : p.in[I_MQG]) + l * 96;
        const bf* kr = WSP(bf, OFF_KR) + (size_t)t * 32;
        bf* dst = WSP(bf, which ? OFF_MK : OFF_MQ) + ((size_t)(b * 6 + h) * S + s) * 96;
        float ss = 0.f;
        for (int d = 0; d < 96; ++d) {
            const float v = which ? (d < 64 ? sKV[tok][h * 128 + d] : bf2f(kr[d - 64])) : sQ[tok][h * 96 + d];
            ss += v * v;
        }
        const float rn = rsqrtf(ss * (1.f / 96.f) + EPS);
        for (int d = 0; d < 64; ++d) {
            const float v = which ? sKV[tok][h * 128 + d] : sQ[tok][h * 96 + d];
            dst[d] = f2bf(v * rn * gain[d]);
        }
        for (int i = 0; i < 16; ++i) {
            const float x1 = (which ? bf2f(kr[i]) : sQ[tok][h * 96 + 64 + i]) * rn * gain[64 + i];
            const float x2 = (which ? bf2f(kr[16 + i]) : sQ[tok][h * 96 + 80 + i]) * rn * gain[80 + i];
            const float cs = rope[i], sn = rope[16 + i];
            dst[64 + i] = f2bf(x1 * cs - x2 * sn);
            dst[80 + i] = f2bf(x1 * sn + x2 * cs);
        }
    }
    bf* mvt = WSP(bf, OFF_MVT);
    for (int e = tid; e < 4 * 384; e += 256) {
        const int tok = e / 384, r = e % 384, h = r >> 6, d = r & 63;
        const int t = t0 + tok, b = t >> 12, s = t & 4095;
        mvt[((size_t)(b * 6 + h) * 64 + d) * S + s] = f2bf(sKV[tok][h * 128 + 64 + d]);
    }
    __syncthreads();
    }
}

DI float rdlane(float v, int j) { return __int_as_float(__builtin_amdgcn_readlane(__float_as_int(v), j)); }

DI void ph_diff_attn_naive(const Params& p, int l, int bid, int nb) {
    for (int u = bid; u < NB * 6 * S / 4; u += nb) {
    const int lane = threadIdx.x & 63, gw = u * 4 + (threadIdx.x >> 6);
    const int q = gw & 4095, bh = gw >> 12, h = bh % 6, b = bh / 6;
    const bf* DQ = WSP(bf, OFF_DQ); const bf* DK = WSP(bf, OFF_DK); const bf* DVT = WSP(bf, OFF_DVT);
    float lam;
    {
        float d1 = 0.f, d2 = 0.f;
        for (int i = 0; i < 32; ++i) { d1 += p.in[I_LQ1][l * 32 + i] * p.in[I_LK1][l * 32 + i]; d2 += p.in[I_LQ2][l * 32 + i] * p.in[I_LK2][l * 32 + i]; }
        lam = expf(d1) - expf(d2) + lambda_init(l);
    }
    const float slope = exp2f(-8.f * (float)(h + 1) / 6.f);
    const float scale = 0.17677669529663687f;
    float q0[32], q1[32];
    {
        const bf* a = DQ + ((size_t)(bh * 2 + 0) * S + q) * 32; const bf* c = DQ + ((size_t)(bh * 2 + 1) * S + q) * 32;
#pragma unroll
        for (int d = 0; d < 32; ++d) { q0[d] = bf2f(a[d]); q1[d] = bf2f(c[d]); }
    }
    float m0 = -INFINITY, m1 = -INFINITY, l0 = 0.f, l1 = 0.f, o0 = 0.f, o1 = 0.f;
    const int nkb = (q >> 6) + 1;
    for (int kb = 0; kb < nkb; ++kb) {
        const int k = kb * 64 + lane;
        const uint4* ka = (const uint4*)(DK + ((size_t)(bh * 2 + 0) * S + k) * 32);
        const uint4* kc = (const uint4*)(DK + ((size_t)(bh * 2 + 1) * S + k) * 32);
        float s0 = 0.f, s1 = 0.f;
#pragma unroll
        for (int i = 0; i < 4; ++i) {
            const uint4 u = ka[i], w = kc[i];
            const unsigned uu[4] = {u.x, u.y, u.z, u.w}, ww[4] = {w.x, w.y, w.z, w.w};
#pragma unroll
            for (int e = 0; e < 4; ++e) {
                s0 += q0[i * 8 + e * 2] * lo16(uu[e]) + q0[i * 8 + e * 2 + 1] * hi16(uu[e]);
                s1 += q1[i * 8 + e * 2] * lo16(ww[e]) + q1[i * 8 + e * 2 + 1] * hi16(ww[e]);
            }
        }
        const float bias = -slope * fabsf((float)(q - k));
        s0 = s0 * scale + bias; s1 = s1 * scale + bias;
        const float n0 = fmaxf(m0, wave_max(s0)), n1 = fmaxf(m1, wave_max(s1));
        const float a0 = __expf(m0 - n0), a1 = __expf(m1 - n1);
        const float p0 = __expf(s0 - n0), p1 = __expf(s1 - n1);
        l0 = l0 * a0 + p0; l1 = l1 * a1 + p1; o0 *= a0; o1 *= a1; m0 = n0; m1 = n1;
        const uint4* vp = (const uint4*)(DVT + ((size_t)bh * 64 + lane) * S + kb * 64);
        uint4 v[8];
#pragma unroll
        for (int i = 0; i < 8; ++i) v[i] = vp[i];
#pragma unroll
        for (int i = 0; i < 8; ++i) {
            const unsigned vv[4] = {v[i].x, v[i].y, v[i].z, v[i].w};
#pragma unroll
            for (int e = 0; e < 4; ++e) {
                const int j = i * 8 + e * 2;
                const float va = lo16(vv[e]), vb = hi16(vv[e]);
                o0 += rdlane(p0, j) * va + rdlane(p0, j + 1) * vb;
                o1 += rdlane(p1, j) * va + rdlane(p1, j + 1) * vb;
            }
        }
    }
    const float L0 = wave_sum(l0), L1 = wave_sum(l1);
    const float o = o0 / L0 - lam * (o1 / L1);
    const float ss = wave_sum(o * o);
    WSP(bf, OFF_MIX)[(size_t)(b * S + q) * 1024 + 256 + h * 64 + lane] = f2bf(o * rsqrtf(ss * (1.f / 64.f) + EPS));
    }
}

DI void ph_mla_attn_naive(const Params& p, int l, int bid, int nb) {
    for (int u = bid; u < NB * 6 * S / 4; u += nb) {
    const int lane = threadIdx.x & 63, gw = u * 4 + (threadIdx.x >> 6);
    const int q = gw & 4095, bh = gw >> 12, h = bh % 6, b = bh / 6;
    const bf* MQ = WSP(bf, OFF_MQ); const bf* MK = WSP(bf, OFF_MK); const bf* MVT = WSP(bf, OFF_MVT);
    const float scale = 0.10206207261596575f;
    float qv[96];
    {
        const bf* a = MQ + ((size_t)bh * S + q) * 96;
#pragma unroll
        for (int d = 0; d < 96; ++d) qv[d] = bf2f(a[d]);
    }
    float m0 = -INFINITY, l0 = 0.f, o0 = 0.f;
    const int nkb = (q >> 6) + 1;
    for (int kb = 0; kb < nkb; ++kb) {
        const int k = kb * 64 + lane;
        const uint4* ka = (const uint4*)(MK + ((size_t)bh * S + k) * 96);
        float s0 = 0.f;
#pragma unroll
        for (int i = 0; i < 12; ++i) {
            const uint4 u = ka[i];
            const unsigned uu[4] = {u.x, u.y, u.z, u.w};
#pragma unroll
            for (int e = 0; e < 4; ++e) s0 += qv[i * 8 + e * 2] * lo16(uu[e]) + qv[i * 8 + e * 2 + 1] * hi16(uu[e]);
        }
        s0 *= scale;
        const float n0 = fmaxf(m0, wave_max(s0));
        const float a0 = __expf(m0 - n0), p0 = __expf(s0 - n0);
        l0 = l0 * a0 + p0; o0 *= a0; m0 = n0;
        const uint4* vp = (const uint4*)(MVT + ((size_t)bh * 64 + lane) * S + kb * 64);
        uint4 v[8];
#pragma unroll
        for (int i = 0; i < 8; ++i) v[i] = vp[i];
#pragma unroll
        for (int i = 0; i < 8; ++i) {
            const unsigned vv[4] = {v[i].x, v[i].y, v[i].z, v[i].w};
#pragma unroll
            for (int e = 0; e < 4; ++e) {
                const int j = i * 8 + e * 2;
                o0 += rdlane(p0, j) * lo16(vv[e]) + rdlane(p0, j + 1) * hi16(vv[e]);
            }
        }
    }
    const float o = o0 / wave_sum(l0);
    const float ss = wave_sum(o * o);
    const int t = b * S + q;
    WSP(bf, OFF_MIX)[(size_t)t * 1024 + 640 + h * 64 + lane] = f2bf(o);
    if (lane == 0) WSP(float, OFF_SSQM)[t * 8 + h] = ss;
    }
}

DI void ph_mla_norm_fix(const Params& p, int bid, int nb) {
    for (int gid = bid * 256 + threadIdx.x; gid < NT * 48; gid += nb * 256) {
    const int t = gid / 48, c8 = (gid % 48) * 8;
    const float* sq = WSP(float, OFF_SSQM) + t * 8;
    const float rn = rsqrtf((sq[0] + sq[1] + sq[2] + sq[3] + sq[4] + sq[5]) * (1.f / 384.f) + EPS);
    bf* m = WSP(bf, OFF_MIX) + (size_t)t * 1024 + 640 + c8;
    float v[8];
#pragma unroll
    for (int j = 0; j < 8; ++j) v[j] = bf2f(m[j]) * rn;
    store8(m, v);
    }
}

DI void ph_p4_gemm_naive(const Params& p, int l, int bid, int nb, unsigned char* smem) {
    float* sA = (float*)smem; float* sB = sA + 16 * 68;
    if (bid == 0 && threadIdx.x < 32) WSP(int, OFF_CTL)[CTL_CNT + threadIdx.x] = 0;
    for (int u = bid; u < 4096; u += nb) {
    const int mt = u / 16, nt = u % 16;
    const bf* A = WSP(bf, OFF_MIX) + (size_t)mt * 64 * D;
    const bf* Bt = WSP(bf, OFF_WOUT) + (size_t)l * 1024 * 1024 + (size_t)(nt * 64) * 1024;
    const float* xin = (l == 0 ? p.in[I_X] : WSP(float, OFF_XFA)) + (size_t)mt * 64 * D + nt * 64;
    float* x1 = p.out + (size_t)mt * 64 * D + nt * 64;
    bf* xb1 = WSP(bf, OFF_XB) + (size_t)mt * 64 * D + nt * 64;
    const float* g2 = p.in[I_N2G] + l * 1024 + nt * 64;
    ngemm_tile<true>(1024, [=](int r, int k) { return bf2f(A[(size_t)r * D + k]); }, [=](int k, int c) { return bf2f(Bt[(size_t)c * 1024 + k]); },
               [=](int r, int c, float v) { const float x = xin[(size_t)r * D + c] + v; x1[(size_t)r * D + c] = x; xb1[(size_t)r * D + c] = f2bf(x * g2[c]); }, sA, sB);
    }
}

DI void ph_router(const Params& p, int l, int bid, int nb) {
    const int lane = threadIdx.x & 63, gw = bid * 4 + (threadIdx.x >> 6), nw = nb * 4;
    const float* WR = WSP(float, OFF_WR) + (size_t)l * 36 * 1024;
    int* cnt = WSP(int, OFF_CTL) + CTL_CNT;
    int* list = WSP(int, OFF_LIST);
    float* gatew = WSP(float, OFF_GATEW);
    for (int t = gw; t < NT; t += nw) {
        const float* x = p.out + (size_t)t * D;
        float4 xv[4]; float ss = 0.f;
#pragma unroll
        for (int i = 0; i < 4; ++i) { xv[i] = *(const float4*)(x + lane * 4 + 256 * i); ss += xv[i].x * xv[i].x + xv[i].y * xv[i].y + xv[i].z * xv[i].z + xv[i].w * xv[i].w; }
        ss = wave_sum(ss);
        const float rinv = rsqrtf(ss * (1.f / 1024.f) + EPS);
        float lg[4];
#pragma unroll
        for (int j = 0; j < 4; ++j) {
            float a = 0.f;
#pragma unroll
            for (int i = 0; i < 4; ++i) { const float4 w = *(const float4*)(WR + (size_t)j * 1024 + lane * 4 + 256 * i); a += xv[i].x * w.x + xv[i].y * w.y + xv[i].z * w.z + xv[i].w * w.w; }
            lg[j] = wave_sum(a) * rinv + p.in[I_RGB][l * 4 + j];
        }
        int g = 0; float gm = lg[0];
#pragma unroll
        for (int j = 1; j < 4; ++j) if (lg[j] > gm) { gm = lg[j]; g = j; }
        float gs = 0.f;
#pragma unroll
        for (int j = 0; j < 4; ++j) gs += __expf(lg[j] - gm);
        const float pg_top = 1.f / gs;
        float e[8];
#pragma unroll
        for (int j = 0; j < 8; ++j) {
            const float* wrow = WR + (size_t)(4 + g * 8 + j) * 1024;
            float a = 0.f;
#pragma unroll
            for (int i = 0; i < 4; ++i) { const float4 w = *(const float4*)(wrow + lane * 4 + 256 * i); a += xv[i].x * w.x + xv[i].y * w.y + xv[i].z * w.z + xv[i].w * w.w; }
            e[j] = wave_sum(a) * rinv + p.in[I_REB][l * 32 + g * 8 + j];
        }
        int i1 = 0; float v1 = e[0];
#pragma unroll
        for (int i = 1; i < 8; ++i) if (e[i] > v1) { v1 = e[i]; i1 = i; }
        int i2 = -1; float v2 = -INFINITY;
#pragma unroll
        for (int i = 0; i < 8; ++i) if (i != i1 && e[i] > v2) { v2 = e[i]; i2 = i; }
        const float p1 = 1.f, p2 = __expf(v2 - v1);
        const float g1 = pg_top * p1 / (p1 + p2), g2 = pg_top * p2 / (p1 + p2);
        if (lane == 0) {
            const int e1 = g * 8 + i1, e2 = g * 8 + i2;
            const int pos1 = atomicAdd(&cnt[e1], 1); list[e1 * 16384 + pos1] = t * 2;
            const int pos2 = atomicAdd(&cnt[e2], 1); list[e2 * 16384 + pos2] = t * 2 + 1;
            gatew[t * 2] = g1; gatew[t * 2 + 1] = g2;
            WSP(float, OFF_RINV2)[t] = rinv;
        }
    }
}

DI void ph_moe_up_naive(const Params& p, int l, int bid, int nb, unsigned char* smem) {
    float* sA = (float*)smem; float* sB = sA + 16 * 68; int* sTok = (int*)(sB + 16 * 68);
    for (int u = bid; u < 32 * 256 * 8; u += nb) {
    const int nt = u & 7, rb = (u >> 3) & 255, e = u >> 11;
    const int* cnt = WSP(int, OFF_CTL) + CTL_CNT;
    const int n = cnt[e];
    if (rb * 64 >= n) continue;
    int base = 0; for (int i = 0; i < e; ++i) base += cnt[i];
    if (threadIdx.x < 64) { const int r = rb * 64 + threadIdx.x; sTok[threadIdx.x] = r < n ? (WSP(int, OFF_LIST)[e * 16384 + r] >> 1) : -1; }
    __syncthreads();
    const bf* XB = WSP(bf, OFF_XB);
    const float* W = (nt < 4 ? p.in[I_W1] : p.in[I_W3]) + (size_t)(l * 32 + e) * 1024 * 256 + (nt & 3) * 64;
    const float* rinv2 = WSP(float, OFF_RINV2);
    float* H = WSP(float, OFF_H13) + (size_t)(base + rb * 64) * 512 + nt * 64;
    const int* tk = sTok;
    ngemm_tile<false>(1024, [=](int r, int k) { const int t = tk[r]; return t >= 0 ? bf2f(XB[(size_t)t * D + k]) : 0.f; }, [=](int k, int c) { return bf2f(f2bf(W[(size_t)k * 256 + c])); },
               [=](int r, int c, float v) { const int t = tk[r]; if (t >= 0) H[(size_t)r * 512 + c] = v * rinv2[t]; }, sA, sB);
    }
}

DI void ph_moe_act_naive(const Params& p, int bid, int nb) {
    for (int gid = bid * 256 + threadIdx.x; gid < 32768 * 32; gid += nb * 256) {
    const int row = gid >> 5, c8 = (gid & 31) * 8;
    const float* H = WSP(float, OFF_H13) + (size_t)row * 512;
    float v[8];
#pragma unroll
    for (int j = 0; j < 8; ++j) { const float a = H[c8 + j], b = H[256 + c8 + j]; v[j] = a * sigmoidf_(a) * b; }
    store8(WSP(bf, OFF_ACT) + (size_t)row * 256 + c8, v);
    }
}

DI void ph_moe_down_naive(const Params& p, int l, int bid, int nb, unsigned char* smem) {
    float* sA = (float*)smem; float* sB = sA + 16 * 68; int* sEnt = (int*)(sB + 16 * 68);
    for (int u = bid; u < 32 * 256 * 16; u += nb) {
    const int nt = u & 15, rb = (u >> 4) & 255, e = u >> 12;
    const int* cnt = WSP(int, OFF_CTL) + CTL_CNT;
    const int n = cnt[e];
    if (rb * 64 >= n) continue;
    int base = 0; for (int i = 0; i < e; ++i) base += cnt[i];
    if (threadIdx.x < 64) { const int r = rb * 64 + threadIdx.x; sEnt[threadIdx.x] = r < n ? WSP(int, OFF_LIST)[e * 16384 + r] : -1; }
    __syncthreads();
    const bf* A = WSP(bf, OFF_ACT) + (size_t)(base + rb * 64) * 256;
    const float* W = p.in[I_W2] + (size_t)(l * 32 + e) * 256 * 1024 + nt * 64;
    const float* gatew = WSP(float, OFF_GATEW);
    bf* Y = WSP(bf, OFF_Y);
    const int* en = sEnt;
    ngemm_tile<false>(256, [=](int r, int k) { return en[r] >= 0 ? bf2f(A[(size_t)r * 256 + k]) : 0.f; }, [=](int k, int c) { return bf2f(f2bf(W[(size_t)k * 1024 + c])); },
               [=](int r, int c, float v) { const int en_ = en[r]; if (en_ >= 0) Y[((size_t)(en_ & 1) * NT + (en_ >> 1)) * D + nt * 64 + c] = f2bf(v * gatew[en_]); }, sA, sB);
    }
}

DI void ph_combine(const Params& p, int last, int bid, int nb) {
    const int lane = threadIdx.x & 63, gw = bid * 4 + (threadIdx.x >> 6), nw = nb * 4;
    const bf* Y = WSP(bf, OFF_Y);
    float* xo = last ? p.out : WSP(float, OFF_XFA);
    bf* xb = WSP(bf, OFF_XB);
    for (int t = gw; t < NT; t += nw) {
        float ss = 0.f;
#pragma unroll
        for (int i = 0; i < 2; ++i) {
            const int c = (lane + 64 * i) * 8;
            const float4 a = *(const float4*)(p.out + (size_t)t * D + c), b = *(const float4*)(p.out + (size_t)t * D + c + 4);
            const uint4 y0 = *(const uint4*)(Y + (size_t)t * D + c), y1 = *(const uint4*)(Y + ((size_t)NT + t) * D + c);
            float v[8] = {a.x, a.y, a.z, a.w, b.x, b.y, b.z, b.w};
            const unsigned u0[4] = {y0.x, y0.y, y0.z, y0.w}, u1[4] = {y1.x, y1.y, y1.z, y1.w};
#pragma unroll
            for (int e = 0; e < 4; ++e) { v[2 * e] += lo16(u0[e]) + lo16(u1[e]); v[2 * e + 1] += hi16(u0[e]) + hi16(u1[e]); }
#pragma unroll
            for (int j = 0; j < 8; ++j) ss += v[j] * v[j];
            *(float4*)(xo + (size_t)t * D + c) = make_float4(v[0], v[1], v[2], v[3]);
            *(float4*)(xo + (size_t)t * D + c + 4) = make_float4(v[4], v[5], v[6], v[7]);
            if (!last) store8(xb + (size_t)t * D + c, v);
        }
        ss = wave_sum(ss);
        if (!last && lane == 0) WSP(float, OFF_RINV1)[t] = rsqrtf(ss * (1.f / 1024.f) + EPS);
    }
}

#define FAST_P1 1
#define FAST_ATTN 1
#define FAST_P4 1
#define FAST_MOE 1
#define FAST_MLAUP 1
constexpr int SMEM_BYTES = GEMM_SMEM;
#define GRID_SYNC() grid.sync()

__global__ void __launch_bounds__(256) mega_fwd(Params p) {
    extern __shared__ __attribute__((aligned(16))) unsigned char smem[];
    cg::grid_group grid = cg::this_grid();
    const int bid = blockIdx.x, nb = gridDim.x;
    ph_prep_weights(p, bid, nb, smem);
    ph_prep_misc(p, bid, nb);
    ph_prep_x(p, bid, nb);
    GRID_SYNC();
    for (int l = 0; l < 2; ++l) {
#if FAST_P1
        ph_p1(p, l, bid, nb, smem);
        GRID_SYNC();
#else
        for (int ch = 0; ch < 4; ++ch) {
            ph_p1_gemm_naive(p, l, ch, bid, nb, smem);
            GRID_SYNC();
            ph_p1_route_naive(p, l, ch, bid, nb);
            GRID_SYNC();
        }
#endif
        ph_lru(p, l, 0, bid, nb, smem);
#if FAST_MLAUP
        ph_mla_up(p, l, bid, nb, smem);
#else
        ph_mla_up_naive(p, l, bid, nb, smem);
#endif
        GRID_SYNC();
#if FAST_ATTN
        ph_p3(p, l, smem);
#else
        ph_lru(p, l, 1, bid, nb, smem);
        ph_diff_attn_naive(p, l, bid, nb);
        ph_mla_attn_naive(p, l, bid, nb);
#endif
        GRID_SYNC();
#if FAST_P4
        ph_p4(p, l, bid, nb, smem);
#else
        ph_mla_norm_fix(p, bid, nb);
        GRID_SYNC();
        ph_p4_gemm_naive(p, l, bid, nb, smem);
#endif
        GRID_SYNC();
        ph_router(p, l, bid, nb);
        GRID_SYNC();
#if FAST_MOE
        ph_moe_up(p, l, bid, nb, smem);
        GRID_SYNC();
        ph_moe_down(p, l, bid, nb, smem);
#else
        ph_moe_up_naive(p, l, bid, nb, smem);
        GRID_SYNC();
        ph_moe_act_naive(p, bid, nb);
        GRID_SYNC();
        ph_moe_down_naive(p, l, bid, nb, smem);
#endif
        GRID_SYNC();
        ph_combine(p, l == 1, bid, nb);
        GRID_SYNC();
    }
}

extern "C" void kernel_launch(void* const* d_in, const int* in_sizes, int n_in, void* d_out, int out_size, void* d_ws, size_t ws_size, hipStream_t stream) {
    if (n_in != N_IN || ws_size < WS_TOTAL || out_size != NT * D) { fprintf(stderr, "kernel_launch: bad sizes n_in %d ws %zu (need %zu) out %d\n", n_in, ws_size, (size_t)WS_TOTAL, out_size); return; }
    static int grid_blocks = 0;
    if (!grid_blocks) {
        int dev = 0, cus = 0, per_cu = 0;
        (void)hipGetDevice(&dev);
        (void)hipDeviceGetAttribute(&cus, hipDeviceAttributeMultiprocessorCount, dev);
        (void)hipFuncSetAttribute((const void*)mega_fwd, hipFuncAttributeMaxDynamicSharedMemorySize, SMEM_BYTES);
        (void)hipOccupancyMaxActiveBlocksPerMultiprocessor(&per_cu, (const void*)mega_fwd, 256, SMEM_BYTES);
        if (per_cu < 1) { fprintf(stderr, "kernel_launch: occupancy query says %d blocks per CU\n", per_cu); return; }
        if (per_cu > 2) per_cu = 2;
        grid_blocks = cus * per_cu;
    }
    Params p{};
    for (int i = 0; i < N_IN; ++i) p.in[i] = (const float*)d_in[i];
    p.out = (float*)d_out; p.ws = (unsigned char*)d_ws;
    void* args[] = {&p};
    hipError_t e = hipLaunchCooperativeKernel((const void*)mega_fwd, dim3(grid_blocks), dim3(256), args, SMEM_BYTES, stream);
    if (e != hipSuccess) fprintf(stderr, "cooperative launch failed: %s (grid %d)\n", hipGetErrorString(e), grid_blocks);
}
```

```cpp
#include <hip/hip_runtime.h>
#include <hip/hip_cooperative_groups.h>
namespace cg = cooperative_groups;
#include <cstdio>
#include <cstdint>

#define DI __device__ __forceinline__
typedef unsigned short bf;

constexpr int NB = 4, S = 4096, D = 1024, NT = NB * S, NPROJ = 2048;
constexpr float EPS = 1e-6f;
enum { I_X = 0, I_N1G, I_WIN, I_CONVW, I_CONVB, I_WA, I_BA, I_WX, I_BX, I_LAM, I_LOUTG, I_DQG, I_DKG, I_LQ1, I_LK1, I_LQ2, I_LK2,
       I_SUBG, I_CQG, I_CKVG, I_WUQ, I_WUKV, I_MQG, I_MKG, I_MOUTG, I_WOUT, I_N2G, I_RGW, I_RGB, I_REW, I_REB, I_W1, I_W3, I_W2, N_IN };

struct Params { const float* in[N_IN]; float* out; unsigned char* ws; };

constexpr size_t AL(size_t x) { return (x + 255) & ~(size_t)255; }
constexpr size_t OFF_WIN = 0;
constexpr size_t OFF_WOUT = OFF_WIN + (size_t)2 * 2048 * 1024 * 2;
constexpr size_t OFF_WUQ = OFF_WOUT + (size_t)2 * 1024 * 1024 * 2;
constexpr size_t OFF_WUKV = OFF_WUQ + (size_t)2 * 768 * 192 * 2;
constexpr size_t OFF_WAX = OFF_WUKV + (size_t)2 * 768 * 128 * 2;
constexpr size_t OFF_WR = OFF_WAX + (size_t)2 * 2 * 4 * 64 * 64 * 2;
constexpr size_t OFF_ROPE = AL(OFF_WR + (size_t)2 * 64 * 1024 * 2);
constexpr size_t OFF_CTL = OFF_ROPE + (size_t)4096 * 32 * 4;
constexpr size_t OFF_RINV1 = OFF_CTL + 65536;
constexpr size_t OFF_RINV2 = OFF_RINV1 + (size_t)NT * 4;
constexpr size_t OFF_SSQ2 = OFF_RINV2 + (size_t)NT * 4;
constexpr size_t OFF_SSQM = OFF_SSQ2 + (size_t)NT * 8 * 4;
constexpr size_t OFF_TOT = OFF_SSQM + (size_t)NT * 8 * 4;
constexpr size_t OFF_GATEW = OFF_TOT + (size_t)4 * 64 * 2 * 256 * 4;
constexpr size_t OFF_LIST = OFF_GATEW + (size_t)NT * 2 * 4;
constexpr size_t OFF_XFA = OFF_LIST + (size_t)32 * 16384 * 4;
constexpr size_t OFF_XB = OFF_XFA + (size_t)NT * D * 4;
constexpr size_t OFF_MIX = OFF_XB + (size_t)NT * D * 2;
constexpr size_t OFF_STAGE = OFF_MIX + (size_t)NT * D * 2;
constexpr size_t OFF_LX = OFF_STAGE;
constexpr size_t OFF_GG = OFF_LX + (size_t)NT * 256 * 2;
constexpr size_t OFF_DQ = OFF_GG + (size_t)NT * 256 * 2;
constexpr size_t OFF_DK = OFF_DQ + (size_t)NT * 384 * 2;
constexpr size_t OFF_DVT = OFF_DK + (size_t)NT * 384 * 2;
constexpr size_t OFF_CQ = OFF_DVT + (size_t)NT * 384 * 2;
constexpr size_t OFF_CKV = OFF_CQ + (size_t)NT * 192 * 2;
constexpr size_t OFF_KR = OFF_CKV + (size_t)NT * 128 * 2;
constexpr size_t OFF_MQ = OFF_KR + (size_t)NT * 32 * 2;
constexpr size_t OFF_MK = OFF_MQ + (size_t)NT * 576 * 2;
constexpr size_t OFF_MVT = OFF_MK + (size_t)NT * 576 * 2;
constexpr size_t OFF_STAGE_END = OFF_MVT + (size_t)NT * 384 * 2;
constexpr size_t OFF_Y = OFF_STAGE;
constexpr size_t OFF_ACT = OFF_Y + (size_t)2 * NT * D * 2;
constexpr size_t OFF_H13 = OFF_Y;
constexpr size_t WS_TOTAL = OFF_STAGE_END;
static_assert(OFF_ACT + (size_t)(32768 + 128) * 256 * 2 <= OFF_STAGE_END, "alias");
constexpr int CTL_CNT = 0;
constexpr int CTL_LAM = 1024 + 4 * 256;
constexpr int CTL_Q = 1024;

#define WSP(T, off) ((T*)(p.ws + (off)))

DI int tidx() { int t = threadIdx.x; asm volatile("" : "+v"(t)); return t; }
DI unsigned xcc_id() { return (unsigned)__builtin_amdgcn_s_getreg((3 << 11) | 20) & 0xFu; }
DI float bf2f(bf v) { return __uint_as_float(((unsigned)v) << 16); }
DI bf f2bf(float f) { unsigned u = __float_as_uint(f); u += 0x7fffu + ((u >> 16) & 1u); return (bf)(u >> 16); }
typedef __bf16 hwbf16x2 __attribute__((ext_vector_type(2)));
typedef float f32x2 __attribute__((ext_vector_type(2)));
DI unsigned pack2(float a, float b) { f32x2 v = {a, b}; return __builtin_bit_cast(unsigned, __builtin_convertvector(v, hwbf16x2)); }
DI float lo16(unsigned u) { return __uint_as_float(u << 16); }
DI float hi16(unsigned u) { return __uint_as_float(u & 0xffff0000u); }
DI float wave_sum(float v) { for (int o = 32; o > 0; o >>= 1) v += __shfl_xor(v, o); return v; }
DI float wave_max(float v) { for (int o = 32; o > 0; o >>= 1) v = fmaxf(v, __shfl_xor(v, o)); return v; }
DI float gelu_tanh(float x) { return 0.5f * x * (1.f + tanhf(0.7978845608028654f * (x + 0.044715f * x * x * x))); }
DI float sigmoidf_(float x) { return 1.f / (1.f + __expf(-x)); }
DI float lambda_init(int l) { return l == 0 ? 0.2f : 0.35550906757f; }
DI void store8(bf* dst, const float* v) { uint4 u; u.x = pack2(v[0], v[1]); u.y = pack2(v[2], v[3]); u.z = pack2(v[4], v[5]); u.w = pack2(v[6], v[7]); *(uint4*)dst = u; }

template <class SCOL, class GAIN>
DI void tr_tile(const float* src, int lds_, bf* dst, int K, int n0, int k0, SCOL scol, GAIN gain, float* tile) {
    const int tid = tidx();
    const int nn = tid & 63;
    const int sc = scol(n0 + nn);
#pragma unroll
    for (int i = 0; i < 16; ++i) {
        const int kk = (tid >> 6) + 4 * i;
        float v = 0.f;
        if (sc >= 0) v = src[(size_t)(k0 + kk) * lds_ + sc] * gain(k0 + kk);
        tile[kk * 65 + nn] = v;
    }
    __syncthreads();
#pragma unroll
    for (int i = 0; i < 2; ++i) {
        const int id = tid + 256 * i, n = id >> 3, kc = (id & 7) * 8;
        float v[8];
#pragma unroll
        for (int j = 0; j < 8; ++j) v[j] = tile[(kc + j) * 65 + n];
        store8(dst + (size_t)(n0 + n) * K + k0 + kc, v);
    }
    __syncthreads();
}

DI int win_col(int n) {
    if (n < 1856) return n;
    if (n < 1888) return 1984 + (n - 1856);
    if (n < 1920) return -1;
    return 1856 + (n - 1920);
}

constexpr int PW_WIN = 2 * 32 * 16;
constexpr int PW_WOUT = 2 * 16 * 16;
constexpr int PW_WUQ = 2 * 12 * 3;
constexpr int PW_WUKV = 2 * 12 * 2;
constexpr int PW_WAX = 2 * 2 * 4;
constexpr int PW_TOTAL = PW_WIN + PW_WOUT + PW_WUQ + PW_WUKV + PW_WAX;

DI void prep_weights_unit(const Params& p, int u, float* tile) {
    if (u < PW_WIN) {
        const int l = u / 512, r = u % 512, nt = r / 16, kt = r % 16;
        const float* g = p.in[I_N1G] + l * 1024;
        tr_tile(p.in[I_WIN] + (size_t)l * 1024 * 2016, 2016, WSP(bf, OFF_WIN) + (size_t)l * 2048 * 1024, 1024, nt * 64, kt * 64,
                [](int n) { return win_col(n); }, [g](int k) { return g[k]; }, tile);
        return;
    }
    u -= PW_WIN;
    if (u < PW_WOUT) {
        const int l = u / 256, r = u % 256, nt = r / 16, kt = r % 16;
        const float* g_lru = p.in[I_LOUTG] + l * 256; const float* g_sub = p.in[I_SUBG] + l * 64; const float* g_mla = p.in[I_MOUTG] + l * 384;
        const float li = 1.f - lambda_init(l);
        tr_tile(p.in[I_WOUT] + (size_t)l * 1024 * 1024, 1024, WSP(bf, OFF_WOUT) + (size_t)l * 1024 * 1024, 1024, nt * 64, kt * 64,
                [](int n) { return n; },
                [=](int k) { return k < 256 ? g_lru[k] : (k < 640 ? g_sub[(k - 256) & 63] * li : g_mla[k - 640]); }, tile);
        return;
    }
    u -= PW_WOUT;
    if (u < PW_WUQ) {
        const int l = u / 36, r = u % 36, nt = r / 3, kt = r % 3;
        const float* g = p.in[I_CQG] + l * 192;
        tr_tile(p.in[I_WUQ] + (size_t)l * 192 * 576, 576, WSP(bf, OFF_WUQ) + (size_t)l * 768 * 192, 192, nt * 64, kt * 64,
                [](int n) { return (n & 127) < 96 ? (n >> 7) * 96 + (n & 127) : -1; }, [g](int k) { return g[k]; }, tile);
        return;
    }
    u -= PW_WUQ;
    if (u < PW_WUKV) {
        const int l = u / 24, r = u % 24, nt = r / 2, kt = r % 2;
        const float* g = p.in[I_CKVG] + l * 128;
        tr_tile(p.in[I_WUKV] + (size_t)l * 128 * 768, 768, WSP(bf, OFF_WUKV) + (size_t)l * 768 * 128, 128, nt * 64, kt * 64,
                [](int n) { return n; }, [g](int k) { return g[k]; }, tile);
        return;
    }
    u -= PW_WUKV;
    {
        const int l = u / 8, which = (u / 4) & 1, blk = u & 3;
        const float* src = (which ? p.in[I_WX] : p.in[I_WA]) + (size_t)(l * 4 + blk) * 4096;
        tr_tile(src, 64, WSP(bf, OFF_WAX) + (size_t)((l * 2 + which) * 4 + blk) * 4096, 64, 0, 0,
                [](int n) { return n; }, [](int) { return 1.f; }, tile);
    }
}

DI void ph_prep_weights(const Params& p, int bid, int nb, unsigned char* smem) {
    float* tile = (float*)smem;
    for (int u = bid; u < PW_TOTAL; u += nb) prep_weights_unit(p, u, tile);
}

DI void ph_prep_misc(const Params& p, int bid, int nb) {
    const int gid = bid * 256 + tidx(), gsz = nb * 256;
    bf* wr = WSP(bf, OFF_WR);
    for (int i = gid; i < 2 * 64 * 1024; i += gsz) {
        const int l = i >> 16, j = (i >> 10) & 63, k = i & 1023;
        float w = 0.f;
        if (j < 4) w = p.in[I_RGW][(size_t)(l * 1024 + k) * 4 + j];
        else if (j < 36) w = p.in[I_REW][(size_t)(l * 1024 + k) * 32 + (j - 4)];
        wr[i] = f2bf(w);
    }
    float* rope = WSP(float, OFF_ROPE);
    for (int i = gid; i < 4096 * 16; i += gsz) {
        const int s = i >> 4, f = i & 15;
        const float inv_freq = (float)exp2(-(double)f / 16.0 * 13.287712379549449);
        const float angf = (float)s * inv_freq;
        double a = (double)angf;
        const double twopi = 6.283185307179586476925;
        a -= twopi * rint(a / twopi);
        const double hh = 0.5 * a, h2 = hh * hh;
        double sn = 1.0, cs = 1.0, ts = 1.0, tc = 1.0;
#pragma unroll
        for (int n = 1; n <= 10; ++n) {
            tc *= -h2 / (double)((2 * n - 1) * (2 * n));
            ts *= -h2 / (double)((2 * n) * (2 * n + 1));
            cs += tc; sn += ts;
        }
        sn *= hh;
        rope[s * 32 + f] = (float)(cs * cs - sn * sn);
        rope[s * 32 + 16 + f] = (float)(2.0 * sn * cs);
    }
    if (gid < 32) WSP(int, OFF_CTL)[CTL_CNT + gid * 32] = 0;
    if (gid < 2) {
        float d1 = 0.f, d2 = 0.f;
        for (int i = 0; i < 32; ++i) { d1 += p.in[I_LQ1][gid * 32 + i] * p.in[I_LK1][gid * 32 + i]; d2 += p.in[I_LQ2][gid * 32 + i] * p.in[I_LK2][gid * 32 + i]; }
        WSP(float, OFF_CTL)[CTL_LAM + gid] = expf(d1) - expf(d2) + lambda_init(gid);
    }
}

DI void ph_prep_x(const Params& p, int bid, int nb) {
    const int lane = tidx() & 63, gw = bid * 4 + (tidx() >> 6), nw = nb * 4;
    const float* x = p.in[I_X];
    bf* xb = WSP(bf, OFF_XB);
    float* rinv = WSP(float, OFF_RINV1);
    for (int t = gw; t < NT; t += nw) {
        float ss = 0.f;
#pragma unroll
        for (int i = 0; i < 2; ++i) {
            const int c = (lane + 64 * i) * 8;
            const float4 a = *(const float4*)(x + (size_t)t * D + c), b = *(const float4*)(x + (size_t)t * D + c + 4);
            float v[8] = {a.x, a.y, a.z, a.w, b.x, b.y, b.z, b.w};
#pragma unroll
            for (int j = 0; j < 8; ++j) ss += v[j] * v[j];
            store8(xb + (size_t)t * D + c, v);
        }
        ss = wave_sum(ss);
        if (lane == 0) rinv[t] = rsqrtf(ss * (1.f / 1024.f) + EPS);
    }
}

template <bool BT, class LA, class LB, class EPI>
DI void ngemm_tile(int K, LA la, LB lb, EPI epi, float* sA, float* sB) {
    const int tid = tidx(), ty = tid >> 4, tx = tid & 15;
    float acc[4][4];
#pragma unroll
    for (int i = 0; i < 4; ++i)
#pragma unroll
        for (int j = 0; j < 4; ++j) acc[i][j] = 0.f;
    for (int k0 = 0; k0 < K; k0 += 16) {
#pragma unroll
        for (int i = 0; i < 4; ++i) {
            const int e = tid + 256 * i;
            sA[(e & 15) * 68 + (e >> 4)] = la(e >> 4, k0 + (e & 15));
            if (BT) sB[(e & 15) * 68 + (e >> 4)] = lb(k0 + (e & 15), e >> 4);
            else sB[(e >> 6) * 68 + (e & 63)] = lb(k0 + (e >> 6), e & 63);
        }
        __syncthreads();
#pragma unroll
        for (int kk = 0; kk < 16; ++kk) {
            const float4 a = *(const float4*)(sA + kk * 68 + ty * 4), b = *(const float4*)(sB + kk * 68 + tx * 4);
            const float av[4] = {a.x, a.y, a.z, a.w}, bv[4] = {b.x, b.y, b.z, b.w};
#pragma unroll
            for (int i = 0; i < 4; ++i)
#pragma unroll
                for (int j = 0; j < 4; ++j) acc[i][j] += av[i] * bv[j];
        }
        __syncthreads();
    }
#pragma unroll
    for (int i = 0; i < 4; ++i)
#pragma unroll
        for (int j = 0; j < 4; ++j) epi(ty * 4 + i, tx * 4 + j, acc[i][j]);
}

DI void ph_p1_gemm_naive(const Params& p, int l, int chunk, int bid, int nb, unsigned char* smem) {
    float* sA = (float*)smem; float* sB = sA + 16 * 68;
    for (int u = bid; u < 2048; u += nb) {
    const int mt = u / 8, nt = u % 8;
    const bf* A = WSP(bf, OFF_XB) + (size_t)mt * 64 * D;
    const bf* Bt = WSP(bf, OFF_WIN) + (size_t)l * 2048 * 1024 + (size_t)(chunk * 512 + nt * 64) * 1024;
    const float* rinv = WSP(float, OFF_RINV1) + mt * 64;
    float* C = WSP(float, OFF_MIX) + (size_t)mt * 64 * 512 + nt * 64;
    ngemm_tile<true>(1024, [=](int r, int k) { return bf2f(A[(size_t)r * D + k]); }, [=](int k, int c) { return bf2f(Bt[(size_t)c * 1024 + k]); },
               [=](int r, int c, float v) { C[(size_t)r * 512 + c] = v * rinv[r]; }, sA, sB);
    }
}

template <class ACC>
DI void route_tile(const Params& p, int l, int mt, int nt, ACC T) {
    const int tid = tidx();
    const int t0 = mt * 128, b = t0 >> 12, s0 = t0 & 4095;
    if (nt < 4) {
        bf* dst = WSP(bf, nt < 2 ? OFF_LX : OFF_GG);
        const int cb = (nt & 1) * 128;
#pragma unroll 1
        for (int it = 0; it < 8; ++it) {
            const int id = it * 256 + tid, r = id >> 4, c8 = (id & 15) * 8;
            float v[8];
#pragma unroll
            for (int j = 0; j < 8; ++j) { v[j] = T(r, c8 + j); if (nt >= 2) v[j] = gelu_tanh(v[j]); }
            store8(dst + (size_t)(t0 + r) * 256 + cb + c8, v);
        }
    } else if (nt < 10) {
        const bool isk = nt >= 7;
        const int g0 = (nt - (isk ? 7 : 4)) * 128;
        const float* gain = (isk ? p.in[I_DKG] : p.in[I_DQG]) + l * 32;
        bf* dst = WSP(bf, isk ? OFF_DK : OFF_DQ);
#pragma unroll 1
        for (int it = 0; it < 8; ++it) {
            const int id = it * 256 + tid, r = id >> 4, c8 = (id & 15) * 8;
            float v[8], ss = 0.f;
#pragma unroll
            for (int j = 0; j < 8; ++j) { v[j] = T(r, c8 + j); ss += v[j] * v[j]; }
            ss += __shfl_xor(ss, 1); ss += __shfl_xor(ss, 2);
            const float rn = rsqrtf(ss * (1.f / 32.f) + EPS);
            const int col = g0 + c8, h = col >> 6, m = (col >> 5) & 1, d0 = col & 31;
#pragma unroll
            for (int j = 0; j < 8; ++j) v[j] = v[j] * rn * gain[d0 + j];
            store8(dst + ((size_t)((b * 6 + h) * 2 + m) * S + s0 + r) * 32 + d0, v);
        }
    } else if (nt < 13) {
        const int g0 = (nt - 10) * 128;
        bf* dst = WSP(bf, OFF_DVT);
#pragma unroll 1
        for (int it = 0; it < 8; ++it) {
            const int id = it * 256 + tid, c = id & 127, rc = id >> 7;
            float v[8];
#pragma unroll
            for (int j = 0; j < 8; ++j) v[j] = T(8 * rc + j, c);
            const int col = g0 + c, h = col >> 6, d = col & 63;
            store8(dst + ((size_t)(b * 6 + h) * 64 + d) * S + s0 + 8 * rc, v);
        }
    } else {
#pragma unroll 1
        for (int it = 0; it < 8; ++it) {
            const int id = it * 256 + tid, r = id >> 4, c8 = (id & 15) * 8;
            float v[8];
#pragma unroll
            for (int j = 0; j < 8; ++j) v[j] = T(r, c8 + j);
            if (nt == 13) store8(WSP(bf, OFF_CQ) + (size_t)(t0 + r) * 192 + c8, v);
            else if (nt == 14) {
                if (c8 < 64) store8(WSP(bf, OFF_CQ) + (size_t)(t0 + r) * 192 + 128 + c8, v);
                else if (c8 < 96) store8(WSP(bf, OFF_KR) + (size_t)(t0 + r) * 32 + (c8 - 64), v);
            } else store8(WSP(bf, OFF_CKV) + (size_t)(t0 + r) * 128 + c8, v);
        }
    }
}

DI void ph_p1_route_naive(const Params& p, int l, int chunk, int bid, int nb) {
    for (int u = bid; u < 512; u += nb) {
    const int mt = u / 4, ntl = u % 4;
    const float* C = WSP(float, OFF_MIX) + (size_t)mt * 128 * 512 + ntl * 128;
    route_tile(p, l, mt, chunk * 4 + ntl, [=](int r, int c) { return C[(size_t)r * 512 + c]; });
    }
}


typedef short bf16x8 __attribute__((ext_vector_type(8)));
typedef short s16x4 __attribute__((ext_vector_type(4)));
typedef float f32x16 __attribute__((ext_vector_type(16)));
typedef __attribute__((address_space(3))) s16x4 lds_s16x4;
#define MFMA32(a, b, c) __builtin_amdgcn_mfma_f32_32x32x16_bf16((a), (b), (c), 0, 0, 0)
constexpr int G_A_BYTES = 16384, G_B_BYTES = 20480;
constexpr int G_OFF_B = 2 * G_A_BYTES;
constexpr int G_LOOP_BYTES = 2 * G_A_BYTES + 2 * G_B_BYTES;
constexpr int G_OFF_AUX = G_LOOP_BYTES;
constexpr int GEMM_SMEM = G_LOOP_BYTES + 1024;

DI unsigned cvt_pk_bf16(float a, float b) { return pack2(a, b); }

struct RowLoader {
    const bf* base; size_t ld;
    DI uint4 load(int i, int kt) const { return *(const uint4*)(base + (size_t)(32 * i) * ld + kt * 64); }
};
struct GatherLoader {
    const bf* rp[4];
    DI uint4 load(int i, int kt) const { return rp[i] ? *(const uint4*)(rp[i] + kt * 64) : make_uint4(0, 0, 0, 0); }
};
struct TrLoader {
    const float* base; size_t ldn;
    DI float4 load(int i, int kt) const { return *(const float4*)(base + (size_t)(kt * 64 + 8 * i) * ldn); }
};

template <int BMODE, class AL, class BL>
DI void gemm_mainloop(f32x16 (&acc)[2][2], int nk, const AL& al, const BL& bl, unsigned char* smem) {
    const int tid = tidx(), lane = tid & 63, wv = tid >> 6, wr = wv >> 1, wc = wv & 1;
    const int r31 = lane & 31, h = lane >> 5, sw = (r31 >> 1) & 7;
    const int a_wr = (tid >> 3) * 128 + (((tid & 7) ^ ((tid >> 4) & 7)) << 4);
    const int b_wr1 = (tid >> 5) * 320 + (tid & 31) * 8;
    const int a_rd = (wr * 64 + r31) * 128, b_rd0 = (wc * 64 + r31) * 128;
    const int b_rd1 = (8 * h + ((lane & 15) >> 2)) * 320 + (wc * 64 + 16 * ((lane >> 4) & 1) + 4 * (lane & 3)) * 2;
    uint4 ra[4]; uint4 rb0[4]; float4 rb1[8];
#pragma unroll
    for (int i = 0; i < 4; ++i) ra[i] = al.load(i, 0);
    if constexpr (BMODE == 0) {
#pragma unroll
        for (int i = 0; i < 4; ++i) rb0[i] = bl.load(i, 0);
    } else {
#pragma unroll
        for (int i = 0; i < 8; ++i) rb1[i] = bl.load(i, 0);
    }
#pragma unroll
    for (int i = 0; i < 4; ++i) *(uint4*)(smem + a_wr + i * 4096) = ra[i];
    if constexpr (BMODE == 0) {
#pragma unroll
        for (int i = 0; i < 4; ++i) *(uint4*)(smem + G_OFF_B + a_wr + i * 4096) = rb0[i];
    } else {
#pragma unroll
        for (int i = 0; i < 8; ++i) *(uint2*)(smem + G_OFF_B + b_wr1 + i * 2560) = make_uint2(cvt_pk_bf16(rb1[i].x, rb1[i].y), cvt_pk_bf16(rb1[i].z, rb1[i].w));
    }
    __syncthreads();
#pragma unroll 1
    for (int kt = 0; kt < nk; ++kt) {
        const int cur = kt & 1;
        const bool more = kt + 1 < nk;
        if (more) {
#pragma unroll
            for (int i = 0; i < 4; ++i) ra[i] = al.load(i, kt + 1);
            if constexpr (BMODE == 0) {
#pragma unroll
                for (int i = 0; i < 4; ++i) rb0[i] = bl.load(i, kt + 1);
            } else {
#pragma unroll
                for (int i = 0; i < 8; ++i) rb1[i] = bl.load(i, kt + 1);
            }
        }
        const unsigned char* sA = smem + cur * G_A_BYTES;
        const unsigned char* sB = smem + G_OFF_B + cur * G_B_BYTES;
#pragma unroll
        for (int ks = 0; ks < 4; ++ks) {
            const int co = ((2 * ks + h) ^ sw) << 4;
            bf16x8 a[2], b[2];
#pragma unroll
            for (int mi = 0; mi < 2; ++mi) a[mi] = *(const bf16x8*)(sA + a_rd + mi * 4096 + co);
            if constexpr (BMODE == 0) {
#pragma unroll
                for (int ni = 0; ni < 2; ++ni) b[ni] = *(const bf16x8*)(sB + b_rd0 + ni * 4096 + co);
            } else {
#pragma unroll
                for (int ni = 0; ni < 2; ++ni) {
                    const s16x4 lo = __builtin_amdgcn_ds_read_tr16_b64_v4i16((lds_s16x4*)(sB + b_rd1 + ks * 5120 + ni * 64));
                    const s16x4 hi = __builtin_amdgcn_ds_read_tr16_b64_v4i16((lds_s16x4*)(sB + b_rd1 + ks * 5120 + 1280 + ni * 64));
                    b[ni] = __builtin_shufflevector(lo, hi, 0, 1, 2, 3, 4, 5, 6, 7);
                }
            }
#pragma unroll
            for (int mi = 0; mi < 2; ++mi)
#pragma unroll
                for (int ni = 0; ni < 2; ++ni) acc[mi][ni] = MFMA32(a[mi], b[ni], acc[mi][ni]);
        }
        if (more) {
            unsigned char* dA = smem + (cur ^ 1) * G_A_BYTES;
            unsigned char* dB = smem + G_OFF_B + (cur ^ 1) * G_B_BYTES;
#pragma unroll
            for (int i = 0; i < 4; ++i) *(uint4*)(dA + a_wr + i * 4096) = ra[i];
            if constexpr (BMODE == 0) {
#pragma unroll
                for (int i = 0; i < 4; ++i) *(uint4*)(dB + a_wr + i * 4096) = rb0[i];
            } else {
#pragma unroll
                for (int i = 0; i < 8; ++i) *(uint2*)(dB + b_wr1 + i * 2560) = make_uint2(cvt_pk_bf16(rb1[i].x, rb1[i].y), cvt_pk_bf16(rb1[i].z, rb1[i].w));
            }
        }
        __syncthreads();
    }
}

DI void acc_zero(f32x16 (&acc)[2][2]) {
#pragma unroll
    for (int mi = 0; mi < 2; ++mi)
#pragma unroll
        for (int ni = 0; ni < 2; ++ni)
#pragma unroll
            for (int r = 0; r < 16; ++r) acc[mi][ni][r] = 0.f;
}
DI void acc_stage(const f32x16 (&acc)[2][2], float* sC) {
    const int lane = tidx() & 63, wv = tidx() >> 6, wr = wv >> 1, wc = wv & 1, r31 = lane & 31, h = lane >> 5;
#pragma unroll
    for (int mi = 0; mi < 2; ++mi)
#pragma unroll
        for (int ni = 0; ni < 2; ++ni)
#pragma unroll
            for (int r = 0; r < 16; ++r)
                sC[(wr * 64 + mi * 32 + (r & 3) + 8 * (r >> 2) + 4 * h) * 128 + wc * 64 + ni * 32 + r31] = acc[mi][ni][r];
    __syncthreads();
}

DI void ph_p1(const Params& p, int l, int bid, int nb, unsigned char* smem) {
    const int tid = tidx();
    const bf* XB = WSP(bf, OFF_XB);
    const bf* W = WSP(bf, OFF_WIN) + (size_t)l * 2048 * 1024;
    const float* rinv = WSP(float, OFF_RINV1);
    float* sC = (float*)smem;
    for (int u = bid; u < 2048; u += nb) {
        const int mt = u >> 4, nt = u & 15;
        RowLoader al{XB + (size_t)(mt * 128 + (tid >> 3)) * 1024 + (tid & 7) * 8, 1024};
        RowLoader bl{W + (size_t)(nt * 128 + (tid >> 3)) * 1024 + (tid & 7) * 8, 1024};
        f32x16 acc[2][2];
        acc_zero(acc);
        gemm_mainloop<0>(acc, 16, al, bl, smem);
        acc_stage(acc, sC);
        const float* rv = rinv + mt * 128;
        route_tile(p, l, mt, nt, [=](int r, int c) { return sC[r * 128 + c] * rv[r]; });
        __syncthreads();
    }
}


DI void ph_p4(const Params& p, int l, int bid, int nb, unsigned char* smem) {
    const int tid = tidx(), lane = tid & 63, wv = tid >> 6, wr = wv >> 1, h = lane >> 5;
    if (bid == 0 && tid < 32) WSP(int, OFF_CTL)[CTL_CNT + tid * 32] = 0;
    const bf* MIX = WSP(bf, OFF_MIX);
    const bf* W = WSP(bf, OFF_WOUT) + (size_t)l * 1024 * 1024;
    const float* xin = l == 0 ? p.in[I_X] : WSP(float, OFF_XFA);
    const float* g2 = p.in[I_N2G] + l * 1024;
    bf* xb1 = WSP(bf, OFF_XB);
    float* sC = (float*)smem; float* sRN = (float*)(smem + G_OFF_AUX);
    for (int u = bid; u < 1024; u += nb) {
        const int mt = u >> 3, nt = u & 7;
        if (tid < 128) { const float* sq = WSP(float, OFF_SSQM) + (size_t)(mt * 128 + tid) * 8; sRN[tid] = rsqrtf((sq[0] + sq[1] + sq[2] + sq[3] + sq[4] + sq[5]) * (1.f / 384.f) + EPS); }
        const bf* abase = MIX + (size_t)(mt * 128 + (tid >> 3)) * 1024 + (tid & 7) * 8;
        const bf* bbase = W + (size_t)(nt * 128 + (tid >> 3)) * 1024 + (tid & 7) * 8;
        f32x16 acc[2][2];
        acc_zero(acc);
        { RowLoader al{abase + 640, 1024}, bl{bbase + 640, 1024}; gemm_mainloop<0>(acc, 6, al, bl, smem); }
#pragma unroll
        for (int mi = 0; mi < 2; ++mi)
#pragma unroll
            for (int r = 0; r < 16; ++r) {
                const float sc = sRN[wr * 64 + mi * 32 + (r & 3) + 8 * (r >> 2) + 4 * h];
                acc[mi][0][r] *= sc; acc[mi][1][r] *= sc;
            }
        { RowLoader al{abase, 1024}, bl{bbase, 1024}; gemm_mainloop<0>(acc, 10, al, bl, smem); }
        acc_stage(acc, sC);
#pragma unroll 1
        for (int it = 0; it < 8; ++it) {
            const int id = it * 256 + tid, r = id >> 4, c8 = (id & 15) * 8;
            const size_t o = (size_t)(mt * 128 + r) * 1024 + nt * 128 + c8;
            const float4 x0 = *(const float4*)(xin + o), x1 = *(const float4*)(xin + o + 4);
            const float4 c0 = *(const float4*)(sC + r * 128 + c8), c1 = *(const float4*)(sC + r * 128 + c8 + 4);
            const float4 ga = *(const float4*)(g2 + nt * 128 + c8), gb = *(const float4*)(g2 + nt * 128 + c8 + 4);
            float v[8] = {x0.x + c0.x, x0.y + c0.y, x0.z + c0.z, x0.w + c0.w, x1.x + c1.x, x1.y + c1.y, x1.z + c1.z, x1.w + c1.w};
            *(float4*)(p.out + o) = make_float4(v[0], v[1], v[2], v[3]);
            *(float4*)(p.out + o + 4) = make_float4(v[4], v[5], v[6], v[7]);
            float ss = 0.f;
#pragma unroll
            for (int j = 0; j < 8; ++j) ss += v[j] * v[j];
            ss += __shfl_xor(ss, 1); ss += __shfl_xor(ss, 2); ss += __shfl_xor(ss, 4); ss += __shfl_xor(ss, 8);
            if ((id & 15) == 0) WSP(float, OFF_SSQ2)[(size_t)(mt * 128 + r) * 8 + nt] = ss;
            const float gg[8] = {ga.x, ga.y, ga.z, ga.w, gb.x, gb.y, gb.z, gb.w};
#pragma unroll
            for (int j = 0; j < 8; ++j) v[j] *= gg[j];
            store8(xb1 + o, v);
        }
        __syncthreads();
    }
}


DI void ph_router_fast(const Params& p, int l, int bid, int nb, unsigned char* smem) {
    const int tid = tidx(), lane = tid & 63, w = tid >> 6, r31 = lane & 31, h = lane >> 5;
    const bf* WR = WSP(bf, OFF_WR) + (size_t)l * 64 * 1024;
    const bf* XB = WSP(bf, OFF_XB);
    float* sP = (float*)smem;
    int* cnt = WSP(int, OFF_CTL) + CTL_CNT;
    int* list = WSP(int, OFF_LIST);
    float* gatew = WSP(float, OFF_GATEW);
    for (int u = bid; u < NT / 32; u += nb) {
        const int t0 = u * 32;
        f32x16 acc[2];
#pragma unroll
        for (int mi = 0; mi < 2; ++mi)
#pragma unroll
            for (int r = 0; r < 16; ++r) acc[mi][r] = 0.f;
        const bf* xa = XB + (size_t)(t0 + r31) * 1024 + w * 256 + 8 * h;
        const bf* wa = WR + (size_t)r31 * 1024 + w * 256 + 8 * h;
#pragma unroll 4
        for (int ks = 0; ks < 16; ++ks) {
            const bf16x8 xb = *(const bf16x8*)(xa + 16 * ks);
            const bf16x8 a0 = *(const bf16x8*)(wa + 16 * ks), a1 = *(const bf16x8*)(wa + 32 * 1024 + 16 * ks);
            acc[0] = MFMA32(a0, xb, acc[0]);
            acc[1] = MFMA32(a1, xb, acc[1]);
        }
#pragma unroll
        for (int mi = 0; mi < 2; ++mi)
#pragma unroll
            for (int r = 0; r < 16; ++r) sP[(w * 64 + mi * 32 + (r & 3) + 8 * (r >> 2) + 4 * h) * 33 + r31] = acc[mi][r];
        __syncthreads();
        if (tid < 32) {
            const int t = t0 + tid;
            const float* sq = WSP(float, OFF_SSQ2) + (size_t)t * 8;
            const float rinv = rsqrtf((sq[0] + sq[1] + sq[2] + sq[3] + sq[4] + sq[5] + sq[6] + sq[7]) * (1.f / 1024.f) + EPS);
            float lg[4];
#pragma unroll
            for (int j = 0; j < 4; ++j) lg[j] = (sP[j * 33 + tid] + sP[(64 + j) * 33 + tid] + sP[(128 + j) * 33 + tid] + sP[(192 + j) * 33 + tid]) * rinv + p.in[I_RGB][l * 4 + j];
            int g = 0; float gm = lg[0];
#pragma unroll
            for (int j = 1; j < 4; ++j) if (lg[j] > gm) { gm = lg[j]; g = j; }
            float gs = 0.f;
#pragma unroll
            for (int j = 0; j < 4; ++j) gs += __expf(lg[j] - gm);
            const float pg_top = 1.f / gs;
            float e[8];
#pragma unroll
            for (int j = 0; j < 8; ++j) {
                const int jj = 4 + g * 8 + j;
                e[j] = (sP[jj * 33 + tid] + sP[(64 + jj) * 33 + tid] + sP[(128 + jj) * 33 + tid] + sP[(192 + jj) * 33 + tid]) * rinv + p.in[I_REB][l * 32 + g * 8 + j];
            }
            int i1 = 0; float v1 = e[0];
#pragma unroll
            for (int i = 1; i < 8; ++i) if (e[i] > v1) { v1 = e[i]; i1 = i; }
            int i2 = -1; float v2 = -INFINITY;
#pragma unroll
            for (int i = 0; i < 8; ++i) if (i != i1 && e[i] > v2) { v2 = e[i]; i2 = i; }
            const float p2 = __expf(v2 - v1);
            const float g1 = pg_top / (1.f + p2), g2 = pg_top * p2 / (1.f + p2);
            const int e1 = g * 8 + i1, e2 = g * 8 + i2;
            int* sCnt = (int*)(smem + 40960); int* sBase = sCnt + 32;
            sCnt[tid] = 0;
            const int rk1 = atomicAdd(&sCnt[e1], 1);
            const int rk2 = atomicAdd(&sCnt[e2], 1);
            const int mine = sCnt[tid];
            if (mine > 0) sBase[tid] = atomicAdd(&cnt[tid * 32], mine);
            list[e1 * 16384 + sBase[e1] + rk1] = t * 2;
            list[e2 * 16384 + sBase[e2] + rk2] = t * 2 + 1;
            gatew[t * 2] = g1; gatew[t * 2 + 1] = g2;
            WSP(float, OFF_RINV2)[t] = rinv;
        }
        __syncthreads();
    }
}

DI void moe_sched_init(const Params& p, int* aux) {
    if (tidx() == 0) {
        const int* cnt = WSP(int, OFF_CTL) + CTL_CNT;
        int rb = 0, base = 0;
        for (int e = 0; e < 32; ++e) { const int c = cnt[e * 32]; aux[e] = c; aux[32 + e] = rb; aux[65 + e] = base; rb += (c + 127) >> 7; base += c; }
        aux[64] = rb; aux[97] = base;
    }
    __syncthreads();
}
struct MoeUnit { int e, base; };
DI MoeUnit moe_unit(const Params& p, const int* aux, int rbg, int* sEnt) {
    int e = 0;
    while (aux[33 + e] <= rbg) ++e;
    const int rb = rbg - aux[32 + e];
    const int n = aux[e] - rb * 128;
    if (tidx() < 128) sEnt[tidx()] = (int)tidx() < n ? WSP(int, OFF_LIST)[e * 16384 + rb * 128 + tidx()] : -1;
    __syncthreads();
    MoeUnit mu; mu.e = e; mu.base = aux[65 + e] + rb * 128;
    return mu;
}

DI void ph_moe_up(const Params& p, int l, int bid, int nb, unsigned char* smem) {
    const int tid = tidx();
    int* aux = (int*)(smem + G_OFF_AUX); int* sEnt = aux + 128;
    float* sC = (float*)smem;
    moe_sched_init(p, aux);
    const int units = aux[64] * 4;
    const bf* XB = WSP(bf, OFF_XB);
    const float* rinv2 = WSP(float, OFF_RINV2);
    bf* ACT = WSP(bf, OFF_ACT);
    for (int u = bid; u < units; u += nb) {
        const int q = u & 3;
        const MoeUnit mu = moe_unit(p, aux, u >> 2, sEnt);
        const int e = mu.e, base = mu.base;
        GatherLoader al;
#pragma unroll
        for (int i = 0; i < 4; ++i) { const int en = sEnt[(tid >> 3) + 32 * i]; al.rp[i] = en >= 0 ? XB + (size_t)(en >> 1) * 1024 + (tid & 7) * 8 : nullptr; }
        const int n4 = tid & 31;
        TrLoader bl{(n4 < 16 ? p.in[I_W1] : p.in[I_W3]) + (size_t)(l * 32 + e) * 262144 + (size_t)(tid >> 5) * 256 + q * 64 + (n4 & 15) * 4, 256};
        f32x16 acc[2][2];
        acc_zero(acc);
        gemm_mainloop<1>(acc, 16, al, bl, smem);
        acc_stage(acc, sC);
#pragma unroll 1
        for (int it = 0; it < 4; ++it) {
            const int id = it * 256 + tid, r = id >> 3, c8 = (id & 7) * 8;
            const int en = sEnt[r];
            if (en >= 0) {
                const float rs = rinv2[en >> 1];
                float v[8];
#pragma unroll
                for (int j = 0; j < 8; ++j) { const float a = sC[r * 128 + c8 + j] * rs, b = sC[r * 128 + 64 + c8 + j] * rs; v[j] = a * sigmoidf_(a) * b; }
                store8(ACT + (size_t)(base + r) * 256 + q * 64 + c8, v);
            }
        }
        __syncthreads();
    }
}

DI void ph_moe_down(const Params& p, int l, int bid, int nb, unsigned char* smem) {
    const int tid = tidx();
    int* aux = (int*)(smem + G_OFF_AUX); int* sEnt = aux + 128;
    float* sC = (float*)smem;
    moe_sched_init(p, aux);
    const int units = aux[64] * 8;
    const bf* ACT = WSP(bf, OFF_ACT);
    const float* gatew = WSP(float, OFF_GATEW);
    bf* Y = WSP(bf, OFF_Y);
    for (int u = bid; u < units; u += nb) {
        const int nt = u & 7;
        const MoeUnit mu = moe_unit(p, aux, u >> 3, sEnt);
        const int e = mu.e, base = mu.base;
        RowLoader al{ACT + (size_t)(base + (tid >> 3)) * 256 + (tid & 7) * 8, 256};
        TrLoader bl{p.in[I_W2] + (size_t)(l * 32 + e) * 262144 + (size_t)(tid >> 5) * 1024 + nt * 128 + (tid & 31) * 4, 1024};
        f32x16 acc[2][2];
        acc_zero(acc);
        gemm_mainloop<1>(acc, 4, al, bl, smem);
        acc_stage(acc, sC);
#pragma unroll 1
        for (int it = 0; it < 8; ++it) {
            const int id = it * 256 + tid, r = id >> 4, c8 = (id & 15) * 8;
            const int en = sEnt[r];
            if (en >= 0) {
                const float gw = gatew[en];
                float v[8];
#pragma unroll
                for (int j = 0; j < 8; ++j) v[j] = sC[r * 128 + c8 + j] * gw;
                store8(Y + ((size_t)(en & 1) * NT + (en >> 1)) * 1024 + nt * 128 + c8, v);
            }
        }
        __syncthreads();
    }
}

DI void ph_mla_up(const Params& p, int l, int bid, int nb, unsigned char* smem) {
    const int tid = tidx();
    float* sC = (float*)smem; float* sRN = (float*)(smem + G_OFF_AUX);
    const float* ropet = WSP(float, OFF_ROPE);
    for (int u = bid; u < 128 * 12; u += nb) {
        const int mt = u / 12, j = u % 12, isq = j < 6, hd = isq ? j : j - 6;
        const int t0 = mt * 128, b = t0 >> 12, s0 = t0 & 4095;
        const int KD = isq ? 192 : 128;
        const bf* Asrc = isq ? WSP(bf, OFF_CQ) : WSP(bf, OFF_CKV);
        {
            const int r = tid >> 1, half = tid & 1, nch = KD / 16;
            const uint4* src = (const uint4*)(Asrc + (size_t)(t0 + r) * KD + half * (KD / 2));
            float ss = 0.f;
            for (int i = 0; i < nch; ++i) { const uint4 v = src[i]; const unsigned w[4] = {v.x, v.y, v.z, v.w};
#pragma unroll
                for (int e = 0; e < 4; ++e) { const float a = lo16(w[e]), c = hi16(w[e]); ss += a * a + c * c; } }
            ss += __shfl_xor(ss, 1);
            if (!half) sRN[r] = rsqrtf(ss / (float)KD + EPS);
        }
        RowLoader al{Asrc + (size_t)(t0 + (tid >> 3)) * KD + (tid & 7) * 8, (size_t)KD};
        const bf* Bsrc = isq ? WSP(bf, OFF_WUQ) + (size_t)l * 768 * 192 + (size_t)hd * 128 * 192 : WSP(bf, OFF_WUKV) + (size_t)l * 768 * 128 + (size_t)hd * 128 * 128;
        RowLoader bl{Bsrc + (size_t)(tid >> 3) * KD + (tid & 7) * 8, (size_t)KD};
        f32x16 acc[2][2];
        acc_zero(acc);
        gemm_mainloop<0>(acc, KD / 64, al, bl, smem);
        acc_stage(acc, sC);
        const float* gain = (isq ? p.in[I_MQG] : p.in[I_MKG]) + l * 96;
        const bf* KR = WSP(bf, OFF_KR);
        bf* dst = WSP(bf, isq ? OFF_MQ : OFF_MK);
#pragma unroll 1
        for (int it = 0; it < 8; ++it) {
            const int id = it * 256 + tid, r = id >> 4, c8 = (id & 15) * 8;
            const int t = t0 + r;
            const float rl = sRN[r];
            float v[8], w[8];
            const int pc = c8 < 80 ? c8 + 16 : c8 - 16;
#pragma unroll
            for (int jj = 0; jj < 8; ++jj) {
                float a = 0.f, bq = 0.f;
                if (c8 < 96) {
                    if (isq || c8 < 64) { a = sC[r * 128 + c8 + jj] * rl; if (c8 >= 64) bq = sC[r * 128 + pc + jj] * rl; }
                    else { a = bf2f(KR[(size_t)t * 32 + c8 - 64 + jj]); bq = bf2f(KR[(size_t)t * 32 + pc - 64 + jj]); }
                }
                v[jj] = a; w[jj] = bq;
            }
            float ss = 0.f;
#pragma unroll
            for (int jj = 0; jj < 8; ++jj) ss += v[jj] * v[jj];
            ss += __shfl_xor(ss, 1); ss += __shfl_xor(ss, 2); ss += __shfl_xor(ss, 4); ss += __shfl_xor(ss, 8);
            const float rn = rsqrtf(ss * (1.f / 96.f) + EPS);
            if (c8 < 96) {
                float o[8];
                if (c8 < 64) {
#pragma unroll
                    for (int jj = 0; jj < 8; ++jj) o[jj] = v[jj] * rn * gain[c8 + jj];
                } else {
                    const float* rp_ = ropet + (size_t)(s0 + r) * 32;
                    const bool first = c8 < 80;
#pragma unroll
                    for (int jj = 0; jj < 8; ++jj) {
                        const int i = (c8 & 15) + jj;
                        const float mine = v[jj] * rn * gain[c8 + jj], other = w[jj] * rn * gain[pc + jj];
                        const float cs = rp_[i], sn = rp_[16 + i];
                        o[jj] = first ? mine * cs - other * sn : other * sn + mine * cs;
                    }
                }
                store8(dst + ((size_t)(b * 6 + hd) * S + s0 + r) * 96 + c8, o);
            }
        }
        if (!isq) {
            bf* mvt = WSP(bf, OFF_MVT);
#pragma unroll 1
            for (int it = 0; it < 4; ++it) {
                const int id = it * 256 + tid, c = id & 63, rc = id >> 6;
                float v[8];
#pragma unroll
                for (int jj = 0; jj < 8; ++jj) v[jj] = sC[(8 * rc + jj) * 128 + 64 + c] * sRN[8 * rc + jj];
                store8(mvt + ((size_t)(b * 6 + hd) * 64 + c) * S + s0 + 8 * rc, v);
            }
        }
        __syncthreads();
    }
}

DI void lru_tile(const Params& p, int l, int b, int tile, int mode, float* sXC  , float* sY  ) {
    const int c = tidx(), blk = c >> 6, j = c & 63, lane = c & 63, wv = c >> 6;
    const bf* LX = WSP(bf, OFF_LX); const bf* GGp = WSP(bf, OFF_GG);
    const float cw0 = p.in[I_CONVW][(l * 4 + 0) * 256 + c], cw1 = p.in[I_CONVW][(l * 4 + 1) * 256 + c], cw2 = p.in[I_CONVW][(l * 4 + 2) * 256 + c],
                cw3 = p.in[I_CONVW][(l * 4 + 3) * 256 + c], cb = p.in[I_CONVB][l * 256 + c];
    const float ba = p.in[I_BA][l * 256 + c], bx = p.in[I_BX][l * 256 + c];
    const float lam = p.in[I_LAM][l * 256 + c];
    const float c8 = 8.f * log1pf(__expf(-lam));
    const uint4* wa4 = (const uint4*)(WSP(bf, OFF_WAX) + (size_t)(((l * 2 + 0) * 4 + blk) * 64 + j) * 64);
    const uint4* wx4 = (const uint4*)(WSP(bf, OFF_WAX) + (size_t)(((l * 2 + 1) * 4 + blk) * 64 + j) * 64);
    const int tb = b * S + tile * 64;
    float xm3 = 0.f, xm2 = 0.f, xm1 = 0.f;
    if (tile > 0) { xm3 = bf2f(LX[(size_t)(tb - 3) * 256 + c]); xm2 = bf2f(LX[(size_t)(tb - 2) * 256 + c]); xm1 = bf2f(LX[(size_t)(tb - 1) * 256 + c]); }
    float h = 0.f, aprod = 1.f;
    if (mode == 1) {
        const float* TOT = WSP(float, OFF_TOT) + (size_t)(b * 64) * 512;
        for (int i = 0; i < tile; ++i) h = TOT[i * 512 + c] * h + TOT[i * 512 + 256 + c];
    }
#pragma unroll 1
    for (int g = 0; g < 4; ++g) {
#pragma unroll 1
        for (int tt = 0; tt < 16; ++tt) {
            const float x0 = bf2f(LX[(size_t)(tb + g * 16 + tt) * 256 + c]);
            sXC[tt * 256 + c] = cw0 * xm3 + cw1 * xm2 + cw2 * xm1 + cw3 * x0 + cb;
            xm3 = xm2; xm2 = xm1; xm1 = x0;
        }
        __syncthreads();
#pragma unroll 1
        for (int tt = 0; tt < 16; ++tt) {
            float ra = ba, rx = bx;
            const float* xr = sXC + tt * 256 + blk * 64;
#pragma unroll
            for (int i = 0; i < 8; ++i) {
                const uint4 wa = wa4[i], wx = wx4[i];
                const unsigned a4[4] = {wa.x, wa.y, wa.z, wa.w}, x4[4] = {wx.x, wx.y, wx.z, wx.w};
#pragma unroll
                for (int q = 0; q < 4; ++q) {
                    const float v0 = xr[i * 8 + q * 2], v1 = xr[i * 8 + q * 2 + 1];
                    ra += v0 * lo16(a4[q]) + v1 * hi16(a4[q]);
                    rx += v0 * lo16(x4[q]) + v1 * hi16(x4[q]);
                }
            }
            const float r = sigmoidf_(ra), ig = sigmoidf_(rx);
            const float log_a = -c8 * r;
            const float a = __expf(log_a);
            const float bb = sqrtf(-expm1f(2.f * log_a)) * ig * sXC[tt * 256 + c];
            h = a * h + bb; aprod *= a;
            if (mode == 1) sY[tt * 256 + c] = h * bf2f(GGp[(size_t)(tb + g * 16 + tt) * 256 + c]);
        }
        __syncthreads();
        if (mode == 1) {
            bf* MIX = WSP(bf, OFF_MIX);
#pragma unroll 1
            for (int q = 0; q < 4; ++q) {
                const int tt = wv * 4 + q;
                const float y0 = sY[tt * 256 + lane], y1 = sY[tt * 256 + 64 + lane], y2 = sY[tt * 256 + 128 + lane], y3 = sY[tt * 256 + 192 + lane];
                const float rn = rsqrtf(wave_sum(y0 * y0 + y1 * y1 + y2 * y2 + y3 * y3) * (1.f / 256.f) + EPS);
                bf* m = MIX + (size_t)(tb + g * 16 + tt) * 1024 + lane;
                m[0] = f2bf(y0 * rn); m[64] = f2bf(y1 * rn); m[128] = f2bf(y2 * rn); m[192] = f2bf(y3 * rn);
            }
            __syncthreads();
        }
    }
    if (mode == 0) {
        float* TOT = WSP(float, OFF_TOT) + (size_t)(b * 64 + tile) * 512;
        TOT[c] = aprod; TOT[256 + c] = h;
    }
}


DI void lru_tile_fast(const Params& p, int l, int b, int tile, int mode, unsigned char* smem) {
    const int tid = tidx(), c = tid, lane = tid & 63, n = tid >> 6, r31 = lane & 31, h = lane >> 5;
    unsigned char* sXC = smem; float* sA = (float*)(smem + 16384); bf* sG = (bf*)(smem + 49152);
    const bf* LX = WSP(bf, OFF_LX); const bf* GGp = WSP(bf, OFF_GG);
    const float cw0 = p.in[I_CONVW][(l * 4 + 0) * 256 + c], cw1 = p.in[I_CONVW][(l * 4 + 1) * 256 + c], cw2 = p.in[I_CONVW][(l * 4 + 2) * 256 + c],
                cw3 = p.in[I_CONVW][(l * 4 + 3) * 256 + c], cb = p.in[I_CONVB][l * 256 + c];
    float gba[2], gbx[2], gc8[2];
#pragma unroll
    for (int ni = 0; ni < 2; ++ni) {
        const int ch = 64 * n + 32 * ni + r31;
        gba[ni] = p.in[I_BA][l * 256 + ch]; gbx[ni] = p.in[I_BX][l * 256 + ch];
        gc8[ni] = 8.f * log1pf(__expf(-p.in[I_LAM][l * 256 + ch]));
    }
    bf16x8 wb[2][2][4];
#pragma unroll
    for (int g = 0; g < 2; ++g)
#pragma unroll
        for (int ni = 0; ni < 2; ++ni)
#pragma unroll
            for (int ks = 0; ks < 4; ++ks)
                wb[g][ni][ks] = *(const bf16x8*)(WSP(bf, OFF_WAX) + (size_t)(((l * 2 + g) * 4 + n) * 64 + 32 * ni + r31) * 64 + 16 * ks + 8 * h);
    const int tb = b * S + tile * 64;
    float xm3 = 0.f, xm2 = 0.f, xm1 = 0.f;
    if (tile > 0) { xm3 = bf2f(LX[(size_t)(tb - 3) * 256 + c]); xm2 = bf2f(LX[(size_t)(tb - 2) * 256 + c]); xm1 = bf2f(LX[(size_t)(tb - 1) * 256 + c]); }
    float hs = 0.f, aprod = 1.f;
    if (mode == 1) {
        const float* TOT = WSP(float, OFF_TOT) + (size_t)(b * 64) * 512;
        for (int i = 0; i < tile; ++i) hs = TOT[i * 512 + c] * hs + TOT[i * 512 + 256 + c];
    }
    const int xoff = (c & 7) * 2, xch = (c & 63) >> 3;
#pragma unroll 1
    for (int half = 0; half < 2; ++half) {
        const int t0 = tb + half * 32;
        float xc[32];
#pragma unroll
        for (int t = 0; t < 32; ++t) {
            const float x0 = bf2f(LX[(size_t)(t0 + t) * 256 + c]);
            xc[t] = cw0 * xm3 + cw1 * xm2 + cw2 * xm1 + cw3 * x0 + cb;
            xm3 = xm2; xm2 = xm1; xm1 = x0;
            *(bf*)(sXC + (n * 32 + t) * 128 + ((xch ^ ((t >> 1) & 7)) << 4) + xoff) = f2bf(xc[t]);
        }
        __syncthreads();
        f32x16 acc[2][2];
#pragma unroll
        for (int g = 0; g < 2; ++g)
#pragma unroll
            for (int ni = 0; ni < 2; ++ni)
#pragma unroll
                for (int r = 0; r < 16; ++r) acc[g][ni][r] = 0.f;
#pragma unroll
        for (int ks = 0; ks < 4; ++ks) {
            const bf16x8 a = *(const bf16x8*)(sXC + (n * 32 + r31) * 128 + (((2 * ks + h) ^ ((r31 >> 1) & 7)) << 4));
#pragma unroll
            for (int g = 0; g < 2; ++g)
#pragma unroll
                for (int ni = 0; ni < 2; ++ni) acc[g][ni] = MFMA32(a, wb[g][ni][ks], acc[g][ni]);
        }
#pragma unroll
        for (int ni = 0; ni < 2; ++ni)
#pragma unroll
            for (int r = 0; r < 16; ++r) {
                const int t = (r & 3) + 8 * (r >> 2) + 4 * h, ch = 64 * n + 32 * ni + r31;
                const float rg = sigmoidf_(acc[0][ni][r] + gba[ni]), ig = sigmoidf_(acc[1][ni][r] + gbx[ni]);
                const float la = -gc8[ni] * rg, y = 2.f * la;
                const float av = __expf(la);
                const float em = y > -0.3f ? y * (1.f + y * (0.5f + y * (0.16666667f + y * 0.041666668f))) : av * av - 1.f;
                sA[t * 256 + ch] = av;
                sG[t * 256 + ch] = f2bf(sqrtf(fmaxf(-em, 0.f)) * ig);
            }
        __syncthreads();
#pragma unroll
        for (int t = 0; t < 32; ++t) {
            const float a = sA[t * 256 + c];
            hs = a * hs + bf2f(sG[t * 256 + c]) * xc[t];
            aprod *= a;
            if (mode == 1) sA[t * 256 + c] = hs * bf2f(GGp[(size_t)(t0 + t) * 256 + c]);
        }
        __syncthreads();
        if (mode == 1) {
            bf* MIX = WSP(bf, OFF_MIX);
#pragma unroll 1
            for (int q = 0; q < 8; ++q) {
                const int t = n * 8 + q;
                const float4 y = *(const float4*)(sA + t * 256 + 4 * lane);
                const float rn = rsqrtf(wave_sum(y.x * y.x + y.y * y.y + y.z * y.z + y.w * y.w) * (1.f / 256.f) + EPS);
                uint2 pk; pk.x = pack2(y.x * rn, y.y * rn); pk.y = pack2(y.z * rn, y.w * rn);
                *(uint2*)(MIX + (size_t)(t0 + t) * 1024 + 4 * lane) = pk;
            }
            __syncthreads();
        }
    }
    if (mode == 0) {
        float* TOT = WSP(float, OFF_TOT) + (size_t)(b * 64 + tile) * 512;
        TOT[c] = aprod; TOT[256 + c] = hs;
    }
}

DI void ph_lru(const Params& p, int l, int mode, int bid, int nb, unsigned char* smem) {
    float* sXC = (float*)smem; float* sY = sXC + 16 * 256;
    for (int u = bid; u < 256; u += nb) lru_tile_fast(p, l, u >> 6, u & 63, mode, smem);
}


DI int pi_row(int r) { return (r & 0x13) | ((r & 4) << 1) | ((r & 8) >> 1); }
DI float fexp2(float x) { return __builtin_amdgcn_exp2f(x); }


template <int KD>
DI void att_issue(uint4& k0r, uint4& k1r, uint4& k2r, uint4& v0r, uint4& v1r, const bf* Kg, const bf* Vg, int j) {
    const int tid = tidx(), k0 = j * 64;
    const bf* src = Kg + (size_t)k0 * KD + tid * 8;
    k0r = *(const uint4*)(src);
    if (KD == 96) { k1r = *(const uint4*)(src + 2048); k2r = *(const uint4*)(src + 4096); }
    const bf* vs = Vg + (size_t)(tid >> 3) * S + k0 + (tid & 7) * 8;
    v0r = *(const uint4*)(vs); v1r = *(const uint4*)(vs + (size_t)32 * S);
}
template <int KD>
DI void att_commit(const uint4& k0r, const uint4& k1r, const uint4& k2r, const uint4& v0r, const uint4& v1r, unsigned char* base) {
    constexpr int KRS = KD == 96 ? 208 : 80, KOFF_V = 64 * KRS;
    const int tid = tidx();
    if (KD == 96) {
        const int i0 = tid, i1 = tid + 256, i2 = tid + 512;
        *(uint4*)(base + (i0 / 12) * 208 + (i0 % 12) * 16) = k0r;
        *(uint4*)(base + (i1 / 12) * 208 + (i1 % 12) * 16) = k1r;
        *(uint4*)(base + (i2 / 12) * 208 + (i2 % 12) * 16) = k2r;
    } else {
        *(uint4*)(base + (tid >> 2) * 80 + (tid & 3) * 16) = k0r;
    }
    const int d = tid >> 3, ch = tid & 7;
    const int voff = KOFF_V + d * 128 + ((ch ^ ((d >> 1) & 7)) << 4);
    *(uint4*)(base + voff) = v0r;
    *(uint4*)(base + voff + 4096) = v1r;
}

template <int KD, bool BIAS>
DI void attn_tile(const unsigned char* base, bool diag, float T, float slc, const bf16x8 (&qf)[KD / 16], f32x16 (&O)[2], float& mrun, float& lrun,
                  int krow, int vsw, int w, int r31, int h) {
    constexpr int KRS = KD == 96 ? 208 : 80, KOFF_V = 64 * KRS, NKS = KD / 16;
    constexpr float C = (KD == 96 ? 0.10206207261596575f : 0.17677669529663687f) * 1.4426950408889634f;
    f32x16 sc[2];
#pragma unroll
    for (int kb2 = 0; kb2 < 2; ++kb2) {
#pragma unroll
        for (int r = 0; r < 16; ++r) sc[kb2][r] = 0.f;
        const unsigned char* kr = base + kb2 * 32 * KRS + krow;
#pragma unroll
        for (int ks = 0; ks < NKS; ++ks) sc[kb2] = MFMA32(*(const bf16x8*)(kr + ks * 32), qf[ks], sc[kb2]);
    }
    if (BIAS) {
        const int ql2 = diag ? 2 * ((w & 1) * 32 + r31) : 4096;
#pragma unroll
        for (int kb2 = 0; kb2 < 2; ++kb2)
#pragma unroll
            for (int r = 0; r < 16; ++r) {
                const int kl = 32 * kb2 + 16 * (r >> 3) + 8 * h + (r & 7);
                sc[kb2][r] = fmaf(slc, (float)min(kl, ql2 - kl), sc[kb2][r]);
            }
    }
    float mx = sc[0][0];
#pragma unroll
    for (int kb2 = 0; kb2 < 2; ++kb2)
#pragma unroll
        for (int r = 0; r < 16; ++r) mx = fmaxf(mx, sc[kb2][r]);
    mx = fmaxf(mx, __shfl_xor(mx, 32));
    const float mnew = fmaxf(mrun, mx * C + T);
    const float alpha = fexp2(mrun - mnew), off = T - mnew;
    float ls = 0.f;
    bf16x8 pf[4];
#pragma unroll
    for (int kb2 = 0; kb2 < 2; ++kb2)
#pragma unroll
        for (int s2 = 0; s2 < 2; ++s2) {
            float pv[8];
#pragma unroll
            for (int jj = 0; jj < 8; ++jj) { pv[jj] = fexp2(fmaf(sc[kb2][8 * s2 + jj], C, off)); ls += pv[jj]; }
            uint4 pk; pk.x = pack2(pv[0], pv[1]); pk.y = pack2(pv[2], pv[3]); pk.z = pack2(pv[4], pv[5]); pk.w = pack2(pv[6], pv[7]);
            pf[2 * kb2 + s2] = __builtin_bit_cast(bf16x8, pk);
        }
    mrun = mnew; lrun = lrun * alpha + ls;
#pragma unroll
    for (int db = 0; db < 2; ++db) {
#pragma unroll
        for (int r = 0; r < 16; ++r) O[db][r] *= alpha;
        const unsigned char* vr = base + KOFF_V + (32 * db + r31) * 128;
#pragma unroll
        for (int s4 = 0; s4 < 4; ++s4) O[db] = MFMA32(*(const bf16x8*)(vr + (((2 * s4 + h) ^ vsw) << 4)), pf[s4], O[db]);
    }
}

template <int KD, bool BIAS>
DI void attn_pass(const bf* Kg, const bf* Vg, const bf* qrow, float sl2, int qb, unsigned char* smem, f32x16 (&O)[2], float& lsum) {
    constexpr int KRS = KD == 96 ? 208 : 80, KOFF_V = 64 * KRS, BUF = KOFF_V + 8192, NKS = KD / 16;
    constexpr float C = (KD == 96 ? 0.10206207261596575f : 0.17677669529663687f) * 1.4426950408889634f;
    const int tid = tidx(), lane = tid & 63, w = tid >> 6, r31 = lane & 31, h = lane >> 5;
    const int mychunk = 2 * qb + (w >> 1), nt = 2 * qb + 2;
    bf16x8 qf[NKS];
#pragma unroll
    for (int ks = 0; ks < NKS; ++ks) qf[ks] = *(const bf16x8*)(qrow + 16 * ks);
    float mrun = -1e30f, lrun = 0.f;
#pragma unroll
    for (int db = 0; db < 2; ++db)
#pragma unroll
        for (int r = 0; r < 16; ++r) O[db][r] = 0.f;
    uint4 ak0, ak1, ak2, av0, av1, bk0, bk1, bk2, bv0, bv1;
    ak1 = make_uint4(0, 0, 0, 0); ak2 = ak1; bk1 = ak1; bk2 = ak1;
    att_issue<KD>(ak0, ak1, ak2, av0, av1, Kg, Vg, 0);
    att_issue<KD>(bk0, bk1, bk2, bv0, bv1, Kg, Vg, 1);
    att_commit<KD>(ak0, ak1, ak2, av0, av1, smem);
    __syncthreads();
    const int krow = pi_row(r31) * KRS + h * 16;
    const int vsw = (r31 >> 1) & 7;
    const float slc = sl2 * (1.f / C);
#pragma unroll 1
    for (int j = 0; j < nt; j += 2) {
        att_issue<KD>(ak0, ak1, ak2, av0, av1, Kg, Vg, min(j + 2, nt - 1));
        if (j <= mychunk) attn_tile<KD, BIAS>(smem, j == mychunk, BIAS ? -sl2 * 64.f * (float)(mychunk - j) : 0.f, slc, qf, O, mrun, lrun, krow, vsw, w, r31, h);
        att_commit<KD>(bk0, bk1, bk2, bv0, bv1, smem + BUF);
        __syncthreads();
        att_issue<KD>(bk0, bk1, bk2, bv0, bv1, Kg, Vg, min(j + 3, nt - 1));
        if (j + 1 <= mychunk) attn_tile<KD, BIAS>(smem + BUF, j + 1 == mychunk, BIAS ? -sl2 * 64.f * (float)(mychunk - j - 1) : 0.f, slc, qf, O, mrun, lrun, krow, vsw, w, r31, h);
        att_commit<KD>(ak0, ak1, ak2, av0, av1, smem);
        __syncthreads();
    }
    lsum = lrun + __shfl_xor(lrun, 32);
}

DI void attn_store(const f32x16 (&o)[2], float osc, unsigned char* stg, bf* dst  ) {
    const int lane = tidx() & 63, r31 = lane & 31, h = lane >> 5;
#pragma unroll
    for (int db = 0; db < 2; ++db)
#pragma unroll
        for (int g = 0; g < 4; ++g) {
            uint2 pk; pk.x = pack2(o[db][4 * g] * osc, o[db][4 * g + 1] * osc); pk.y = pack2(o[db][4 * g + 2] * osc, o[db][4 * g + 3] * osc);
            *(uint2*)(stg + r31 * 144 + (32 * db + 8 * g + 4 * h) * 2) = pk;
        }
#pragma unroll
    for (int i = 0; i < 4; ++i) {
        const int id = lane + 64 * i, row = id >> 3, ch = id & 7;
        *(uint4*)(dst + (size_t)row * 1024 + ch * 8) = *(const uint4*)(stg + row * 144 + ch * 16);
    }
}
constexpr int ATT_STG = 2 * (64 * 208 + 8192);

DI void mla_unit(const Params& p, int l, int bh, int qb, unsigned char* smem) {
    const int lane = tidx() & 63, w = tidx() >> 6, r31 = lane & 31, h = lane >> 5;
    const int b = bh / 6, hd = bh % 6, q = qb * 128 + 32 * w + r31;
    f32x16 O[2]; float lsum;
    attn_pass<96, false>(WSP(bf, OFF_MK) + (size_t)bh * S * 96, WSP(bf, OFF_MVT) + (size_t)bh * 64 * S,
                         WSP(bf, OFF_MQ) + ((size_t)bh * S + q) * 96 + 8 * h, 0.f, qb, smem, O, lsum);
    const float inv = 1.f / lsum;
    float ss = 0.f;
#pragma unroll
    for (int db = 0; db < 2; ++db)
#pragma unroll
        for (int r = 0; r < 16; ++r) { O[db][r] *= inv; ss += O[db][r] * O[db][r]; }
    ss += __shfl_xor(ss, 32);
    const int trow = b * S + qb * 128 + 32 * w;
    if (h == 0) WSP(float, OFF_SSQM)[(size_t)(trow + r31) * 8 + hd] = ss;
    attn_store(O, 1.f, smem + ATT_STG + w * (32 * 144), WSP(bf, OFF_MIX) + (size_t)trow * 1024 + 640 + hd * 64);
}

DI void diff_unit(const Params& p, int l, int bh, int qb, unsigned char* smem) {
    const int lane = tidx() & 63, w = tidx() >> 6, r31 = lane & 31, h = lane >> 5;
    const int b = bh / 6, hd = bh % 6, q = qb * 128 + 32 * w + r31;
    const float sl2 = exp2f(-8.f * (float)(hd + 1) / 6.f) * 1.4426950408889634f;
    const bf* Vg = WSP(bf, OFF_DVT) + (size_t)bh * 64 * S;
    f32x16 O0[2], O1[2]; float l0, l1;
    attn_pass<32, true>(WSP(bf, OFF_DK) + (size_t)(bh * 2) * S * 32, Vg, WSP(bf, OFF_DQ) + ((size_t)(bh * 2) * S + q) * 32 + 8 * h, sl2, qb, smem, O0, l0);
    {
        const float inv = 1.f / l0;
#pragma unroll
        for (int db = 0; db < 2; ++db)
#pragma unroll
            for (int r = 0; r < 16; ++r) O0[db][r] *= inv;
    }
    attn_pass<32, true>(WSP(bf, OFF_DK) + (size_t)(bh * 2 + 1) * S * 32, Vg, WSP(bf, OFF_DQ) + ((size_t)(bh * 2 + 1) * S + q) * 32 + 8 * h, sl2, qb, smem, O1, l1);
    const float lam1 = WSP(float, OFF_CTL)[CTL_LAM + l] / l1;
    float ss = 0.f;
#pragma unroll
    for (int db = 0; db < 2; ++db)
#pragma unroll
        for (int r = 0; r < 16; ++r) { const float v = O0[db][r] - lam1 * O1[db][r]; O0[db][r] = v; ss += v * v; }
    ss += __shfl_xor(ss, 32);
    const int trow = b * S + qb * 128 + 32 * w;
    attn_store(O0, rsqrtf(ss * (1.f / 64.f) + EPS), smem + ATT_STG + w * (32 * 144), WSP(bf, OFF_MIX) + (size_t)trow * 1024 + 256 + hd * 64);
}

constexpr int P3_QLEN = 192 + 32;
DI void ph_p3(const Params& p, int l, int qslot, unsigned char* smem) {
    int* qheads = WSP(int, OFF_CTL) + CTL_Q + qslot * 256;
    int* sU = (int*)(smem + GEMM_SMEM + 16);
    float* sXC = (float*)smem; float* sY = sXC + 16 * 256;
    const int x0 = (int)(xcc_id() & 7u);
    int qi = 0;
    for (;;) {
        const int x = (x0 + qi) & 7;
        if (tidx() == 0) *sU = atomicAdd(qheads + x * 32, 1);
        __syncthreads();
        const int u = *sU;
        __syncthreads();
        if (u >= P3_QLEN) { if (++qi == 8) break; continue; }
        if (u < 192) {
            const int qb = 31 - u / 6, c = u % 6, bh = x + 8 * (c % 3);
            if (c < 3) diff_unit(p, l, bh, qb, smem);
            else mla_unit(p, l, bh, qb, smem);
        } else {
            const int v = x * 32 + (u - 192);
            lru_tile_fast(p, l, v >> 6, v & 63, 1, smem);
        }
    }
}

DI void ph_mla_up_naive(const Params& p, int l, int bid, int nb, unsigned char* smem) {
    float (*sCQ)[192] = (float (*)[192])smem; float (*sCKV)[128] = (float (*)[128])(smem + 4 * 192 * 4);
    float (*sQ)[576] = (float (*)[576])(smem + 4 * 320 * 4); float (*sKV)[768] = (float (*)[768])(smem + 4 * 896 * 4);
    const int tid = tidx(), lane = tid & 63, wv = tid >> 6;
    for (int u = bid; u < NT / 4; u += nb) {
    const int t0 = u * 4;
    {
        const int t = t0 + wv;
        const bf* cq = WSP(bf, OFF_CQ) + (size_t)t * 192; const bf* ckv = WSP(bf, OFF_CKV) + (size_t)t * 128;
        float a0 = bf2f(cq[lane]), a1 = bf2f(cq[lane + 64]), a2 = bf2f(cq[lane + 128]);
        float ss = wave_sum(a0 * a0 + a1 * a1 + a2 * a2);
        float rn = rsqrtf(ss * (1.f / 192.f) + EPS);
        sCQ[wv][lane] = a0 * rn; sCQ[wv][lane + 64] = a1 * rn; sCQ[wv][lane + 128] = a2 * rn;
        float b0 = bf2f(ckv[lane]), b1 = bf2f(ckv[lane + 64]);
        ss = wave_sum(b0 * b0 + b1 * b1);
        rn = rsqrtf(ss * (1.f / 128.f) + EPS);
        sCKV[wv][lane] = b0 * rn; sCKV[wv][lane + 64] = b1 * rn;
    }
    __syncthreads();
    const bf* WUQ = WSP(bf, OFF_WUQ) + (size_t)l * 768 * 192;
    const bf* WUKV = WSP(bf, OFF_WUKV) + (size_t)l * 768 * 128;
    for (int n = tid; n < 576; n += 256) {
        float acc[4] = {0.f, 0.f, 0.f, 0.f};
        for (int k = 0; k < 192; ++k) { const float w = bf2f(WUQ[(size_t)((n / 96) * 128 + n % 96) * 192 + k]);
#pragma unroll
            for (int q = 0; q < 4; ++q) acc[q] += sCQ[q][k] * w; }
#pragma unroll
        for (int q = 0; q < 4; ++q) sQ[q][n] = acc[q];
    }
    for (int n = tid; n < 768; n += 256) {
        float acc[4] = {0.f, 0.f, 0.f, 0.f};
        for (int k = 0; k < 128; ++k) { const float w = bf2f(WUKV[(size_t)n * 128 + k]);
#pragma unroll
            for (int q = 0; q < 4; ++q) acc[q] += sCKV[q][k] * w; }
#pragma unroll
        for (int q = 0; q < 4; ++q) sKV[q][n] = acc[q];
    }
    __syncthreads();
    if (tid < 48) {
        const int tok = tid / 12, h = (tid % 12) >> 1, which = tid & 1;
        const int t = t0 + tok, b = t >> 12, s = t & 4095;
        const float* rope = WSP(float, OFF_ROPE) + s * 32;
        const float* gain = (which ? p.in[I_MKG] : p.in[I_MQG]) + l * 96;
        const bf* kr = WSP(bf, OFF_KR) + (size_t)t * 32;
        bf* dst = WSP(bf, which ? OFF_MK : OFF_MQ) + ((size_t)(b * 6 + h) * S + s) * 96;
        float ss = 0.f;
        for (int d = 0; d < 96; ++d) {
            const float v = which ? (d < 64 ? sKV[tok][h * 128 + d] : bf2f(kr[d - 64])) : sQ[tok][h * 96 + d];
            ss += v * v;
        }
        const float rn = rsqrtf(ss * (1.f / 96.f) + EPS);
        for (int d = 0; d < 64; ++d) {
            const float v = which ? sKV[tok][h * 128 + d] : sQ[tok][h * 96 + d];
            dst[d] = f2bf(v * rn * gain[d]);
        }
        for (int i = 0; i < 16; ++i) {
            const float x1 = (which ? bf2f(kr[i]) : sQ[tok][h * 96 + 64 + i]) * rn * gain[64 + i];
            const float x2 = (which ? bf2f(kr[16 + i]) : sQ[tok][h * 96 + 80 + i]) * rn * gain[80 + i];
            const float cs = rope[i], sn = rope[16 + i];
            dst[64 + i] = f2bf(x1 * cs - x2 * sn);
            dst[80 + i] = f2bf(x1 * sn + x2 * cs);
        }
    }
    bf* mvt = WSP(bf, OFF_MVT);
    for (int e = tid; e < 4 * 384; e += 256) {
        const int tok = e / 384, r = e % 384, h = r >> 6, d = r & 63;
        const int t = t0 + tok, b = t >> 12, s = t & 4095;
        mvt[((size_t)(b * 6 + h) * 64 + d) * S + s] = f2bf(sKV[tok][h * 128 + 64 + d]);
    }
    __syncthreads();
    }
}

DI float rdlane(float v, int j) { return __int_as_float(__builtin_amdgcn_readlane(__float_as_int(v), j)); }

DI void ph_diff_attn_naive(const Params& p, int l, int bid, int nb) {
    for (int u = bid; u < NB * 6 * S / 4; u += nb) {
    const int lane = tidx() & 63, gw = u * 4 + (tidx() >> 6);
    const int q = gw & 4095, bh = gw >> 12, h = bh % 6, b = bh / 6;
    const bf* DQ = WSP(bf, OFF_DQ); const bf* DK = WSP(bf, OFF_DK); const bf* DVT = WSP(bf, OFF_DVT);
    float lam;
    {
        float d1 = 0.f, d2 = 0.f;
        for (int i = 0; i < 32; ++i) { d1 += p.in[I_LQ1][l * 32 + i] * p.in[I_LK1][l * 32 + i]; d2 += p.in[I_LQ2][l * 32 + i] * p.in[I_LK2][l * 32 + i]; }
        lam = expf(d1) - expf(d2) + lambda_init(l);
    }
    const float slope = exp2f(-8.f * (float)(h + 1) / 6.f);
    const float scale = 0.17677669529663687f;
    float q0[32], q1[32];
    {
        const bf* a = DQ + ((size_t)(bh * 2 + 0) * S + q) * 32; const bf* c = DQ + ((size_t)(bh * 2 + 1) * S + q) * 32;
#pragma unroll
        for (int d = 0; d < 32; ++d) { q0[d] = bf2f(a[d]); q1[d] = bf2f(c[d]); }
    }
    float m0 = -INFINITY, m1 = -INFINITY, l0 = 0.f, l1 = 0.f, o0 = 0.f, o1 = 0.f;
    const int nkb = (q >> 6) + 1;
    for (int kb = 0; kb < nkb; ++kb) {
        const int k = kb * 64 + lane;
        const uint4* ka = (const uint4*)(DK + ((size_t)(bh * 2 + 0) * S + k) * 32);
        const uint4* kc = (const uint4*)(DK + ((size_t)(bh * 2 + 1) * S + k) * 32);
        float s0 = 0.f, s1 = 0.f;
#pragma unroll
        for (int i = 0; i < 4; ++i) {
            const uint4 u = ka[i], w = kc[i];
            const unsigned uu[4] = {u.x, u.y, u.z, u.w}, ww[4] = {w.x, w.y, w.z, w.w};
#pragma unroll
            for (int e = 0; e < 4; ++e) {
                s0 += q0[i * 8 + e * 2] * lo16(uu[e]) + q0[i * 8 + e * 2 + 1] * hi16(uu[e]);
                s1 += q1[i * 8 + e * 2] * lo16(ww[e]) + q1[i * 8 + e * 2 + 1] * hi16(ww[e]);
            }
        }
        const float bias = -slope * fabsf((float)(q - k));
        s0 = s0 * scale + bias; s1 = s1 * scale + bias;
        const float n0 = fmaxf(m0, wave_max(s0)), n1 = fmaxf(m1, wave_max(s1));
        const float a0 = __expf(m0 - n0), a1 = __expf(m1 - n1);
        const float p0 = __expf(s0 - n0), p1 = __expf(s1 - n1);
        l0 = l0 * a0 + p0; l1 = l1 * a1 + p1; o0 *= a0; o1 *= a1; m0 = n0; m1 = n1;
        const uint4* vp = (const uint4*)(DVT + ((size_t)bh * 64 + lane) * S + kb * 64);
        uint4 v[8];
#pragma unroll
        for (int i = 0; i < 8; ++i) v[i] = vp[i];
#pragma unroll
        for (int i = 0; i < 8; ++i) {
            const unsigned vv[4] = {v[i].x, v[i].y, v[i].z, v[i].w};
#pragma unroll
            for (int e = 0; e < 4; ++e) {
                const int j = i * 8 + e * 2;
                const float va = lo16(vv[e]), vb = hi16(vv[e]);
                o0 += rdlane(p0, j) * va + rdlane(p0, j + 1) * vb;
                o1 += rdlane(p1, j) * va + rdlane(p1, j + 1) * vb;
            }
        }
    }
    const float L0 = wave_sum(l0), L1 = wave_sum(l1);
    const float o = o0 / L0 - lam * (o1 / L1);
    const float ss = wave_sum(o * o);
    WSP(bf, OFF_MIX)[(size_t)(b * S + q) * 1024 + 256 + h * 64 + lane] = f2bf(o * rsqrtf(ss * (1.f / 64.f) + EPS));
    }
}

DI void ph_mla_attn_naive(const Params& p, int l, int bid, int nb) {
    for (int u = bid; u < NB * 6 * S / 4; u += nb) {
    const int lane = tidx() & 63, gw = u * 4 + (tidx() >> 6);
    const int q = gw & 4095, bh = gw >> 12, h = bh % 6, b = bh / 6;
    const bf* MQ = WSP(bf, OFF_MQ); const bf* MK = WSP(bf, OFF_MK); const bf* MVT = WSP(bf, OFF_MVT);
    const float scale = 0.10206207261596575f;
    float qv[96];
    {
        const bf* a = MQ + ((size_t)bh * S + q) * 96;
#pragma unroll
        for (int d = 0; d < 96; ++d) qv[d] = bf2f(a[d]);
    }
    float m0 = -INFINITY, l0 = 0.f, o0 = 0.f;
    const int nkb = (q >> 6) + 1;
    for (int kb = 0; kb < nkb; ++kb) {
        const int k = kb * 64 + lane;
        const uint4* ka = (const uint4*)(MK + ((size_t)bh * S + k) * 96);
        float s0 = 0.f;
#pragma unroll
        for (int i = 0; i < 12; ++i) {
            const uint4 u = ka[i];
            const unsigned uu[4] = {u.x, u.y, u.z, u.w};
#pragma unroll
            for (int e = 0; e < 4; ++e) s0 += qv[i * 8 + e * 2] * lo16(uu[e]) + qv[i * 8 + e * 2 + 1] * hi16(uu[e]);
        }
        s0 *= scale;
        const float n0 = fmaxf(m0, wave_max(s0));
        const float a0 = __expf(m0 - n0), p0 = __expf(s0 - n0);
        l0 = l0 * a0 + p0; o0 *= a0; m0 = n0;
        const uint4* vp = (const uint4*)(MVT + ((size_t)bh * 64 + lane) * S + kb * 64);
        uint4 v[8];
#pragma unroll
        for (int i = 0; i < 8; ++i) v[i] = vp[i];
#pragma unroll
        for (int i = 0; i < 8; ++i) {
            const unsigned vv[4] = {v[i].x, v[i].y, v[i].z, v[i].w};
#pragma unroll
            for (int e = 0; e < 4; ++e) {
                const int j = i * 8 + e * 2;
                o0 += rdlane(p0, j) * lo16(vv[e]) + rdlane(p0, j + 1) * hi16(vv[e]);
            }
        }
    }
    const float o = o0 / wave_sum(l0);
    const float ss = wave_sum(o * o);
    const int t = b * S + q;
    WSP(bf, OFF_MIX)[(size_t)t * 1024 + 640 + h * 64 + lane] = f2bf(o);
    if (lane == 0) WSP(float, OFF_SSQM)[t * 8 + h] = ss;
    }
}

DI void ph_mla_norm_fix(const Params& p, int bid, int nb) {
    for (int gid = bid * 256 + tidx(); gid < NT * 48; gid += nb * 256) {
    const int t = gid / 48, c8 = (gid % 48) * 8;
    const float* sq = WSP(float, OFF_SSQM) + t * 8;
    const float rn = rsqrtf((sq[0] + sq[1] + sq[2] + sq[3] + sq[4] + sq[5]) * (1.f / 384.f) + EPS);
    bf* m = WSP(bf, OFF_MIX) + (size_t)t * 1024 + 640 + c8;
    float v[8];
#pragma unroll
    for (int j = 0; j < 8; ++j) v[j] = bf2f(m[j]) * rn;
    store8(m, v);
    }
}

DI void ph_p4_gemm_naive(const Params& p, int l, int bid, int nb, unsigned char* smem) {
    float* sA = (float*)smem; float* sB = sA + 16 * 68;
    if (bid == 0 && tidx() < 32) WSP(int, OFF_CTL)[CTL_CNT + tidx()] = 0;
    for (int u = bid; u < 4096; u += nb) {
    const int mt = u / 16, nt = u % 16;
    const bf* A = WSP(bf, OFF_MIX) + (size_t)mt * 64 * D;
    const bf* Bt = WSP(bf, OFF_WOUT) + (size_t)l * 1024 * 1024 + (size_t)(nt * 64) * 1024;
    const float* xin = (l == 0 ? p.in[I_X] : WSP(float, OFF_XFA)) + (size_t)mt * 64 * D + nt * 64;
    float* x1 = p.out + (size_t)mt * 64 * D + nt * 64;
    bf* xb1 = WSP(bf, OFF_XB) + (size_t)mt * 64 * D + nt * 64;
    const float* g2 = p.in[I_N2G] + l * 1024 + nt * 64;
    ngemm_tile<true>(1024, [=](int r, int k) { return bf2f(A[(size_t)r * D + k]); }, [=](int k, int c) { return bf2f(Bt[(size_t)c * 1024 + k]); },
               [=](int r, int c, float v) { const float x = xin[(size_t)r * D + c] + v; x1[(size_t)r * D + c] = x; xb1[(size_t)r * D + c] = f2bf(x * g2[c]); }, sA, sB);
    }
}

DI void ph_router(const Params& p, int l, int bid, int nb) {
    const int lane = tidx() & 63, gw = bid * 4 + (tidx() >> 6), nw = nb * 4;
    const float* WR = WSP(float, OFF_WR) + (size_t)l * 36 * 1024;
    int* cnt = WSP(int, OFF_CTL) + CTL_CNT;
    int* list = WSP(int, OFF_LIST);
    float* gatew = WSP(float, OFF_GATEW);
    for (int t = gw; t < NT; t += nw) {
        const float* x = p.out + (size_t)t * D;
        float4 xv[4]; float ss = 0.f;
#pragma unroll
        for (int i = 0; i < 4; ++i) { xv[i] = *(const float4*)(x + lane * 4 + 256 * i); ss += xv[i].x * xv[i].x + xv[i].y * xv[i].y + xv[i].z * xv[i].z + xv[i].w * xv[i].w; }
        ss = wave_sum(ss);
        const float rinv = rsqrtf(ss * (1.f / 1024.f) + EPS);
        float lg[4];
#pragma unroll
        for (int j = 0; j < 4; ++j) {
            float a = 0.f;
#pragma unroll
            for (int i = 0; i < 4; ++i) { const float4 w = *(const float4*)(WR + (size_t)j * 1024 + lane * 4 + 256 * i); a += xv[i].x * w.x + xv[i].y * w.y + xv[i].z * w.z + xv[i].w * w.w; }
            lg[j] = wave_sum(a) * rinv + p.in[I_RGB][l * 4 + j];
        }
        int g = 0; float gm = lg[0];
#pragma unroll
        for (int j = 1; j < 4; ++j) if (lg[j] > gm) { gm = lg[j]; g = j; }
        float gs = 0.f;
#pragma unroll
        for (int j = 0; j < 4; ++j) gs += __expf(lg[j] - gm);
        const float pg_top = 1.f / gs;
        float e[8];
#pragma unroll
        for (int j = 0; j < 8; ++j) {
            const float* wrow = WR + (size_t)(4 + g * 8 + j) * 1024;
            float a = 0.f;
#pragma unroll
            for (int i = 0; i < 4; ++i) { const float4 w = *(const float4*)(wrow + lane * 4 + 256 * i); a += xv[i].x * w.x + xv[i].y * w.y + xv[i].z * w.z + xv[i].w * w.w; }
            e[j] = wave_sum(a) * rinv + p.in[I_REB][l * 32 + g * 8 + j];
        }
        int i1 = 0; float v1 = e[0];
#pragma unroll
        for (int i = 1; i < 8; ++i) if (e[i] > v1) { v1 = e[i]; i1 = i; }
        int i2 = -1; float v2 = -INFINITY;
#pragma unroll
        for (int i = 0; i < 8; ++i) if (i != i1 && e[i] > v2) { v2 = e[i]; i2 = i; }
        const float p1 = 1.f, p2 = __expf(v2 - v1);
        const float g1 = pg_top * p1 / (p1 + p2), g2 = pg_top * p2 / (p1 + p2);
        if (lane == 0) {
            const int e1 = g * 8 + i1, e2 = g * 8 + i2;
            const int pos1 = atomicAdd(&cnt[e1], 1); list[e1 * 16384 + pos1] = t * 2;
            const int pos2 = atomicAdd(&cnt[e2], 1); list[e2 * 16384 + pos2] = t * 2 + 1;
            gatew[t * 2] = g1; gatew[t * 2 + 1] = g2;
            WSP(float, OFF_RINV2)[t] = rinv;
        }
    }
}

DI void ph_moe_up_naive(const Params& p, int l, int bid, int nb, unsigned char* smem) {
    float* sA = (float*)smem; float* sB = sA + 16 * 68; int* sTok = (int*)(sB + 16 * 68);
    for (int u = bid; u < 32 * 256 * 8; u += nb) {
    const int nt = u & 7, rb = (u >> 3) & 255, e = u >> 11;
    const int* cnt = WSP(int, OFF_CTL) + CTL_CNT;
    const int n = cnt[e];
    if (rb * 64 >= n) continue;
    int base = 0; for (int i = 0; i < e; ++i) base += cnt[i];
    if (tidx() < 64) { const int r = rb * 64 + tidx(); sTok[tidx()] = r < n ? (WSP(int, OFF_LIST)[e * 16384 + r] >> 1) : -1; }
    __syncthreads();
    const bf* XB = WSP(bf, OFF_XB);
    const float* W = (nt < 4 ? p.in[I_W1] : p.in[I_W3]) + (size_t)(l * 32 + e) * 1024 * 256 + (nt & 3) * 64;
    const float* rinv2 = WSP(float, OFF_RINV2);
    float* H = WSP(float, OFF_H13) + (size_t)(base + rb * 64) * 512 + nt * 64;
    const int* tk = sTok;
    ngemm_tile<false>(1024, [=](int r, int k) { const int t = tk[r]; return t >= 0 ? bf2f(XB[(size_t)t * D + k]) : 0.f; }, [=](int k, int c) { return bf2f(f2bf(W[(size_t)k * 256 + c])); },
               [=](int r, int c, float v) { const int t = tk[r]; if (t >= 0) H[(size_t)r * 512 + c] = v * rinv2[t]; }, sA, sB);
    }
}

DI void ph_moe_act_naive(const Params& p, int bid, int nb) {
    for (int gid = bid * 256 + tidx(); gid < 32768 * 32; gid += nb * 256) {
    const int row = gid >> 5, c8 = (gid & 31) * 8;
    const float* H = WSP(float, OFF_H13) + (size_t)row * 512;
    float v[8];
#pragma unroll
    for (int j = 0; j < 8; ++j) { const float a = H[c8 + j], b = H[256 + c8 + j]; v[j] = a * sigmoidf_(a) * b; }
    store8(WSP(bf, OFF_ACT) + (size_t)row * 256 + c8, v);
    }
}

DI void ph_moe_down_naive(const Params& p, int l, int bid, int nb, unsigned char* smem) {
    float* sA = (float*)smem; float* sB = sA + 16 * 68; int* sEnt = (int*)(sB + 16 * 68);
    for (int u = bid; u < 32 * 256 * 16; u += nb) {
    const int nt = u & 15, rb = (u >> 4) & 255, e = u >> 12;
    const int* cnt = WSP(int, OFF_CTL) + CTL_CNT;
    const int n = cnt[e];
    if (rb * 64 >= n) continue;
    int base = 0; for (int i = 0; i < e; ++i) base += cnt[i];
    if (tidx() < 64) { const int r = rb * 64 + tidx(); sEnt[tidx()] = r < n ? WSP(int, OFF_LIST)[e * 16384 + r] : -1; }
    __syncthreads();
    const bf* A = WSP(bf, OFF_ACT) + (size_t)(base + rb * 64) * 256;
    const float* W = p.in[I_W2] + (size_t)(l * 32 + e) * 256 * 1024 + nt * 64;
    const float* gatew = WSP(float, OFF_GATEW);
    bf* Y = WSP(bf, OFF_Y);
    const int* en = sEnt;
    ngemm_tile<false>(256, [=](int r, int k) { return en[r] >= 0 ? bf2f(A[(size_t)r * 256 + k]) : 0.f; }, [=](int k, int c) { return bf2f(f2bf(W[(size_t)k * 1024 + c])); },
               [=](int r, int c, float v) { const int en_ = en[r]; if (en_ >= 0) Y[((size_t)(en_ & 1) * NT + (en_ >> 1)) * D + nt * 64 + c] = f2bf(v * gatew[en_]); }, sA, sB);
    }
}

DI void ph_combine(const Params& p, int last, int bid, int nb) {
    const int lane = tidx() & 63, gw = bid * 4 + (tidx() >> 6), nw = nb * 4;
    const bf* Y = WSP(bf, OFF_Y);
    float* xo = last ? p.out : WSP(float, OFF_XFA);
    bf* xb = WSP(bf, OFF_XB);
    for (int t = gw; t < NT; t += nw) {
        float ss = 0.f;
#pragma unroll
        for (int i = 0; i < 2; ++i) {
            const int c = (lane + 64 * i) * 8;
            const float4 a = *(const float4*)(p.out + (size_t)t * D + c), b = *(const float4*)(p.out + (size_t)t * D + c + 4);
            const uint4 y0 = *(const uint4*)(Y + (size_t)t * D + c), y1 = *(const uint4*)(Y + ((size_t)NT + t) * D + c);
            float v[8] = {a.x, a.y, a.z, a.w, b.x, b.y, b.z, b.w};
            const unsigned u0[4] = {y0.x, y0.y, y0.z, y0.w}, u1[4] = {y1.x, y1.y, y1.z, y1.w};
#pragma unroll
            for (int e = 0; e < 4; ++e) { v[2 * e] += lo16(u0[e]) + lo16(u1[e]); v[2 * e + 1] += hi16(u0[e]) + hi16(u1[e]); }
#pragma unroll
            for (int j = 0; j < 8; ++j) ss += v[j] * v[j];
            *(float4*)(xo + (size_t)t * D + c) = make_float4(v[0], v[1], v[2], v[3]);
            *(float4*)(xo + (size_t)t * D + c + 4) = make_float4(v[4], v[5], v[6], v[7]);
            if (!last) store8(xb + (size_t)t * D + c, v);
        }
        ss = wave_sum(ss);
        if (!last && lane == 0) WSP(float, OFF_RINV1)[t] = rsqrtf(ss * (1.f / 1024.f) + EPS);
    }
}


#define XB_TMO      128
#define XB_XCNT(j)  (256  + 64 * (j))
#define XB_XSUB(j)  (1280 + 64 * (j))
#define XB_XGEN(j)  (2304 + 64 * (j))
#define XB_TOP      3328
#define XB_TOPGEN   3392
#define XCD_BAR_WORDS 3456
#define XB_SPIN_CAP (1u << 22)
#define LAS __attribute__((address_space(3)))
constexpr size_t OFF_BAR = OFF_CTL + 16384;
static_assert(16384 + XCD_BAR_WORDS * 4 <= 65536, "ctl region");

DI unsigned xb_ld(unsigned* p) { return __hip_atomic_load(p, __ATOMIC_RELAXED, __HIP_MEMORY_SCOPE_AGENT); }
DI unsigned xb_add(unsigned* p, unsigned v) { return __hip_atomic_fetch_add(p, v, __ATOMIC_RELAXED, __HIP_MEMORY_SCOPE_AGENT); }
DI unsigned xb_xcc_id() { return (unsigned)__builtin_amdgcn_s_getreg((3 << 11) | 20) & 0xFu; }
#define XB_SPIN(cond, bar) do { unsigned _sp = 0; while (cond) { __builtin_amdgcn_s_sleep(1); \
    if ((++_sp & 255u) == 0u) { if (xb_ld(&(bar)[XB_TMO])) break; if (_sp > XB_SPIN_CAP) { atomicAdd(&(bar)[XB_TMO], 1u); break; } } } } while (0)

struct XcdBarrier { unsigned* bar; unsigned x; volatile LAS unsigned* st; };

DI XcdBarrier xcd_barrier_post(unsigned* bar, volatile LAS unsigned* st) {
    XcdBarrier b; b.bar = bar; b.x = xb_xcc_id(); b.st = st;
    if (tidx() == 0) (void)xb_add(&bar[XB_XCNT(b.x)], 1u);
    return b;
}
DI void xcd_barrier_complete(unsigned* bar, unsigned x, unsigned& nloc, unsigned& nx) {
    const unsigned G = gridDim.x * gridDim.y * gridDim.z;
    unsigned sum, cnt, mine, sp = 0u;
    for (;;) {
        sum = 0u; cnt = 0u; mine = 0u;
#pragma unroll
        for (unsigned j = 0; j < 16; ++j) { const unsigned c = xb_ld(&bar[XB_XCNT(j)]); sum += c; cnt += (c > 0u) ? 1u : 0u; mine = (j == x) ? c : mine; }
        if (sum == G) break;
        __builtin_amdgcn_s_sleep(1);
        if ((++sp & 255u) == 0u) { if (xb_ld(&bar[XB_TMO])) break; if (sp > XB_SPIN_CAP) { atomicAdd(&bar[XB_TMO], 1u); break; } }
    }
    nloc = mine > 0u ? mine : 1u; nx = cnt > 0u ? cnt : 1u;
}
DI void xcd_barrier(const XcdBarrier& b) {
    asm volatile("s_waitcnt vmcnt(0)" ::: "memory");
    __syncthreads();
    if (tidx() == 0) {
        unsigned* bar = b.bar;
        __builtin_amdgcn_s_waitcnt(0);
        unsigned nloc = b.st[0], nx = b.st[1];
        if (nloc == 0u) { xcd_barrier_complete(bar, b.x, nloc, nx); b.st[0] = nloc; b.st[1] = nx; }
        const unsigned old = xb_add(&bar[XB_XSUB(b.x)], 1u);
        const unsigned gen = old / nloc;
        if (old + 1u == (gen + 1u) * nloc) {
            __builtin_amdgcn_fence(__ATOMIC_RELEASE, "agent");
            asm volatile("s_waitcnt vmcnt(0)" ::: "memory");
            const unsigned og = xb_add(&bar[XB_TOP], 1u);
            const unsigned tg = og / nx;
            if (og + 1u == (tg + 1u) * nx) xb_add(&bar[XB_TOPGEN], 1u);
            else XB_SPIN(xb_ld(&bar[XB_TOPGEN]) == tg, bar);
            __builtin_amdgcn_fence(__ATOMIC_ACQUIRE, "agent");
            xb_add(&bar[XB_XGEN(b.x)], 1u);
            asm volatile("s_waitcnt vmcnt(0)" ::: "memory");
        } else {
            XB_SPIN(xb_ld(&bar[XB_XGEN(b.x)]) == gen, bar);
            __builtin_amdgcn_fence(__ATOMIC_ACQUIRE, "agent");
            asm volatile("s_waitcnt vmcnt(0)" ::: "memory");
        }
    }
    __syncthreads();
}

#define USE_CG_SYNC 0
#ifndef PROBE
#define PROBE 0
#endif
#define FAST_P1 1
#define FAST_ATTN 1
#define FAST_P4 1
#define FAST_MOE 1
#define FAST_MLAUP 1
constexpr int SMEM_BYTES = GEMM_SMEM + 64;
#if USE_CG_SYNC
#define GRID_SYNC() grid.sync()
#else
#define GRID_SYNC() xcd_barrier(xbar)
#endif

__global__ void __launch_bounds__(256, 2) mega_fwd(Params p) {
    extern __shared__ __attribute__((aligned(16))) unsigned char smem[];
#if USE_CG_SYNC
    cg::grid_group grid = cg::this_grid();
#else
    if (tidx() < 8) ((unsigned*)(smem + GEMM_SMEM))[tidx()] = 0u;
    __syncthreads();
    XcdBarrier xbar = xcd_barrier_post((unsigned*)(p.ws + OFF_BAR), (volatile LAS unsigned*)(smem + GEMM_SMEM));
#endif
    const int bid = blockIdx.x, nb = gridDim.x;
    ph_prep_weights(p, bid, nb, smem);
    ph_prep_misc(p, bid, nb);
    ph_prep_x(p, bid, nb);
    GRID_SYNC();
#if PROBE == 9
    for (int i = 0; i < 20; ++i) GRID_SYNC();
#endif
#if PROBE == 8
    ph_prep_weights(p, bid, nb, smem); ph_prep_misc(p, bid, nb); ph_prep_x(p, bid, nb); GRID_SYNC();
#endif
    for (int l = 0; l < 2; ++l) {
        ph_p1(p, l, bid, nb, smem);
        GRID_SYNC();
#if PROBE == 1
        ph_p1(p, l, bid, nb, smem); GRID_SYNC();
#endif
        ph_lru(p, l, 0, bid, nb, smem);
        ph_mla_up(p, l, bid, nb, smem);
        GRID_SYNC();
#if PROBE == 2
        ph_lru(p, l, 0, bid, nb, smem); ph_mla_up(p, l, bid, nb, smem); GRID_SYNC();
#endif
        ph_p3(p, l, l, smem);
        GRID_SYNC();
#if PROBE == 3
        ph_p3(p, l, 2 + l, smem); GRID_SYNC();
#endif
        ph_p4(p, l, bid, nb, smem);
        GRID_SYNC();
#if PROBE == 4
        ph_p4(p, l, bid, nb, smem); GRID_SYNC();
#endif
        ph_router_fast(p, l, bid, nb, smem);
        GRID_SYNC();
#if PROBE == 5
        if (bid == 0 && tidx() < 32) WSP(int, OFF_CTL)[CTL_CNT + tidx() * 32] = 0;
        GRID_SYNC();
        ph_router_fast(p, l, bid, nb, smem); GRID_SYNC();
#endif
        ph_moe_up(p, l, bid, nb, smem);
        GRID_SYNC();
        ph_moe_down(p, l, bid, nb, smem);
        GRID_SYNC();
#if PROBE == 6
        ph_moe_up(p, l, bid, nb, smem); GRID_SYNC(); ph_moe_down(p, l, bid, nb, smem); GRID_SYNC();
#endif
        ph_combine(p, l == 1, bid, nb);
        if (l == 0) GRID_SYNC();
#if PROBE == 7
        if (l == 0) { ph_combine(p, 0, bid, nb); GRID_SYNC(); }
#endif
    }
}

extern "C" void kernel_launch(void* const* d_in, const int* in_sizes, int n_in, void* d_out, int out_size, void* d_ws, size_t ws_size, hipStream_t stream) {
    if (n_in != N_IN || ws_size < WS_TOTAL || out_size != NT * D) { fprintf(stderr, "kernel_launch: bad sizes n_in %d ws %zu (need %zu) out %d\n", n_in, ws_size, (size_t)WS_TOTAL, out_size); return; }
    static int grid_blocks = 0;
    if (!grid_blocks) {
        int dev = 0, cus = 0, per_cu = 0;
        (void)hipGetDevice(&dev);
        (void)hipDeviceGetAttribute(&cus, hipDeviceAttributeMultiprocessorCount, dev);
        (void)hipFuncSetAttribute((const void*)mega_fwd, hipFuncAttributeMaxDynamicSharedMemorySize, SMEM_BYTES);
        (void)hipOccupancyMaxActiveBlocksPerMultiprocessor(&per_cu, (const void*)mega_fwd, 256, SMEM_BYTES);
        if (per_cu < 1) { fprintf(stderr, "kernel_launch: occupancy query says %d blocks per CU\n", per_cu); return; }
        if (per_cu > 2) per_cu = 2;
        grid_blocks = cus * per_cu;
    }
    Params p{};
    for (int i = 0; i < N_IN; ++i) p.in[i] = (const float*)d_in[i];
    p.out = (float*)d_out; p.ws = (unsigned char*)d_ws;
    (void)hipMemsetAsync((unsigned char*)d_ws + OFF_CTL, 0, 65536, stream);
    void* args[] = {&p};
    hipError_t e = hipLaunchCooperativeKernel((const void*)mega_fwd, dim3(grid_blocks), dim3(256), args, SMEM_BYTES, stream);
    if (e != hipSuccess) fprintf(stderr, "cooperative launch failed: %s (grid %d)\n", hipGetErrorString(e), grid_blocks);
}
```

```cpp
#include <hip/hip_runtime.h>
#include <hip/hip_cooperative_groups.h>
namespace cg = cooperative_groups;
#include <cstdio>
#include <cstdint>

#define DI __device__ __forceinline__
typedef unsigned short bf;

constexpr int NB = 4, S = 4096, D = 1024, NT = NB * S, NPROJ = 2048;
constexpr float EPS = 1e-6f;
enum { I_X = 0, I_N1G, I_WIN, I_CONVW, I_CONVB, I_WA, I_BA, I_WX, I_BX, I_LAM, I_LOUTG, I_DQG, I_DKG, I_LQ1, I_LK1, I_LQ2, I_LK2,
       I_SUBG, I_CQG, I_CKVG, I_WUQ, I_WUKV, I_MQG, I_MKG, I_MOUTG, I_WOUT, I_N2G, I_RGW, I_RGB, I_REW, I_REB, I_W1, I_W3, I_W2, N_IN };

struct Params { const float* in[N_IN]; float* out; unsigned char* ws; };

constexpr size_t AL(size_t x) { return (x + 255) & ~(size_t)255; }
constexpr size_t OFF_WIN = 0;
constexpr size_t OFF_WOUT = OFF_WIN + (size_t)2 * 2048 * 1024 * 2;
constexpr size_t OFF_WUQ = OFF_WOUT + (size_t)2 * 1024 * 1024 * 2;
constexpr size_t OFF_WUKV = OFF_WUQ + (size_t)2 * 768 * 192 * 2;
constexpr size_t OFF_WAX = OFF_WUKV + (size_t)2 * 768 * 128 * 2;
constexpr size_t OFF_WR = OFF_WAX + (size_t)2 * 2 * 4 * 64 * 64 * 2;
constexpr size_t OFF_ROPE = AL(OFF_WR + (size_t)2 * 64 * 1024 * 2);
constexpr size_t OFF_CTL = OFF_ROPE + (size_t)4096 * 32 * 4;
constexpr size_t OFF_RINV1 = OFF_CTL + 65536;
constexpr size_t OFF_RINV2 = OFF_RINV1 + (size_t)NT * 4;
constexpr size_t OFF_SSQ2 = OFF_RINV2 + (size_t)NT * 4;
constexpr size_t OFF_SSQM = OFF_SSQ2 + (size_t)NT * 8 * 4;
constexpr size_t OFF_TOT = OFF_SSQM + (size_t)NT * 8 * 4;
constexpr size_t OFF_GATEW = OFF_TOT + (size_t)4 * 64 * 2 * 256 * 4;
constexpr size_t OFF_LIST = OFF_GATEW + (size_t)NT * 2 * 4;
constexpr size_t OFF_XFA = OFF_LIST + (size_t)32 * 16384 * 4;
constexpr size_t OFF_XB = OFF_XFA + (size_t)NT * D * 4;
constexpr size_t OFF_MIX = OFF_XB + (size_t)NT * D * 2;
constexpr size_t OFF_STAGE = OFF_MIX + (size_t)NT * D * 2;
constexpr size_t OFF_LX = OFF_STAGE;
constexpr size_t OFF_GG = OFF_LX + (size_t)NT * 256 * 2;
constexpr size_t OFF_DQ = OFF_GG + (size_t)NT * 256 * 2;
constexpr size_t OFF_DK = OFF_DQ + (size_t)NT * 384 * 2;
constexpr size_t OFF_DVT = OFF_DK + (size_t)NT * 384 * 2;
constexpr size_t OFF_CQ = OFF_DVT + (size_t)NT * 384 * 2;
constexpr size_t OFF_CKV = OFF_CQ + (size_t)NT * 192 * 2;
constexpr size_t OFF_KR = OFF_CKV + (size_t)NT * 128 * 2;
constexpr size_t OFF_MQ = OFF_KR + (size_t)NT * 32 * 2;
constexpr size_t OFF_MK = OFF_MQ + (size_t)NT * 576 * 2;
constexpr size_t OFF_MVT = OFF_MK + (size_t)NT * 576 * 2;
constexpr size_t OFF_STAGE_END = OFF_MVT + (size_t)NT * 384 * 2;
constexpr size_t OFF_Y = OFF_STAGE;
constexpr size_t OFF_ACT = OFF_Y + (size_t)2 * NT * D * 2;
constexpr size_t OFF_H13 = OFF_Y;
constexpr size_t WS_TOTAL = OFF_STAGE_END;
static_assert(OFF_ACT + (size_t)(32768 + 128) * 256 * 2 <= OFF_STAGE_END, "alias");
constexpr int CTL_CNT = 0;
constexpr int CTL_LAM = 1024 + 4 * 256;
constexpr int CTL_Q = 1024;

#define WSP(T, off) ((T*)(p.ws + (off)))

DI int tidx() { int t = threadIdx.x; asm volatile("" : "+v"(t)); return t; }
DI unsigned xcc_id() { return (unsigned)__builtin_amdgcn_s_getreg((3 << 11) | 20) & 0xFu; }
DI float bf2f(bf v) { return __uint_as_float(((unsigned)v) << 16); }
DI bf f2bf(float f) { unsigned u = __float_as_uint(f); u += 0x7fffu + ((u >> 16) & 1u); return (bf)(u >> 16); }
typedef __bf16 hwbf16x2 __attribute__((ext_vector_type(2)));
typedef float f32x2 __attribute__((ext_vector_type(2)));
DI unsigned pack2(float a, float b) { f32x2 v = {a, b}; return __builtin_bit_cast(unsigned, __builtin_convertvector(v, hwbf16x2)); }
DI float lo16(unsigned u) { return __uint_as_float(u << 16); }
DI float hi16(unsigned u) { return __uint_as_float(u & 0xffff0000u); }
DI float wave_sum(float v) { for (int o = 32; o > 0; o >>= 1) v += __shfl_xor(v, o); return v; }
DI float wave_max(float v) { for (int o = 32; o > 0; o >>= 1) v = fmaxf(v, __shfl_xor(v, o)); return v; }
DI float gelu_tanh(float x) { return 0.5f * x * (1.f + tanhf(0.7978845608028654f * (x + 0.044715f * x * x * x))); }
DI float sigmoidf_(float x) { return 1.f / (1.f + __expf(-x)); }
DI float lambda_init(int l) { return l == 0 ? 0.2f : 0.35550906757f; }
DI void store8(bf* dst, const float* v) { uint4 u; u.x = pack2(v[0], v[1]); u.y = pack2(v[2], v[3]); u.z = pack2(v[4], v[5]); u.w = pack2(v[6], v[7]); *(uint4*)dst = u; }

template <class SCOL, class GAIN>
DI void tr_tile(const float* src, int lds_, bf* dst, int K, int n0, int k0, SCOL scol, GAIN gain, float* tile) {
    const int tid = tidx();
    const int nn = tid & 63;
    const int sc = scol(n0 + nn);
#pragma unroll
    for (int i = 0; i < 16; ++i) {
        const int kk = (tid >> 6) + 4 * i;
        float v = 0.f;
        if (sc >= 0) v = src[(size_t)(k0 + kk) * lds_ + sc] * gain(k0 + kk);
        tile[kk * 65 + nn] = v;
    }
    __syncthreads();
#pragma unroll
    for (int i = 0; i < 2; ++i) {
        const int id = tid + 256 * i, n = id >> 3, kc = (id & 7) * 8;
        float v[8];
#pragma unroll
        for (int j = 0; j < 8; ++j) v[j] = tile[(kc + j) * 65 + n];
        store8(dst + (size_t)(n0 + n) * K + k0 + kc, v);
    }
    __syncthreads();
}

DI int win_col(int n) {
    if (n < 1856) return n;
    if (n < 1888) return 1984 + (n - 1856);
    if (n < 1920) return -1;
    return 1856 + (n - 1920);
}

constexpr int PW_WIN = 2 * 32 * 16;
constexpr int PW_WOUT = 2 * 16 * 16;
constexpr int PW_WUQ = 2 * 12 * 3;
constexpr int PW_WUKV = 2 * 12 * 2;
constexpr int PW_WAX = 2 * 2 * 4;
constexpr int PW_TOTAL = PW_WIN + PW_WOUT + PW_WUQ + PW_WUKV + PW_WAX;

DI void prep_weights_unit(const Params& p, int u, float* tile) {
    if (u < PW_WIN) {
        const int l = u / 512, r = u % 512, nt = r / 16, kt = r % 16;
        const float* g = p.in[I_N1G] + l * 1024;
        tr_tile(p.in[I_WIN] + (size_t)l * 1024 * 2016, 2016, WSP(bf, OFF_WIN) + (size_t)l * 2048 * 1024, 1024, nt * 64, kt * 64,
                [](int n) { return win_col(n); }, [g](int k) { return g[k]; }, tile);
        return;
    }
    u -= PW_WIN;
    if (u < PW_WOUT) {
        const int l = u / 256, r = u % 256, nt = r / 16, kt = r % 16;
        const float* g_lru = p.in[I_LOUTG] + l * 256; const float* g_sub = p.in[I_SUBG] + l * 64; const float* g_mla = p.in[I_MOUTG] + l * 384;
        const float li = 1.f - lambda_init(l);
        tr_tile(p.in[I_WOUT] + (size_t)l * 1024 * 1024, 1024, WSP(bf, OFF_WOUT) + (size_t)l * 1024 * 1024, 1024, nt * 64, kt * 64,
                [](int n) { return n; },
                [=](int k) { return k < 256 ? g_lru[k] : (k < 640 ? g_sub[(k - 256) & 63] * li : g_mla[k - 640]); }, tile);
        return;
    }
    u -= PW_WOUT;
    if (u < PW_WUQ) {
        const int l = u / 36, r = u % 36, nt = r / 3, kt = r % 3;
        const float* g = p.in[I_CQG] + l * 192;
        tr_tile(p.in[I_WUQ] + (size_t)l * 192 * 576, 576, WSP(bf, OFF_WUQ) + (size_t)l * 768 * 192, 192, nt * 64, kt * 64,
                [](int n) { return (n & 127) < 96 ? (n >> 7) * 96 + (n & 127) : -1; }, [g](int k) { return g[k]; }, tile);
        return;
    }
    u -= PW_WUQ;
    if (u < PW_WUKV) {
        const int l = u / 24, r = u % 24, nt = r / 2, kt = r % 2;
        const float* g = p.in[I_CKVG] + l * 128;
        tr_tile(p.in[I_WUKV] + (size_t)l * 128 * 768, 768, WSP(bf, OFF_WUKV) + (size_t)l * 768 * 128, 128, nt * 64, kt * 64,
                [](int n) { return n; }, [g](int k) { return g[k]; }, tile);
        return;
    }
    u -= PW_WUKV;
    {
        const int l = u / 8, which = (u / 4) & 1, blk = u & 3;
        const float* src = (which ? p.in[I_WX] : p.in[I_WA]) + (size_t)(l * 4 + blk) * 4096;
        tr_tile(src, 64, WSP(bf, OFF_WAX) + (size_t)((l * 2 + which) * 4 + blk) * 4096, 64, 0, 0,
                [](int n) { return n; }, [](int) { return 1.f; }, tile);
    }
}

DI void ph_prep_weights(const Params& p, int bid, int nb, unsigned char* smem) {
    float* tile = (float*)smem;
    for (int u = bid; u < PW_TOTAL; u += nb) prep_weights_unit(p, u, tile);
}

DI void ph_prep_misc(const Params& p, int bid, int nb) {
    const int gid = bid * 256 + tidx(), gsz = nb * 256;
    bf* wr = WSP(bf, OFF_WR);
    for (int i = gid; i < 2 * 64 * 1024; i += gsz) {
        const int l = i >> 16, j = (i >> 10) & 63, k = i & 1023;
        float w = 0.f;
        if (j < 4) w = p.in[I_RGW][(size_t)(l * 1024 + k) * 4 + j];
        else if (j < 36) w = p.in[I_REW][(size_t)(l * 1024 + k) * 32 + (j - 4)];
        wr[i] = f2bf(w);
    }
    float* rope = WSP(float, OFF_ROPE);
    for (int i = gid; i < 4096 * 16; i += gsz) {
        const int s = i >> 4, f = i & 15;
        const float inv_freq = (float)exp2(-(double)f / 16.0 * 13.287712379549449);
        const float angf = (float)s * inv_freq;
        double a = (double)angf;
        const double twopi = 6.283185307179586476925;
        a -= twopi * rint(a / twopi);
        const double hh = 0.5 * a, h2 = hh * hh;
        double sn = 1.0, cs = 1.0, ts = 1.0, tc = 1.0;
#pragma unroll
        for (int n = 1; n <= 10; ++n) {
            tc *= -h2 / (double)((2 * n - 1) * (2 * n));
            ts *= -h2 / (double)((2 * n) * (2 * n + 1));
            cs += tc; sn += ts;
        }
        sn *= hh;
        rope[s * 32 + f] = (float)(cs * cs - sn * sn);
        rope[s * 32 + 16 + f] = (float)(2.0 * sn * cs);
    }
    if (gid < 32) WSP(int, OFF_CTL)[CTL_CNT + gid * 32] = 0;
    if (gid < 2) {
        float d1 = 0.f, d2 = 0.f;
        for (int i = 0; i < 32; ++i) { d1 += p.in[I_LQ1][gid * 32 + i] * p.in[I_LK1][gid * 32 + i]; d2 += p.in[I_LQ2][gid * 32 + i] * p.in[I_LK2][gid * 32 + i]; }
        WSP(float, OFF_CTL)[CTL_LAM + gid] = expf(d1) - expf(d2) + lambda_init(gid);
        float gq = 0.f, gk = 0.f;
        for (int i = 0; i < 32; ++i) { gq = fmaxf(gq, fabsf(p.in[I_DQG][gid * 32 + i])); gk = fmaxf(gk, fabsf(p.in[I_DKG][gid * 32 + i])); }
        WSP(float, OFF_CTL)[CTL_LAM + 2 + gid] = 32.f * gq * gk * 0.17677669529663687f * 1.4426950408889634f * 1.02f;
    }
}

DI void ph_prep_x(const Params& p, int bid, int nb) {
    const int lane = tidx() & 63, gw = bid * 4 + (tidx() >> 6), nw = nb * 4;
    const float* x = p.in[I_X];
    bf* xb = WSP(bf, OFF_XB);
    float* rinv = WSP(float, OFF_RINV1);
    for (int t = gw; t < NT; t += nw) {
        float ss = 0.f;
#pragma unroll
        for (int i = 0; i < 2; ++i) {
            const int c = (lane + 64 * i) * 8;
            const float4 a = *(const float4*)(x + (size_t)t * D + c), b = *(const float4*)(x + (size_t)t * D + c + 4);
            float v[8] = {a.x, a.y, a.z, a.w, b.x, b.y, b.z, b.w};
#pragma unroll
            for (int j = 0; j < 8; ++j) ss += v[j] * v[j];
            store8(xb + (size_t)t * D + c, v);
        }
        ss = wave_sum(ss);
        if (lane == 0) rinv[t] = rsqrtf(ss * (1.f / 1024.f) + EPS);
    }
}

template <bool BT, class LA, class LB, class EPI>
DI void ngemm_tile(int K, LA la, LB lb, EPI epi, float* sA, float* sB) {
    const int tid = tidx(), ty = tid >> 4, tx = tid & 15;
    float acc[4][4];
#pragma unroll
    for (int i = 0; i < 4; ++i)
#pragma unroll
        for (int j = 0; j < 4; ++j) acc[i][j] = 0.f;
    for (int k0 = 0; k0 < K; k0 += 16) {
#pragma unroll
        for (int i = 0; i < 4; ++i) {
            const int e = tid + 256 * i;
            sA[(e & 15) * 68 + (e >> 4)] = la(e >> 4, k0 + (e & 15));
            if (BT) sB[(e & 15) * 68 + (e >> 4)] = lb(k0 + (e & 15), e >> 4);
            else sB[(e >> 6) * 68 + (e & 63)] = lb(k0 + (e >> 6), e & 63);
        }
        __syncthreads();
#pragma unroll
        for (int kk = 0; kk < 16; ++kk) {
            const float4 a = *(const float4*)(sA + kk * 68 + ty * 4), b = *(const float4*)(sB + kk * 68 + tx * 4);
            const float av[4] = {a.x, a.y, a.z, a.w}, bv[4] = {b.x, b.y, b.z, b.w};
#pragma unroll
            for (int i = 0; i < 4; ++i)
#pragma unroll
                for (int j = 0; j < 4; ++j) acc[i][j] += av[i] * bv[j];
        }
        __syncthreads();
    }
#pragma unroll
    for (int i = 0; i < 4; ++i)
#pragma unroll
        for (int j = 0; j < 4; ++j) epi(ty * 4 + i, tx * 4 + j, acc[i][j]);
}

DI void ph_p1_gemm_naive(const Params& p, int l, int chunk, int bid, int nb, unsigned char* smem) {
    float* sA = (float*)smem; float* sB = sA + 16 * 68;
    for (int u = bid; u < 2048; u += nb) {
    const int mt = u / 8, nt = u % 8;
    const bf* A = WSP(bf, OFF_XB) + (size_t)mt * 64 * D;
    const bf* Bt = WSP(bf, OFF_WIN) + (size_t)l * 2048 * 1024 + (size_t)(chunk * 512 + nt * 64) * 1024;
    const float* rinv = WSP(float, OFF_RINV1) + mt * 64;
    float* C = WSP(float, OFF_MIX) + (size_t)mt * 64 * 512 + nt * 64;
    ngemm_tile<true>(1024, [=](int r, int k) { return bf2f(A[(size_t)r * D + k]); }, [=](int k, int c) { return bf2f(Bt[(size_t)c * 1024 + k]); },
               [=](int r, int c, float v) { C[(size_t)r * 512 + c] = v * rinv[r]; }, sA, sB);
    }
}

template <class ACC>
DI void route_tile(const Params& p, int l, int mt, int nt, ACC T) {
    const int tid = tidx();
    const int t0 = mt * 128, b = t0 >> 12, s0 = t0 & 4095;
    if (nt < 4) {
        bf* dst = WSP(bf, nt < 2 ? OFF_LX : OFF_GG);
        const int cb = (nt & 1) * 128;
#pragma unroll 1
        for (int it = 0; it < 8; ++it) {
            const int id = it * 256 + tid, r = id >> 4, c8 = (id & 15) * 8;
            float v[8];
#pragma unroll
            for (int j = 0; j < 8; ++j) { v[j] = T(r, c8 + j); if (nt >= 2) v[j] = gelu_tanh(v[j]); }
            store8(dst + (size_t)(t0 + r) * 256 + cb + c8, v);
        }
    } else if (nt < 10) {
        const bool isk = nt >= 7;
        const int g0 = (nt - (isk ? 7 : 4)) * 128;
        const float* gain = (isk ? p.in[I_DKG] : p.in[I_DQG]) + l * 32;
        bf* dst = WSP(bf, isk ? OFF_DK : OFF_DQ);
#pragma unroll 1
        for (int it = 0; it < 8; ++it) {
            const int id = it * 256 + tid, r = id >> 4, c8 = (id & 15) * 8;
            float v[8], ss = 0.f;
#pragma unroll
            for (int j = 0; j < 8; ++j) { v[j] = T(r, c8 + j); ss += v[j] * v[j]; }
            ss += __shfl_xor(ss, 1); ss += __shfl_xor(ss, 2);
            const float rn = rsqrtf(ss * (1.f / 32.f) + EPS);
            const int col = g0 + c8, h = col >> 6, m = (col >> 5) & 1, d0 = col & 31;
#pragma unroll
            for (int j = 0; j < 8; ++j) v[j] = v[j] * rn * gain[d0 + j];
            store8(dst + ((size_t)((b * 6 + h) * 2 + m) * S + s0 + r) * 32 + d0, v);
        }
    } else if (nt < 13) {
        const int g0 = (nt - 10) * 128;
        bf* dst = WSP(bf, OFF_DVT);
#pragma unroll 1
        for (int it = 0; it < 8; ++it) {
            const int id = it * 256 + tid, c = id & 127, rc = id >> 7;
            float v[8];
#pragma unroll
            for (int j = 0; j < 8; ++j) v[j] = T(8 * rc + j, c);
            const int col = g0 + c, h = col >> 6, d = col & 63;
            store8(dst + ((size_t)(b * 6 + h) * 64 + d) * S + s0 + 8 * rc, v);
        }
    } else {
#pragma unroll 1
        for (int it = 0; it < 8; ++it) {
            const int id = it * 256 + tid, r = id >> 4, c8 = (id & 15) * 8;
            float v[8];
#pragma unroll
            for (int j = 0; j < 8; ++j) v[j] = T(r, c8 + j);
            if (nt == 13) store8(WSP(bf, OFF_CQ) + (size_t)(t0 + r) * 192 + c8, v);
            else if (nt == 14) {
                if (c8 < 64) store8(WSP(bf, OFF_CQ) + (size_t)(t0 + r) * 192 + 128 + c8, v);
                else if (c8 < 96) store8(WSP(bf, OFF_KR) + (size_t)(t0 + r) * 32 + (c8 - 64), v);
            } else store8(WSP(bf, OFF_CKV) + (size_t)(t0 + r) * 128 + c8, v);
        }
    }
}

DI void ph_p1_route_naive(const Params& p, int l, int chunk, int bid, int nb) {
    for (int u = bid; u < 512; u += nb) {
    const int mt = u / 4, ntl = u % 4;
    const float* C = WSP(float, OFF_MIX) + (size_t)mt * 128 * 512 + ntl * 128;
    route_tile(p, l, mt, chunk * 4 + ntl, [=](int r, int c) { return C[(size_t)r * 512 + c]; });
    }
}


typedef short bf16x8 __attribute__((ext_vector_type(8)));
typedef short s16x4 __attribute__((ext_vector_type(4)));
typedef float f32x16 __attribute__((ext_vector_type(16)));
typedef __attribute__((address_space(3))) s16x4 lds_s16x4;
#define MFMA32(a, b, c) __builtin_amdgcn_mfma_f32_32x32x16_bf16((a), (b), (c), 0, 0, 0)
constexpr int G_A_BYTES = 16384, G_B_BYTES = 20480;
constexpr int G_OFF_B = 2 * G_A_BYTES;
constexpr int G_LOOP_BYTES = 2 * G_A_BYTES + 2 * G_B_BYTES;
constexpr int G_OFF_AUX = G_LOOP_BYTES;
constexpr int GEMM_SMEM = G_LOOP_BYTES + 2048;

DI unsigned cvt_pk_bf16(float a, float b) { return pack2(a, b); }

struct RowLoader {
    const bf* base; size_t ld;
    DI uint4 load(int i, int kt) const { return *(const uint4*)(base + (size_t)(32 * i) * ld + kt * 64); }
};
struct GatherLoader {
    const bf* rp[4];
    DI uint4 load(int i, int kt) const { return rp[i] ? *(const uint4*)(rp[i] + kt * 64) : make_uint4(0, 0, 0, 0); }
};
struct TrLoader {
    const float* base; size_t ldn;
    DI float4 load(int i, int kt) const { return *(const float4*)(base + (size_t)(kt * 64 + 8 * i) * ldn); }
};

template <int BMODE, class AL, class BL>
DI void g_issue(uint4 (&ra)[4], uint4 (&rb0)[4], float4 (&rb1)[8], const AL& al, const BL& bl, int kt) {
#pragma unroll
    for (int i = 0; i < 4; ++i) ra[i] = al.load(i, kt);
    if constexpr (BMODE == 0) {
#pragma unroll
        for (int i = 0; i < 4; ++i) rb0[i] = bl.load(i, kt);
    } else {
#pragma unroll
        for (int i = 0; i < 8; ++i) rb1[i] = bl.load(i, kt);
    }
}
template <int BMODE>
DI void g_commit(const uint4 (&ra)[4], const uint4 (&rb0)[4], const float4 (&rb1)[8], unsigned char* dA, unsigned char* dB, int a_wr, int b_wr1) {
#pragma unroll
    for (int i = 0; i < 4; ++i) *(uint4*)(dA + a_wr + i * 4096) = ra[i];
    if constexpr (BMODE == 0) {
#pragma unroll
        for (int i = 0; i < 4; ++i) *(uint4*)(dB + a_wr + i * 4096) = rb0[i];
    } else {
#pragma unroll
        for (int i = 0; i < 8; ++i) *(uint2*)(dB + b_wr1 + i * 2560) = make_uint2(cvt_pk_bf16(rb1[i].x, rb1[i].y), cvt_pk_bf16(rb1[i].z, rb1[i].w));
    }
}
template <int BMODE>
DI void g_compute(f32x16 (&acc)[2][2], const unsigned char* sA, const unsigned char* sB, int a_rd, int b_rd0, int b_rd1, int h, int sw) {
#pragma unroll
    for (int ks = 0; ks < 4; ++ks) {
        const int co = ((2 * ks + h) ^ sw) << 4;
        bf16x8 a[2], b[2];
#pragma unroll
        for (int mi = 0; mi < 2; ++mi) a[mi] = *(const bf16x8*)(sA + a_rd + mi * 4096 + co);
        if constexpr (BMODE == 0) {
#pragma unroll
            for (int ni = 0; ni < 2; ++ni) b[ni] = *(const bf16x8*)(sB + b_rd0 + ni * 4096 + co);
        } else {
#pragma unroll
            for (int ni = 0; ni < 2; ++ni) {
                const s16x4 lo = __builtin_amdgcn_ds_read_tr16_b64_v4i16((lds_s16x4*)(sB + b_rd1 + ks * 5120 + ni * 64));
                const s16x4 hi = __builtin_amdgcn_ds_read_tr16_b64_v4i16((lds_s16x4*)(sB + b_rd1 + ks * 5120 + 1280 + ni * 64));
                b[ni] = __builtin_shufflevector(lo, hi, 0, 1, 2, 3, 4, 5, 6, 7);
            }
        }
#pragma unroll
        for (int mi = 0; mi < 2; ++mi)
#pragma unroll
            for (int ni = 0; ni < 2; ++ni) acc[mi][ni] = MFMA32(a[mi], b[ni], acc[mi][ni]);
    }
}
template <int BMODE, class AL, class BL>
DI void gemm_mainloop(f32x16 (&acc)[2][2], int nk, const AL& al, const BL& bl, unsigned char* smem) {
    const int tid = tidx(), lane = tid & 63, wv = tid >> 6, wr = wv >> 1, wc = wv & 1;
    const int r31 = lane & 31, h = lane >> 5, sw = (r31 >> 1) & 7;
    const int a_wr = (tid >> 3) * 128 + (((tid & 7) ^ ((tid >> 4) & 7)) << 4);
    const int b_wr1 = (tid >> 5) * 320 + (tid & 31) * 8;
    const int a_rd = (wr * 64 + r31) * 128, b_rd0 = (wc * 64 + r31) * 128;
    const int b_rd1 = (8 * h + ((lane & 15) >> 2)) * 320 + (wc * 64 + 16 * ((lane >> 4) & 1) + 4 * (lane & 3)) * 2;
    uint4 raA[4], rbA[4], raB[4], rbB[4]; float4 rfA[8], rfB[8];
    unsigned char* const sA0 = smem; unsigned char* const sA1 = smem + G_A_BYTES;
    unsigned char* const sB0 = smem + G_OFF_B; unsigned char* const sB1 = smem + G_OFF_B + G_B_BYTES;
    g_issue<BMODE>(raA, rbA, rfA, al, bl, 0);
    g_issue<BMODE>(raB, rbB, rfB, al, bl, min(1, nk - 1));
    g_commit<BMODE>(raA, rbA, rfA, sA0, sB0, a_wr, b_wr1);
    __syncthreads();
#pragma unroll 1
    for (int kt = 0; kt < nk; kt += 2) {
        g_issue<BMODE>(raA, rbA, rfA, al, bl, min(kt + 2, nk - 1));
        g_compute<BMODE>(acc, sA0, sB0, a_rd, b_rd0, b_rd1, h, sw);
        g_commit<BMODE>(raB, rbB, rfB, sA1, sB1, a_wr, b_wr1);
        __syncthreads();
        if (kt + 1 >= nk) break;
        g_issue<BMODE>(raB, rbB, rfB, al, bl, min(kt + 3, nk - 1));
        g_compute<BMODE>(acc, sA1, sB1, a_rd, b_rd0, b_rd1, h, sw);
        g_commit<BMODE>(raA, rbA, rfA, sA0, sB0, a_wr, b_wr1);
        __syncthreads();
    }
}

DI void acc_zero(f32x16 (&acc)[2][2]) {
#pragma unroll
    for (int mi = 0; mi < 2; ++mi)
#pragma unroll
        for (int ni = 0; ni < 2; ++ni)
#pragma unroll
            for (int r = 0; r < 16; ++r) acc[mi][ni][r] = 0.f;
}
DI void acc_stage(const f32x16 (&acc)[2][2], float* sC) {
    const int lane = tidx() & 63, wv = tidx() >> 6, wr = wv >> 1, wc = wv & 1, r31 = lane & 31, h = lane >> 5;
#pragma unroll
    for (int mi = 0; mi < 2; ++mi)
#pragma unroll
        for (int ni = 0; ni < 2; ++ni)
#pragma unroll
            for (int r = 0; r < 16; ++r)
                sC[(wr * 64 + mi * 32 + (r & 3) + 8 * (r >> 2) + 4 * h) * 128 + wc * 64 + ni * 32 + r31] = acc[mi][ni][r];
    __syncthreads();
}

DI void ph_p1(const Params& p, int l, int bid, int nb, unsigned char* smem) {
    const int tid = tidx();
    const bf* XB = WSP(bf, OFF_XB);
    const bf* W = WSP(bf, OFF_WIN) + (size_t)l * 2048 * 1024;
    const float* rinv = WSP(float, OFF_RINV1);
    float* sC = (float*)smem;
    for (int u = bid; u < 2048; u += nb) {
        const int mt = u >> 4, nt = u & 15;
        RowLoader al{XB + (size_t)(mt * 128 + (tid >> 3)) * 1024 + (tid & 7) * 8, 1024};
        RowLoader bl{W + (size_t)(nt * 128 + (tid >> 3)) * 1024 + (tid & 7) * 8, 1024};
        float* sRV = (float*)(smem + G_OFF_AUX);
        if (tid < 128) sRV[tid] = rinv[mt * 128 + tid];
        f32x16 acc[2][2];
        acc_zero(acc);
        gemm_mainloop<0>(acc, 16, al, bl, smem);
        acc_stage(acc, sC);
        route_tile(p, l, mt, nt, [=](int r, int c) { return sC[r * 128 + c] * sRV[r]; });
        __syncthreads();
    }
}


DI void ph_p4(const Params& p, int l, int bid, int nb, unsigned char* smem) {
    const int tid = tidx(), lane = tid & 63, wv = tid >> 6, wr = wv >> 1, h = lane >> 5;
    if (bid == 0 && tid < 32) WSP(int, OFF_CTL)[CTL_CNT + tid * 32] = 0;
    const bf* MIX = WSP(bf, OFF_MIX);
    const bf* W = WSP(bf, OFF_WOUT) + (size_t)l * 1024 * 1024;
    const float* xin = l == 0 ? p.in[I_X] : WSP(float, OFF_XFA);
    const float* g2 = p.in[I_N2G] + l * 1024;
    bf* xb1 = WSP(bf, OFF_XB);
    float* sC = (float*)smem; float* sRN = (float*)(smem + G_OFF_AUX);
    for (int u = bid; u < 1024; u += nb) {
        const int mt = u >> 3, nt = u & 7;
        if (tid < 128) { const float* sq = WSP(float, OFF_SSQM) + (size_t)(mt * 128 + tid) * 8; sRN[tid] = rsqrtf((sq[0] + sq[1] + sq[2] + sq[3] + sq[4] + sq[5]) * (1.f / 384.f) + EPS); }
        const bf* abase = MIX + (size_t)(mt * 128 + (tid >> 3)) * 1024 + (tid & 7) * 8;
        const bf* bbase = W + (size_t)(nt * 128 + (tid >> 3)) * 1024 + (tid & 7) * 8;
        f32x16 acc[2][2];
        acc_zero(acc);
        { RowLoader al{abase + 640, 1024}, bl{bbase + 640, 1024}; gemm_mainloop<0>(acc, 6, al, bl, smem); }
#pragma unroll
        for (int mi = 0; mi < 2; ++mi)
#pragma unroll
            for (int r = 0; r < 16; ++r) {
                const float sc = sRN[wr * 64 + mi * 32 + (r & 3) + 8 * (r >> 2) + 4 * h];
                acc[mi][0][r] *= sc; acc[mi][1][r] *= sc;
            }
        { RowLoader al{abase, 1024}, bl{bbase, 1024}; gemm_mainloop<0>(acc, 10, al, bl, smem); }
        acc_stage(acc, sC);
        const float4 ga = *(const float4*)(g2 + nt * 128 + (tid & 15) * 8), gb = *(const float4*)(g2 + nt * 128 + (tid & 15) * 8 + 4);
#pragma unroll 4
        for (int it = 0; it < 8; ++it) {
            const int id = it * 256 + tid, r = id >> 4, c8 = (id & 15) * 8;
            const size_t o = (size_t)(mt * 128 + r) * 1024 + nt * 128 + c8;
            const float4 x0 = *(const float4*)(xin + o), x1 = *(const float4*)(xin + o + 4);
            const float4 c0 = *(const float4*)(sC + r * 128 + c8), c1 = *(const float4*)(sC + r * 128 + c8 + 4);
            float v[8] = {x0.x + c0.x, x0.y + c0.y, x0.z + c0.z, x0.w + c0.w, x1.x + c1.x, x1.y + c1.y, x1.z + c1.z, x1.w + c1.w};
            *(float4*)(p.out + o) = make_float4(v[0], v[1], v[2], v[3]);
            *(float4*)(p.out + o + 4) = make_float4(v[4], v[5], v[6], v[7]);
            float ss = 0.f;
#pragma unroll
            for (int j = 0; j < 8; ++j) ss += v[j] * v[j];
            ss += __shfl_xor(ss, 1); ss += __shfl_xor(ss, 2); ss += __shfl_xor(ss, 4); ss += __shfl_xor(ss, 8);
            if ((id & 15) == 0) WSP(float, OFF_SSQ2)[(size_t)(mt * 128 + r) * 8 + nt] = ss;
            const float gg[8] = {ga.x, ga.y, ga.z, ga.w, gb.x, gb.y, gb.z, gb.w};
#pragma unroll
            for (int j = 0; j < 8; ++j) v[j] *= gg[j];
            store8(xb1 + o, v);
        }
        __syncthreads();
    }
}


DI void ph_router_fast(const Params& p, int l, int bid, int nb, unsigned char* smem) {
    const int tid = tidx(), lane = tid & 63, w = tid >> 6, r31 = lane & 31, h = lane >> 5;
    const bf* WR = WSP(bf, OFF_WR) + (size_t)l * 64 * 1024;
    const bf* XB = WSP(bf, OFF_XB);
    float* sP = (float*)smem;
    int* cnt = WSP(int, OFF_CTL) + CTL_CNT;
    int* list = WSP(int, OFF_LIST);
    float* gatew = WSP(float, OFF_GATEW);
    for (int u = bid; u < NT / 32; u += nb) {
        const int t0 = u * 32;
        f32x16 acc[2];
#pragma unroll
        for (int mi = 0; mi < 2; ++mi)
#pragma unroll
            for (int r = 0; r < 16; ++r) acc[mi][r] = 0.f;
        const bf* xa = XB + (size_t)(t0 + r31) * 1024 + w * 256 + 8 * h;
        const bf* wa = WR + (size_t)r31 * 1024 + w * 256 + 8 * h;
#pragma unroll 4
        for (int ks = 0; ks < 16; ++ks) {
            const bf16x8 xb = *(const bf16x8*)(xa + 16 * ks);
            const bf16x8 a0 = *(const bf16x8*)(wa + 16 * ks), a1 = *(const bf16x8*)(wa + 32 * 1024 + 16 * ks);
            acc[0] = MFMA32(a0, xb, acc[0]);
            acc[1] = MFMA32(a1, xb, acc[1]);
        }
#pragma unroll
        for (int mi = 0; mi < 2; ++mi)
#pragma unroll
            for (int r = 0; r < 16; ++r) sP[(w * 64 + mi * 32 + (r & 3) + 8 * (r >> 2) + 4 * h) * 33 + r31] = acc[mi][r];
        __syncthreads();
        if (tid < 32) {
            const int t = t0 + tid;
            const float* sq = WSP(float, OFF_SSQ2) + (size_t)t * 8;
            const float rinv = rsqrtf((sq[0] + sq[1] + sq[2] + sq[3] + sq[4] + sq[5] + sq[6] + sq[7]) * (1.f / 1024.f) + EPS);
            float lg[4];
#pragma unroll
            for (int j = 0; j < 4; ++j) lg[j] = (sP[j * 33 + tid] + sP[(64 + j) * 33 + tid] + sP[(128 + j) * 33 + tid] + sP[(192 + j) * 33 + tid]) * rinv + p.in[I_RGB][l * 4 + j];
            int g = 0; float gm = lg[0];
#pragma unroll
            for (int j = 1; j < 4; ++j) if (lg[j] > gm) { gm = lg[j]; g = j; }
            float gs = 0.f;
#pragma unroll
            for (int j = 0; j < 4; ++j) gs += __expf(lg[j] - gm);
            const float pg_top = 1.f / gs;
            float e[8];
#pragma unroll
            for (int j = 0; j < 8; ++j) {
                const int jj = 4 + g * 8 + j;
                e[j] = (sP[jj * 33 + tid] + sP[(64 + jj) * 33 + tid] + sP[(128 + jj) * 33 + tid] + sP[(192 + jj) * 33 + tid]) * rinv + p.in[I_REB][l * 32 + g * 8 + j];
            }
            int i1 = 0; float v1 = e[0];
#pragma unroll
            for (int i = 1; i < 8; ++i) if (e[i] > v1) { v1 = e[i]; i1 = i; }
            int i2 = -1; float v2 = -INFINITY;
#pragma unroll
            for (int i = 0; i < 8; ++i) if (i != i1 && e[i] > v2) { v2 = e[i]; i2 = i; }
            const float p2 = __expf(v2 - v1);
            const float g1 = pg_top / (1.f + p2), g2 = pg_top * p2 / (1.f + p2);
            const int e1 = g * 8 + i1, e2 = g * 8 + i2;
            int* sCnt = (int*)(smem + 40960); int* sBase = sCnt + 32;
            sCnt[tid] = 0;
            const int rk1 = atomicAdd(&sCnt[e1], 1);
            const int rk2 = atomicAdd(&sCnt[e2], 1);
            const int mine = sCnt[tid];
            if (mine > 0) sBase[tid] = atomicAdd(&cnt[tid * 32], mine);
            list[e1 * 16384 + sBase[e1] + rk1] = t * 2;
            list[e2 * 16384 + sBase[e2] + rk2] = t * 2 + 1;
            gatew[t * 2] = g1; gatew[t * 2 + 1] = g2;
            WSP(float, OFF_RINV2)[t] = rinv;
        }
        __syncthreads();
    }
}

DI void moe_sched_init(const Params& p, int* aux) {
    if (tidx() == 0) {
        const int* cnt = WSP(int, OFF_CTL) + CTL_CNT;
        int rb = 0, base = 0;
        for (int e = 0; e < 32; ++e) { const int c = cnt[e * 32]; aux[e] = c; aux[32 + e] = rb; aux[65 + e] = base; rb += (c + 127) >> 7; base += c; }
        aux[64] = rb; aux[97] = base;
    }
    __syncthreads();
}
struct MoeUnit { int e, base; };
DI MoeUnit moe_unit(const Params& p, const int* aux, int rbg, int* sEnt, int which) {
    int e = 0;
    while (aux[33 + e] <= rbg) ++e;
    const int rb = rbg - aux[32 + e];
    const int n = aux[e] - rb * 128;
    if (tidx() < 128) {
        const int en = (int)tidx() < n ? WSP(int, OFF_LIST)[e * 16384 + rb * 128 + tidx()] : -1;
        sEnt[tidx()] = en;
        ((float*)sEnt)[128 + tidx()] = en >= 0 ? (which ? WSP(float, OFF_GATEW)[en] : WSP(float, OFF_RINV2)[en >> 1]) : 0.f;
    }
    __syncthreads();
    MoeUnit mu; mu.e = e; mu.base = aux[65 + e] + rb * 128;
    return mu;
}

DI void ph_moe_up(const Params& p, int l, int bid, int nb, unsigned char* smem) {
    const int tid = tidx();
    int* aux = (int*)(smem + G_OFF_AUX); int* sEnt = aux + 128;
    float* sC = (float*)smem;
    moe_sched_init(p, aux);
    const int units = aux[64] * 4;
    const bf* XB = WSP(bf, OFF_XB);
    const float* rinv2 = WSP(float, OFF_RINV2);
    bf* ACT = WSP(bf, OFF_ACT);
    for (int u = bid; u < units; u += nb) {
        const int q = u & 3;
        const MoeUnit mu = moe_unit(p, aux, u >> 2, sEnt, 0);
        const int e = mu.e, base = mu.base;
        GatherLoader al;
#pragma unroll
        for (int i = 0; i < 4; ++i) { const int en = sEnt[(tid >> 3) + 32 * i]; al.rp[i] = en >= 0 ? XB + (size_t)(en >> 1) * 1024 + (tid & 7) * 8 : nullptr; }
        const int n4 = tid & 31;
        TrLoader bl{(n4 < 16 ? p.in[I_W1] : p.in[I_W3]) + (size_t)(l * 32 + e) * 262144 + (size_t)(tid >> 5) * 256 + q * 64 + (n4 & 15) * 4, 256};
        f32x16 acc[2][2];
        acc_zero(acc);
        gemm_mainloop<1>(acc, 16, al, bl, smem);
        acc_stage(acc, sC);
#pragma unroll 1
        for (int it = 0; it < 4; ++it) {
            const int id = it * 256 + tid, r = id >> 3, c8 = (id & 7) * 8;
            const int en = sEnt[r];
            if (en >= 0) {
                const float rs = ((const float*)sEnt)[128 + r];
                float v[8];
#pragma unroll
                for (int j = 0; j < 8; ++j) { const float a = sC[r * 128 + c8 + j] * rs, b = sC[r * 128 + 64 + c8 + j] * rs; v[j] = a * sigmoidf_(a) * b; }
                store8(ACT + (size_t)(base + r) * 256 + q * 64 + c8, v);
            }
        }
        __syncthreads();
    }
}

DI void ph_moe_down(const Params& p, int l, int bid, int nb, unsigned char* smem) {
    const int tid = tidx();
    int* aux = (int*)(smem + G_OFF_AUX); int* sEnt = aux + 128;
    float* sC = (float*)smem;
    moe_sched_init(p, aux);
    const int units = aux[64] * 8;
    const bf* ACT = WSP(bf, OFF_ACT);
    const float* gatew = WSP(float, OFF_GATEW);
    bf* Y = WSP(bf, OFF_Y);
    for (int u = bid; u < units; u += nb) {
        const int nt = u & 7;
        const MoeUnit mu = moe_unit(p, aux, u >> 3, sEnt, 1);
        const int e = mu.e, base = mu.base;
        RowLoader al{ACT + (size_t)(base + (tid >> 3)) * 256 + (tid & 7) * 8, 256};
        TrLoader bl{p.in[I_W2] + (size_t)(l * 32 + e) * 262144 + (size_t)(tid >> 5) * 1024 + nt * 128 + (tid & 31) * 4, 1024};
        f32x16 acc[2][2];
        acc_zero(acc);
        gemm_mainloop<1>(acc, 4, al, bl, smem);
        acc_stage(acc, sC);
#pragma unroll 1
        for (int it = 0; it < 8; ++it) {
            const int id = it * 256 + tid, r = id >> 4, c8 = (id & 15) * 8;
            const int en = sEnt[r];
            if (en >= 0) {
                const float gw = ((const float*)sEnt)[128 + r];
                float v[8];
#pragma unroll
                for (int j = 0; j < 8; ++j) v[j] = sC[r * 128 + c8 + j] * gw;
                store8(Y + ((size_t)(en & 1) * NT + (en >> 1)) * 1024 + nt * 128 + c8, v);
            }
        }
        __syncthreads();
    }
}

template <bool ISQ>
DI void mla_up_unit(const Params& p, int l, int mt, int hd, unsigned char* smem) {
    constexpr int KD = ISQ ? 192 : 128, NCH = KD / 16;
    const int tid = tidx();
    float* sC = (float*)smem; float* sRN = (float*)(smem + G_OFF_AUX);
    const int t0 = mt * 128, b = t0 >> 12, s0 = t0 & 4095;
    const bf* Asrc = ISQ ? WSP(bf, OFF_CQ) : WSP(bf, OFF_CKV);
    {
        const int r = tid >> 1, half = tid & 1;
        const uint4* src = (const uint4*)(Asrc + (size_t)(t0 + r) * KD + half * (KD / 2));
        uint4 v[NCH];
#pragma unroll
        for (int i = 0; i < NCH; ++i) v[i] = src[i];
        float ss = 0.f;
#pragma unroll
        for (int i = 0; i < NCH; ++i) { const unsigned w[4] = {v[i].x, v[i].y, v[i].z, v[i].w};
#pragma unroll
            for (int e = 0; e < 4; ++e) { const float a = lo16(w[e]), c = hi16(w[e]); ss += a * a + c * c; } }
        ss += __shfl_xor(ss, 1);
        if (!half) sRN[r] = rsqrtf(ss * (1.f / (float)KD) + EPS);
    }
    RowLoader al{Asrc + (size_t)(t0 + (tid >> 3)) * KD + (tid & 7) * 8, (size_t)KD};
    const bf* Bsrc = ISQ ? WSP(bf, OFF_WUQ) + (size_t)l * 768 * 192 + (size_t)hd * 128 * 192 : WSP(bf, OFF_WUKV) + (size_t)l * 768 * 128 + (size_t)hd * 128 * 128;
    RowLoader bl{Bsrc + (size_t)(tid >> 3) * KD + (tid & 7) * 8, (size_t)KD};
    f32x16 acc[2][2];
    acc_zero(acc);
    gemm_mainloop<0>(acc, KD / 64, al, bl, smem);
    acc_stage(acc, sC);
    const float* gain = (ISQ ? p.in[I_MQG] : p.in[I_MKG]) + l * 96;
    const int c8 = (tid & 15) * 8, rb = tid >> 4;
    const bool act = c8 < 96, rot = act && c8 >= 64, first = c8 < 80;
    const int pc = first ? c8 + 16 : c8 - 16;
    float gown[8], gpar[8];
#pragma unroll
    for (int jj = 0; jj < 8; ++jj) { gown[jj] = act ? gain[c8 + jj] : 0.f; gpar[jj] = rot ? gain[pc + jj] : 0.f; }
    const bf* KR = WSP(bf, OFF_KR);
    const float* ropet = WSP(float, OFF_ROPE);
    bf* dst = WSP(bf, ISQ ? OFF_MQ : OFF_MK) + ((size_t)(b * 6 + hd) * S + s0) * 96 + c8;
#pragma unroll 2
    for (int it = 0; it < 8; ++it) {
        const int r = it * 16 + rb, t = t0 + r;
        const float rl = sRN[r];
        float v[8], w[8];
#pragma unroll
        for (int jj = 0; jj < 8; ++jj) { v[jj] = 0.f; w[jj] = 0.f; }
        if (act && (ISQ || c8 < 64)) {
            const float4 a0 = *(const float4*)(sC + r * 128 + c8), a1 = *(const float4*)(sC + r * 128 + c8 + 4);
            v[0] = a0.x * rl; v[1] = a0.y * rl; v[2] = a0.z * rl; v[3] = a0.w * rl; v[4] = a1.x * rl; v[5] = a1.y * rl; v[6] = a1.z * rl; v[7] = a1.w * rl;
            if (rot) {
                const float4 b0 = *(const float4*)(sC + r * 128 + pc), b1 = *(const float4*)(sC + r * 128 + pc + 4);
                w[0] = b0.x * rl; w[1] = b0.y * rl; w[2] = b0.z * rl; w[3] = b0.w * rl; w[4] = b1.x * rl; w[5] = b1.y * rl; w[6] = b1.z * rl; w[7] = b1.w * rl;
            }
        } else if (rot) {
            const uint4 ko = *(const uint4*)(KR + (size_t)t * 32 + (c8 - 64)), kp = *(const uint4*)(KR + (size_t)t * 32 + (pc - 64));
            v[0] = lo16(ko.x); v[1] = hi16(ko.x); v[2] = lo16(ko.y); v[3] = hi16(ko.y); v[4] = lo16(ko.z); v[5] = hi16(ko.z); v[6] = lo16(ko.w); v[7] = hi16(ko.w);
            w[0] = lo16(kp.x); w[1] = hi16(kp.x); w[2] = lo16(kp.y); w[3] = hi16(kp.y); w[4] = lo16(kp.z); w[5] = hi16(kp.z); w[6] = lo16(kp.w); w[7] = hi16(kp.w);
        }
        float ss = 0.f;
#pragma unroll
        for (int jj = 0; jj < 8; ++jj) ss += v[jj] * v[jj];
        ss += __shfl_xor(ss, 1); ss += __shfl_xor(ss, 2); ss += __shfl_xor(ss, 4); ss += __shfl_xor(ss, 8);
        const float rn = rsqrtf(ss * (1.f / 96.f) + EPS);
        if (act) {
            float o[8];
            if (!rot) {
#pragma unroll
                for (int jj = 0; jj < 8; ++jj) o[jj] = v[jj] * rn * gown[jj];
            } else {
                const float* rp_ = ropet + (size_t)(s0 + r) * 32 + (c8 & 15);
                const float4 c0 = *(const float4*)(rp_), c1 = *(const float4*)(rp_ + 4), n0 = *(const float4*)(rp_ + 16), n1 = *(const float4*)(rp_ + 20);
                const float cs[8] = {c0.x, c0.y, c0.z, c0.w, c1.x, c1.y, c1.z, c1.w}, sn[8] = {n0.x, n0.y, n0.z, n0.w, n1.x, n1.y, n1.z, n1.w};
#pragma unroll
                for (int jj = 0; jj < 8; ++jj) {
                    const float mine = v[jj] * rn * gown[jj], other = w[jj] * rn * gpar[jj];
                    o[jj] = first ? mine * cs[jj] - other * sn[jj] : other * sn[jj] + mine * cs[jj];
                }
            }
            store8(dst + (size_t)r * 96, o);
        }
    }
    if (!ISQ) {
        bf* mvt = WSP(bf, OFF_MVT);
#pragma unroll 2
        for (int it = 0; it < 4; ++it) {
            const int id = it * 256 + tid, c = id & 63, rc = id >> 6;
            float v[8];
#pragma unroll
            for (int jj = 0; jj < 8; ++jj) v[jj] = sC[(8 * rc + jj) * 128 + 64 + c] * sRN[8 * rc + jj];
            store8(mvt + ((size_t)(b * 6 + hd) * 64 + c) * S + s0 + 8 * rc, v);
        }
    }
    __syncthreads();
}
DI void ph_mla_up(const Params& p, int l, int bid, int nb, unsigned char* smem) {
    for (int u = bid; u < 128 * 12; u += nb) {
        const int mt = u / 12, j = u % 12;
        if (j < 6) mla_up_unit<true>(p, l, mt, j, smem);
        else mla_up_unit<false>(p, l, mt, j - 6, smem);
    }
}

DI void lru_tile_fast(const Params& p, int l, int b, int tile, int mode, unsigned char* smem) {
    const int tid = tidx(), c = tid, lane = tid & 63, n = tid >> 6, r31 = lane & 31, h = lane >> 5;
    unsigned char* sXC = smem; float* sA = (float*)(smem + 16384); bf* sG = (bf*)(smem + 49152);
    const bf* LX = WSP(bf, OFF_LX); const bf* GGp = WSP(bf, OFF_GG);
    const float cw0 = p.in[I_CONVW][(l * 4 + 0) * 256 + c], cw1 = p.in[I_CONVW][(l * 4 + 1) * 256 + c], cw2 = p.in[I_CONVW][(l * 4 + 2) * 256 + c],
                cw3 = p.in[I_CONVW][(l * 4 + 3) * 256 + c], cb = p.in[I_CONVB][l * 256 + c];
    float gba[2], gbx[2], gc8[2];
#pragma unroll
    for (int ni = 0; ni < 2; ++ni) {
        const int ch = 64 * n + 32 * ni + r31;
        gba[ni] = p.in[I_BA][l * 256 + ch]; gbx[ni] = p.in[I_BX][l * 256 + ch];
        gc8[ni] = 8.f * log1pf(__expf(-p.in[I_LAM][l * 256 + ch]));
    }
    bf16x8 wb[2][2][4];
#pragma unroll
    for (int g = 0; g < 2; ++g)
#pragma unroll
        for (int ni = 0; ni < 2; ++ni)
#pragma unroll
            for (int ks = 0; ks < 4; ++ks)
                wb[g][ni][ks] = *(const bf16x8*)(WSP(bf, OFF_WAX) + (size_t)(((l * 2 + g) * 4 + n) * 64 + 32 * ni + r31) * 64 + 16 * ks + 8 * h);
    const int tb = b * S + tile * 64;
    float xm3 = 0.f, xm2 = 0.f, xm1 = 0.f;
    if (tile > 0) { xm3 = bf2f(LX[(size_t)(tb - 3) * 256 + c]); xm2 = bf2f(LX[(size_t)(tb - 2) * 256 + c]); xm1 = bf2f(LX[(size_t)(tb - 1) * 256 + c]); }
    float hs = 0.f, aprod = 1.f;
    if (mode == 1) {
        const float* TOT = WSP(float, OFF_TOT) + (size_t)(b * 64) * 512;
#pragma unroll 8
        for (int i = 0; i < tile; ++i) hs = TOT[i * 512 + c] * hs + TOT[i * 512 + 256 + c];
    }
    const int xoff = (c & 7) * 2, xch = (c & 63) >> 3;
#pragma unroll 1
    for (int half = 0; half < 2; ++half) {
        const int t0 = tb + half * 32;
        float xc[32];
#pragma unroll
        for (int t = 0; t < 32; ++t) {
            const float x0 = bf2f(LX[(size_t)(t0 + t) * 256 + c]);
            xc[t] = cw0 * xm3 + cw1 * xm2 + cw2 * xm1 + cw3 * x0 + cb;
            xm3 = xm2; xm2 = xm1; xm1 = x0;
            *(bf*)(sXC + (n * 32 + t) * 128 + ((xch ^ ((t >> 1) & 7)) << 4) + xoff) = f2bf(xc[t]);
        }
        __syncthreads();
        f32x16 acc[2][2];
#pragma unroll
        for (int g = 0; g < 2; ++g)
#pragma unroll
            for (int ni = 0; ni < 2; ++ni)
#pragma unroll
                for (int r = 0; r < 16; ++r) acc[g][ni][r] = 0.f;
#pragma unroll
        for (int ks = 0; ks < 4; ++ks) {
            const bf16x8 a = *(const bf16x8*)(sXC + (n * 32 + r31) * 128 + (((2 * ks + h) ^ ((r31 >> 1) & 7)) << 4));
#pragma unroll
            for (int g = 0; g < 2; ++g)
#pragma unroll
                for (int ni = 0; ni < 2; ++ni) acc[g][ni] = MFMA32(a, wb[g][ni][ks], acc[g][ni]);
        }
#pragma unroll
        for (int ni = 0; ni < 2; ++ni)
#pragma unroll
            for (int r = 0; r < 16; ++r) {
                const int t = (r & 3) + 8 * (r >> 2) + 4 * h, ch = 64 * n + 32 * ni + r31;
                const float rg = sigmoidf_(acc[0][ni][r] + gba[ni]), ig = sigmoidf_(acc[1][ni][r] + gbx[ni]);
                const float la = -gc8[ni] * rg, y = 2.f * la;
                const float av = __expf(la);
                const float em = y > -0.3f ? y * (1.f + y * (0.5f + y * (0.16666667f + y * 0.041666668f))) : av * av - 1.f;
                sA[t * 256 + ch] = av;
                sG[t * 256 + ch] = f2bf(sqrtf(fmaxf(-em, 0.f)) * ig);
            }
        __syncthreads();
#pragma unroll
        for (int t = 0; t < 32; ++t) {
            const float a = sA[t * 256 + c];
            hs = a * hs + bf2f(sG[t * 256 + c]) * xc[t];
            aprod *= a;
            if (mode == 1) sA[t * 256 + c] = hs * bf2f(GGp[(size_t)(t0 + t) * 256 + c]);
        }
        __syncthreads();
        if (mode == 1) {
            bf* MIX = WSP(bf, OFF_MIX);
#pragma unroll 1
            for (int q = 0; q < 8; ++q) {
                const int t = n * 8 + q;
                const float4 y = *(const float4*)(sA + t * 256 + 4 * lane);
                const float rn = rsqrtf(wave_sum(y.x * y.x + y.y * y.y + y.z * y.z + y.w * y.w) * (1.f / 256.f) + EPS);
                uint2 pk; pk.x = pack2(y.x * rn, y.y * rn); pk.y = pack2(y.z * rn, y.w * rn);
                *(uint2*)(MIX + (size_t)(t0 + t) * 1024 + 4 * lane) = pk;
            }
            __syncthreads();
        }
    }
    if (mode == 0) {
        float* TOT = WSP(float, OFF_TOT) + (size_t)(b * 64 + tile) * 512;
        TOT[c] = aprod; TOT[256 + c] = hs;
    }
}

DI void ph_lru(const Params& p, int l, int mode, int bid, int nb, unsigned char* smem) {
    float* sXC = (float*)smem; float* sY = sXC + 16 * 256;
    for (int u = bid; u < 256; u += nb) lru_tile_fast(p, l, u >> 6, u & 63, mode, smem);
}


DI int pi_row(int r) { return (r & 0x13) | ((r & 4) << 1) | ((r & 8) >> 1); }
DI float fexp2(float x) { return __builtin_amdgcn_exp2f(x); }


template <int KD>
DI void att_issue(uint4& k0r, uint4& k1r, uint4& k2r, uint4& v0r, uint4& v1r, const bf* Kg, const bf* Vg, int j) {
    const int tid = tidx(), k0 = j * 64;
    const bf* src = Kg + (size_t)k0 * KD + tid * 8;
    k0r = *(const uint4*)(src);
    if (KD == 96) { k1r = *(const uint4*)(src + 2048); k2r = *(const uint4*)(src + 4096); }
    const bf* vs = Vg + (size_t)(tid >> 3) * S + k0 + (tid & 7) * 8;
    v0r = *(const uint4*)(vs); v1r = *(const uint4*)(vs + (size_t)32 * S);
}
template <int KD>
DI void att_commit(const uint4& k0r, const uint4& k1r, const uint4& k2r, const uint4& v0r, const uint4& v1r, unsigned char* base) {
    constexpr int KRS = KD == 96 ? 208 : 80, KOFF_V = 64 * KRS;
    const int tid = tidx();
    if (KD == 96) {
        const int i0 = tid, i1 = tid + 256, i2 = tid + 512;
        *(uint4*)(base + (i0 / 12) * 208 + (i0 % 12) * 16) = k0r;
        *(uint4*)(base + (i1 / 12) * 208 + (i1 % 12) * 16) = k1r;
        *(uint4*)(base + (i2 / 12) * 208 + (i2 % 12) * 16) = k2r;
    } else {
        *(uint4*)(base + (tid >> 2) * 80 + (tid & 3) * 16) = k0r;
    }
    const int d = tid >> 3, ch = tid & 7;
    const int voff = KOFF_V + d * 128 + ((ch ^ ((d >> 1) & 7)) << 4);
    *(uint4*)(base + voff) = v0r;
    *(uint4*)(base + voff + 4096) = v1r;
}

template <int KD, bool BIAS, int VAR>
DI void attn_tile(const unsigned char* base, bool diag, float T, float slc, const bf16x8 (&qf)[KD / 16], f32x16 (&O)[2], float& mrun, float& lrun,
                  int krow, int vsw, int w, int r31, int h) {
    constexpr int KRS = KD == 96 ? 208 : 80, KOFF_V = 64 * KRS, NKS = KD / 16;
    constexpr float C = (KD == 96 ? 0.10206207261596575f : 0.17677669529663687f) * 1.4426950408889634f;
    f32x16 sc[2];
    bf16x8 kf[2][NKS];
#pragma unroll
    for (int kb2 = 0; kb2 < 2; ++kb2) {
#pragma unroll
        for (int r = 0; r < 16; ++r) sc[kb2][r] = 0.f;
#pragma unroll
        for (int ks = 0; ks < NKS; ++ks) kf[kb2][ks] = *(const bf16x8*)(base + kb2 * 32 * KRS + krow + ks * 32);
    }
    __builtin_amdgcn_sched_barrier(0);
    if (VAR != 4) {
#pragma unroll
    for (int ks = 0; ks < NKS; ++ks)
#pragma unroll
        for (int kb2 = 0; kb2 < 2; ++kb2) sc[kb2] = MFMA32(kf[kb2][ks], qf[ks], sc[kb2]);
    } else { asm volatile("" :: "v"(kf[0][0]), "v"(kf[1][NKS - 1])); }
    bf16x8 vf[2][4];
#pragma unroll
    for (int db = 0; db < 2; ++db)
#pragma unroll
        for (int s4 = 0; s4 < 4; ++s4) vf[db][s4] = *(const bf16x8*)(base + KOFF_V + (32 * db + r31) * 128 + (((2 * s4 + h) ^ vsw) << 4));
    __builtin_amdgcn_sched_barrier(0);
    if (BIAS) {
        const int ql2 = diag ? 2 * ((w & 1) * 32 + r31) : 4096;
#pragma unroll
        for (int kb2 = 0; kb2 < 2; ++kb2)
#pragma unroll
            for (int r = 0; r < 16; ++r) {
                const int kl = 32 * kb2 + 16 * (r >> 3) + 8 * h + (r & 7);
                sc[kb2][r] = fmaf(slc, (float)min(kl, ql2 - kl), sc[kb2][r]);
            }
    }
    float mx = sc[0][0];
    if (VAR != 1) {
#pragma unroll
    for (int kb2 = 0; kb2 < 2; ++kb2)
#pragma unroll
        for (int r = 0; r < 16; ++r) mx = fmaxf(mx, sc[kb2][r]);
    mx = fmaxf(mx, __shfl_xor(mx, 32));
    }
    const float mnew = VAR == 1 ? mrun : fmaxf(mrun, mx * C + T);
    const float alpha = VAR == 1 ? 1.f : fexp2(mrun - mnew), off = T - mnew;
    float ls = 0.f;
    bf16x8 pf[4];
#pragma unroll
    for (int kb2 = 0; kb2 < 2; ++kb2)
#pragma unroll
        for (int s2 = 0; s2 < 2; ++s2) {
            float pv[8];
#pragma unroll
            for (int jj = 0; jj < 8; ++jj) { pv[jj] = VAR == 1 ? sc[kb2][8 * s2 + jj] : fexp2(fmaf(sc[kb2][8 * s2 + jj], C, off)); ls += pv[jj]; }
            uint4 pk; pk.x = pack2(pv[0], pv[1]); pk.y = pack2(pv[2], pv[3]); pk.z = pack2(pv[4], pv[5]); pk.w = pack2(pv[6], pv[7]);
            pf[2 * kb2 + s2] = __builtin_bit_cast(bf16x8, pk);
        }
    mrun = mnew; lrun = lrun * alpha + ls;
#pragma unroll
    for (int db = 0; db < 2; ++db)
#pragma unroll
        for (int r = 0; r < 16; ++r) O[db][r] *= alpha;
    if (VAR != 4) {
#pragma unroll
    for (int s4 = 0; s4 < 4; ++s4)
#pragma unroll
        for (int db = 0; db < 2; ++db) O[db] = MFMA32(vf[db][s4], pf[s4], O[db]);
    } else { asm volatile("" :: "v"(vf[0][0]), "v"(vf[1][3]), "v"(pf[0]), "v"(pf[3])); }
}

template <int KD, bool BIAS, int VAR>
DI void attn_pass(const bf* Kg, const bf* Vg, const bf* qrow, float sl2, int qb, int jstart, unsigned char* smem, f32x16 (&O)[2], float& lsum) {
    constexpr int KRS = KD == 96 ? 208 : 80, KOFF_V = 64 * KRS, BUF = KOFF_V + 8192, NKS = KD / 16;
    constexpr float C = (KD == 96 ? 0.10206207261596575f : 0.17677669529663687f) * 1.4426950408889634f;
    const int tid = tidx(), lane = tid & 63, w = tid >> 6, r31 = lane & 31, h = lane >> 5;
    const int mychunk = 2 * qb + (w >> 1), nt = 2 * qb + 2;
    bf16x8 qf[NKS];
#pragma unroll
    for (int ks = 0; ks < NKS; ++ks) qf[ks] = *(const bf16x8*)(qrow + 16 * ks);
    float mrun = -1e30f, lrun = 0.f;
#pragma unroll
    for (int db = 0; db < 2; ++db)
#pragma unroll
        for (int r = 0; r < 16; ++r) O[db][r] = 0.f;
    uint4 ak0, ak1, ak2, av0, av1, bk0, bk1, bk2, bv0, bv1;
    ak1 = make_uint4(0, 0, 0, 0); ak2 = ak1; bk1 = ak1; bk2 = ak1;
    att_issue<KD>(ak0, ak1, ak2, av0, av1, Kg, Vg, jstart);
    att_issue<KD>(bk0, bk1, bk2, bv0, bv1, Kg, Vg, jstart + 1);
    att_commit<KD>(ak0, ak1, ak2, av0, av1, smem);
    __syncthreads();
    const int krow = pi_row(r31) * KRS + h * 16;
    const int vsw = (r31 >> 1) & 7;
    const float slc = sl2 * (1.f / C);
#pragma unroll 1
    for (int j = jstart; j < nt; j += 2) {
        if (VAR != 2 && VAR != 3) att_issue<KD>(ak0, ak1, ak2, av0, av1, Kg, Vg, min(j + 2, nt - 1));
        if (j <= mychunk) attn_tile<KD, BIAS, VAR>(smem, j == mychunk, BIAS ? -sl2 * 64.f * (float)(mychunk - j) : 0.f, slc, qf, O, mrun, lrun, krow, vsw, w, r31, h);
        if (VAR != 3) att_commit<KD>(bk0, bk1, bk2, bv0, bv1, smem + BUF);
        __syncthreads();
        if (VAR != 2 && VAR != 3) att_issue<KD>(bk0, bk1, bk2, bv0, bv1, Kg, Vg, min(j + 3, nt - 1));
        if (j + 1 <= mychunk) attn_tile<KD, BIAS, VAR>(smem + BUF, j + 1 == mychunk, BIAS ? -sl2 * 64.f * (float)(mychunk - j - 1) : 0.f, slc, qf, O, mrun, lrun, krow, vsw, w, r31, h);
        if (VAR != 3) att_commit<KD>(ak0, ak1, ak2, av0, av1, smem);
        __syncthreads();
    }
    lsum = lrun + __shfl_xor(lrun, 32);
}

DI void attn_store(const f32x16 (&o)[2], float osc, unsigned char* stg, bf* dst  ) {
    const int lane = tidx() & 63, r31 = lane & 31, h = lane >> 5;
#pragma unroll
    for (int db = 0; db < 2; ++db)
#pragma unroll
        for (int g = 0; g < 4; ++g) {
            uint2 pk; pk.x = pack2(o[db][4 * g] * osc, o[db][4 * g + 1] * osc); pk.y = pack2(o[db][4 * g + 2] * osc, o[db][4 * g + 3] * osc);
            *(uint2*)(stg + r31 * 144 + (32 * db + 8 * g + 4 * h) * 2) = pk;
        }
#pragma unroll
    for (int i = 0; i < 4; ++i) {
        const int id = lane + 64 * i, row = id >> 3, ch = id & 7;
        *(uint4*)(dst + (size_t)row * 1024 + ch * 8) = *(const uint4*)(stg + row * 144 + ch * 16);
    }
}
constexpr int ATT_STG = 2 * (64 * 208 + 8192);

template <int VAR>
DI void mla_unit(const Params& p, int l, int bh, int qb, unsigned char* smem) {
    const int lane = tidx() & 63, w = tidx() >> 6, r31 = lane & 31, h = lane >> 5;
    const int b = bh / 6, hd = bh % 6, q = qb * 128 + 32 * w + r31;
    f32x16 O[2]; float lsum;
    attn_pass<96, false, VAR>(WSP(bf, OFF_MK) + (size_t)bh * S * 96, WSP(bf, OFF_MVT) + (size_t)bh * 64 * S,
                         WSP(bf, OFF_MQ) + ((size_t)bh * S + q) * 96 + 8 * h, 0.f, qb, 0, smem, O, lsum);
    const float inv = 1.f / lsum;
    float ss = 0.f;
#pragma unroll
    for (int db = 0; db < 2; ++db)
#pragma unroll
        for (int r = 0; r < 16; ++r) { O[db][r] *= inv; ss += O[db][r] * O[db][r]; }
    ss += __shfl_xor(ss, 32);
    const int trow = b * S + qb * 128 + 32 * w;
    if (VAR == 0 && h == 0) WSP(float, OFF_SSQM)[(size_t)(trow + r31) * 8 + hd] = ss;
    attn_store(O, 1.f, smem + ATT_STG + w * (32 * 144), WSP(bf, VAR == 0 ? OFF_MIX : OFF_XB) + (size_t)trow * 1024 + 640 + hd * 64);
}

template <int VAR>
DI void diff_unit(const Params& p, int l, int bh, int qb, unsigned char* smem) {
    const int lane = tidx() & 63, w = tidx() >> 6, r31 = lane & 31, h = lane >> 5;
    const int b = bh / 6, hd = bh % 6, q = qb * 128 + 32 * w + r31;
    const float sl2 = exp2f(-8.f * (float)(hd + 1) / 6.f) * 1.4426950408889634f;
    const bf* Vg = WSP(bf, OFF_DVT) + (size_t)bh * 64 * S;
    const float smax2 = WSP(float, OFF_CTL)[CTL_LAM + 2 + l];
    const int ncut = (int)((160.f + 2.f * smax2) / (sl2 * 64.f)) + 2;
    const int jstart = max(0, 2 * qb - ncut) & ~1;
    f32x16 O0[2], O1[2]; float l0, l1;
    attn_pass<32, true, VAR>(WSP(bf, OFF_DK) + (size_t)(bh * 2) * S * 32, Vg, WSP(bf, OFF_DQ) + ((size_t)(bh * 2) * S + q) * 32 + 8 * h, sl2, qb, jstart, smem, O0, l0);
    {
        const float inv = 1.f / l0;
#pragma unroll
        for (int db = 0; db < 2; ++db)
#pragma unroll
            for (int r = 0; r < 16; ++r) O0[db][r] *= inv;
    }
    attn_pass<32, true, VAR>(WSP(bf, OFF_DK) + (size_t)(bh * 2 + 1) * S * 32, Vg, WSP(bf, OFF_DQ) + ((size_t)(bh * 2 + 1) * S + q) * 32 + 8 * h, sl2, qb, jstart, smem, O1, l1);
    const float lam1 = WSP(float, OFF_CTL)[CTL_LAM + l] / l1;
    float ss = 0.f;
#pragma unroll
    for (int db = 0; db < 2; ++db)
#pragma unroll
        for (int r = 0; r < 16; ++r) { const float v = O0[db][r] - lam1 * O1[db][r]; O0[db][r] = v; ss += v * v; }
    ss += __shfl_xor(ss, 32);
    const int trow = b * S + qb * 128 + 32 * w;
    attn_store(O0, rsqrtf(ss * (1.f / 64.f) + EPS), smem + ATT_STG + w * (32 * 144), WSP(bf, VAR == 0 ? OFF_MIX : OFF_XB) + (size_t)trow * 1024 + 256 + hd * 64);
}

constexpr int P3_QLEN = 192 + 32;
template <int VAR>
DI void ph_p3(const Params& p, int l, int qslot, unsigned char* smem) {
    int* qheads = WSP(int, OFF_CTL) + CTL_Q + qslot * 256;
    int* sU = (int*)(smem + GEMM_SMEM + 16);
    float* sXC = (float*)smem; float* sY = sXC + 16 * 256;
    const int x0 = (int)(xcc_id() & 7u);
    int qi = 0;
    for (;;) {
        const int x = (x0 + qi) & 7;
        if (tidx() == 0) *sU = atomicAdd(qheads + x * 32, 1);
        __syncthreads();
        const int u = *sU;
        __syncthreads();
        if (u >= P3_QLEN) { if (++qi == 8) break; continue; }
        if (u < 192) {
            const int qb = 31 - u / 6, c = u % 6, bh = x + 8 * (c % 3);
            if (c < 3) diff_unit<VAR>(p, l, bh, qb, smem);
            else mla_unit<VAR>(p, l, bh, qb, smem);
        } else {
            const int v = x * 32 + (u - 192);
            if (VAR == 0) lru_tile_fast(p, l, v >> 6, v & 63, 1, smem);
        }
    }
}

DI void ph_mla_up_naive(const Params& p, int l, int bid, int nb, unsigned char* smem) {
    float (*sCQ)[192] = (float (*)[192])smem; float (*sCKV)[128] = (float (*)[128])(smem + 4 * 192 * 4);
    float (*sQ)[576] = (float (*)[576])(smem + 4 * 320 * 4); float (*sKV)[768] = (float (*)[768])(smem + 4 * 896 * 4);
    const int tid = tidx(), lane = tid & 63, wv = tid >> 6;
    for (int u = bid; u < NT / 4; u += nb) {
    const int t0 = u * 4;
    {
        const int t = t0 + wv;
        const bf* cq = WSP(bf, OFF_CQ) + (size_t)t * 192; const bf* ckv = WSP(bf, OFF_CKV) + (size_t)t * 128;
        float a0 = bf2f(cq[lane]), a1 = bf2f(cq[lane + 64]), a2 = bf2f(cq[lane + 128]);
        float ss = wave_sum(a0 * a0 + a1 * a1 + a2 * a2);
        float rn = rsqrtf(ss * (1.f / 192.f) + EPS);
        sCQ[wv][lane] = a0 * rn; sCQ[wv][lane + 64] = a1 * rn; sCQ[wv][lane + 128] = a2 * rn;
        float b0 = bf2f(ckv[lane]), b1 = bf2f(ckv[lane + 64]);
        ss = wave_sum(b0 * b0 + b1 * b1);
        rn = rsqrtf(ss * (1.f / 128.f) + EPS);
        sCKV[wv][lane] = b0 * rn; sCKV[wv][lane + 64] = b1 * rn;
    }
    __syncthreads();
    const bf* WUQ = WSP(bf, OFF_WUQ) + (size_t)l * 768 * 192;
    const bf* WUKV = WSP(bf, OFF_WUKV) + (size_t)l * 768 * 128;
    for (int n = tid; n < 576; n += 256) {
        float acc[4] = {0.f, 0.f, 0.f, 0.f};
        for (int k = 0; k < 192; ++k) { const float w = bf2f(WUQ[(size_t)((n / 96) * 128 + n % 96) * 192 + k]);
#pragma unroll
            for (int q = 0; q < 4; ++q) acc[q] += sCQ[q][k] * w; }
#pragma unroll
        for (int q = 0; q < 4; ++q) sQ[q][n] = acc[q];
    }
    for (int n = tid; n < 768; n += 256) {
        float acc[4] = {0.f, 0.f, 0.f, 0.f};
        for (int k = 0; k < 128; ++k) { const float w = bf2f(WUKV[(size_t)n * 128 + k]);
#pragma unroll
            for (int q = 0; q < 4; ++q) acc[q] += sCKV[q][k] * w; }
#pragma unroll
        for (int q = 0; q < 4; ++q) sKV[q][n] = acc[q];
    }
    __syncthreads();
    if (tid < 48) {
        const int tok = tid / 12, h = (tid % 12) >> 1, which = tid & 1;
        const int t = t0 + tok, b = t >> 12, s = t & 4095;
        const float* rope = WSP(float, OFF_ROPE) + s * 32;
        const float* gain = (which ? p.in[I_MKG] : p.in[I_MQG]) + l * 96;
        const bf* kr = WSP(bf, OFF_KR) + (size_t)t * 32;
        bf* dst = WSP(bf, which ? OFF_MK : OFF_MQ) + ((size_t)(b * 6 + h) * S + s) * 96;
        float ss = 0.f;
        for (int d = 0; d < 96; ++d) {
            const float v = which ? (d < 64 ? sKV[tok][h * 128 + d] : bf2f(kr[d - 64])) : sQ[tok][h * 96 + d];
            ss += v * v;
        }
        const float rn = rsqrtf(ss * (1.f / 96.f) + EPS);
        for (int d = 0; d < 64; ++d) {
            const float v = which ? sKV[tok][h * 128 + d] : sQ[tok][h * 96 + d];
            dst[d] = f2bf(v * rn * gain[d]);
        }
        for (int i = 0; i < 16; ++i) {
            const float x1 = (which ? bf2f(kr[i]) : sQ[tok][h * 96 + 64 + i]) * rn * gain[64 + i];
            const float x2 = (which ? bf2f(kr[16 + i]) : sQ[tok][h * 96 + 80 + i]) * rn * gain[80 + i];
            const float cs = rope[i], sn = rope[16 + i];
            dst[64 + i] = f2bf(x1 * cs - x2 * sn);
            dst[80 + i] = f2bf(x1 * sn + x2 * cs);
        }
    }
    bf* mvt = WSP(bf, OFF_MVT);
    for (int e = tid; e < 4 * 384; e += 256) {
        const int tok = e / 384, r = e % 384, h = r >> 6, d = r & 63;
        const int t = t0 + tok, b = t >> 12, s = t & 4095;
        mvt[((size_t)(b * 6 + h) * 64 + d) * S + s] = f2bf(sKV[tok][h * 128 + 64 + d]);
    }
    __syncthreads();
    }
}

DI float rdlane(float v, int j) { return __int_as_float(__builtin_amdgcn_readlane(__float_as_int(v), j)); }

DI void ph_diff_attn_naive(const Params& p, int l, int bid, int nb) {
    for (int u = bid; u < NB * 6 * S / 4; u += nb) {
    const int lane = tidx() & 63, gw = u * 4 + (tidx() >> 6);
    const int q = gw & 4095, bh = gw >> 12, h = bh % 6, b = bh / 6;
    const bf* DQ = WSP(bf, OFF_DQ); const bf* DK = WSP(bf, OFF_DK); const bf* DVT = WSP(bf, OFF_DVT);
    float lam;
    {
        float d1 = 0.f, d2 = 0.f;
        for (int i = 0; i < 32; ++i) { d1 += p.in[I_LQ1][l * 32 + i] * p.in[I_LK1][l * 32 + i]; d2 += p.in[I_LQ2][l * 32 + i] * p.in[I_LK2][l * 32 + i]; }
        lam = expf(d1) - expf(d2) + lambda_init(l);
    }
    const float slope = exp2f(-8.f * (float)(h + 1) / 6.f);
    const float scale = 0.17677669529663687f;
    float q0[32], q1[32];
    {
        const bf* a = DQ + ((size_t)(bh * 2 + 0) * S + q) * 32; const bf* c = DQ + ((size_t)(bh * 2 + 1) * S + q) * 32;
#pragma unroll
        for (int d = 0; d < 32; ++d) { q0[d] = bf2f(a[d]); q1[d] = bf2f(c[d]); }
    }
    float m0 = -INFINITY, m1 = -INFINITY, l0 = 0.f, l1 = 0.f, o0 = 0.f, o1 = 0.f;
    const int nkb = (q >> 6) + 1;
    for (int kb = 0; kb < nkb; ++kb) {
        const int k = kb * 64 + lane;
        const uint4* ka = (const uint4*)(DK + ((size_t)(bh * 2 + 0) * S + k) * 32);
        const uint4* kc = (const uint4*)(DK + ((size_t)(bh * 2 + 1) * S + k) * 32);
        float s0 = 0.f, s1 = 0.f;
#pragma unroll
        for (int i = 0; i < 4; ++i) {
            const uint4 u = ka[i], w = kc[i];
            const unsigned uu[4] = {u.x, u.y, u.z, u.w}, ww[4] = {w.x, w.y, w.z, w.w};
#pragma unroll
            for (int e = 0; e < 4; ++e) {
                s0 += q0[i * 8 + e * 2] * lo16(uu[e]) + q0[i * 8 + e * 2 + 1] * hi16(uu[e]);
                s1 += q1[i * 8 + e * 2] * lo16(ww[e]) + q1[i * 8 + e * 2 + 1] * hi16(ww[e]);
            }
        }
        const float bias = -slope * fabsf((float)(q - k));
        s0 = s0 * scale + bias; s1 = s1 * scale + bias;
        const float n0 = fmaxf(m0, wave_max(s0)), n1 = fmaxf(m1, wave_max(s1));
        const float a0 = __expf(m0 - n0), a1 = __expf(m1 - n1);
        const float p0 = __expf(s0 - n0), p1 = __expf(s1 - n1);
        l0 = l0 * a0 + p0; l1 = l1 * a1 + p1; o0 *= a0; o1 *= a1; m0 = n0; m1 = n1;
        const uint4* vp = (const uint4*)(DVT + ((size_t)bh * 64 + lane) * S + kb * 64);
        uint4 v[8];
#pragma unroll
        for (int i = 0; i < 8; ++i) v[i] = vp[i];
#pragma unroll
        for (int i = 0; i < 8; ++i) {
            const unsigned vv[4] = {v[i].x, v[i].y, v[i].z, v[i].w};
#pragma unroll
            for (int e = 0; e < 4; ++e) {
                const int j = i * 8 + e * 2;
                const float va = lo16(vv[e]), vb = hi16(vv[e]);
                o0 += rdlane(p0, j) * va + rdlane(p0, j + 1) * vb;
                o1 += rdlane(p1, j) * va + rdlane(p1, j + 1) * vb;
            }
        }
    }
    const float L0 = wave_sum(l0), L1 = wave_sum(l1);
    const float o = o0 / L0 - lam * (o1 / L1);
    const float ss = wave_sum(o * o);
    WSP(bf, OFF_MIX)[(size_t)(b * S + q) * 1024 + 256 + h * 64 + lane] = f2bf(o * rsqrtf(ss * (1.f / 64.f) + EPS));
    }
}

DI void ph_mla_attn_naive(const Params& p, int l, int bid, int nb) {
    for (int u = bid; u < NB * 6 * S / 4; u += nb) {
    const int lane = tidx() & 63, gw = u * 4 + (tidx() >> 6);
    const int q = gw & 4095, bh = gw >> 12, h = bh % 6, b = bh / 6;
    const bf* MQ = WSP(bf, OFF_MQ); const bf* MK = WSP(bf, OFF_MK); const bf* MVT = WSP(bf, OFF_MVT);
    const float scale = 0.10206207261596575f;
    float qv[96];
    {
        const bf* a = MQ + ((size_t)bh * S + q) * 96;
#pragma unroll
        for (int d = 0; d < 96; ++d) qv[d] = bf2f(a[d]);
    }
    float m0 = -INFINITY, l0 = 0.f, o0 = 0.f;
    const int nkb = (q >> 6) + 1;
    for (int kb = 0; kb < nkb; ++kb) {
        const int k = kb * 64 + lane;
        const uint4* ka = (const uint4*)(MK + ((size_t)bh * S + k) * 96);
        float s0 = 0.f;
#pragma unroll
        for (int i = 0; i < 12; ++i) {
            const uint4 u = ka[i];
            const unsigned uu[4] = {u.x, u.y, u.z, u.w};
#pragma unroll
            for (int e = 0; e < 4; ++e) s0 += qv[i * 8 + e * 2] * lo16(uu[e]) + qv[i * 8 + e * 2 + 1] * hi16(uu[e]);
        }
        s0 *= scale;
        const float n0 = fmaxf(m0, wave_max(s0));
        const float a0 = __expf(m0 - n0), p0 = __expf(s0 - n0);
        l0 = l0 * a0 + p0; o0 *= a0; m0 = n0;
        const uint4* vp = (const uint4*)(MVT + ((size_t)bh * 64 + lane) * S + kb * 64);
        uint4 v[8];
#pragma unroll
        for (int i = 0; i < 8; ++i) v[i] = vp[i];
#pragma unroll
        for (int i = 0; i < 8; ++i) {
            const unsigned vv[4] = {v[i].x, v[i].y, v[i].z, v[i].w};
#pragma unroll
            for (int e = 0; e < 4; ++e) {
                const int j = i * 8 + e * 2;
                o0 += rdlane(p0, j) * lo16(vv[e]) + rdlane(p0, j + 1) * hi16(vv[e]);
            }
        }
    }
    const float o = o0 / wave_sum(l0);
    const float ss = wave_sum(o * o);
    const int t = b * S + q;
    WSP(bf, OFF_MIX)[(size_t)t * 1024 + 640 + h * 64 + lane] = f2bf(o);
    if (lane == 0) WSP(float, OFF_SSQM)[t * 8 + h] = ss;
    }
}

DI void ph_mla_norm_fix(const Params& p, int bid, int nb) {
    for (int gid = bid * 256 + tidx(); gid < NT * 48; gid += nb * 256) {
    const int t = gid / 48, c8 = (gid % 48) * 8;
    const float* sq = WSP(float, OFF_SSQM) + t * 8;
    const float rn = rsqrtf((sq[0] + sq[1] + sq[2] + sq[3] + sq[4] + sq[5]) * (1.f / 384.f) + EPS);
    bf* m = WSP(bf, OFF_MIX) + (size_t)t * 1024 + 640 + c8;
    float v[8];
#pragma unroll
    for (int j = 0; j < 8; ++j) v[j] = bf2f(m[j]) * rn;
    store8(m, v);
    }
}

DI void ph_p4_gemm_naive(const Params& p, int l, int bid, int nb, unsigned char* smem) {
    float* sA = (float*)smem; float* sB = sA + 16 * 68;
    if (bid == 0 && tidx() < 32) WSP(int, OFF_CTL)[CTL_CNT + tidx()] = 0;
    for (int u = bid; u < 4096; u += nb) {
    const int mt = u / 16, nt = u % 16;
    const bf* A = WSP(bf, OFF_MIX) + (size_t)mt * 64 * D;
    const bf* Bt = WSP(bf, OFF_WOUT) + (size_t)l * 1024 * 1024 + (size_t)(nt * 64) * 1024;
    const float* xin = (l == 0 ? p.in[I_X] : WSP(float, OFF_XFA)) + (size_t)mt * 64 * D + nt * 64;
    float* x1 = p.out + (size_t)mt * 64 * D + nt * 64;
    bf* xb1 = WSP(bf, OFF_XB) + (size_t)mt * 64 * D + nt * 64;
    const float* g2 = p.in[I_N2G] + l * 1024 + nt * 64;
    ngemm_tile<true>(1024, [=](int r, int k) { return bf2f(A[(size_t)r * D + k]); }, [=](int k, int c) { return bf2f(Bt[(size_t)c * 1024 + k]); },
               [=](int r, int c, float v) { const float x = xin[(size_t)r * D + c] + v; x1[(size_t)r * D + c] = x; xb1[(size_t)r * D + c] = f2bf(x * g2[c]); }, sA, sB);
    }
}

DI void ph_router(const Params& p, int l, int bid, int nb) {
    const int lane = tidx() & 63, gw = bid * 4 + (tidx() >> 6), nw = nb * 4;
    const float* WR = WSP(float, OFF_WR) + (size_t)l * 36 * 1024;
    int* cnt = WSP(int, OFF_CTL) + CTL_CNT;
    int* list = WSP(int, OFF_LIST);
    float* gatew = WSP(float, OFF_GATEW);
    for (int t = gw; t < NT; t += nw) {
        const float* x = p.out + (size_t)t * D;
        float4 xv[4]; float ss = 0.f;
#pragma unroll
        for (int i = 0; i < 4; ++i) { xv[i] = *(const float4*)(x + lane * 4 + 256 * i); ss += xv[i].x * xv[i].x + xv[i].y * xv[i].y + xv[i].z * xv[i].z + xv[i].w * xv[i].w; }
        ss = wave_sum(ss);
        const float rinv = rsqrtf(ss * (1.f / 1024.f) + EPS);
        float lg[4];
#pragma unroll
        for (int j = 0; j < 4; ++j) {
            float a = 0.f;
#pragma unroll
            for (int i = 0; i < 4; ++i) { const float4 w = *(const float4*)(WR + (size_t)j * 1024 + lane * 4 + 256 * i); a += xv[i].x * w.x + xv[i].y * w.y + xv[i].z * w.z + xv[i].w * w.w; }
            lg[j] = wave_sum(a) * rinv + p.in[I_RGB][l * 4 + j];
        }
        int g = 0; float gm = lg[0];
#pragma unroll
        for (int j = 1; j < 4; ++j) if (lg[j] > gm) { gm = lg[j]; g = j; }
        float gs = 0.f;
#pragma unroll
        for (int j = 0; j < 4; ++j) gs += __expf(lg[j] - gm);
        const float pg_top = 1.f / gs;
        float e[8];
#pragma unroll
        for (int j = 0; j < 8; ++j) {
            const float* wrow = WR + (size_t)(4 + g * 8 + j) * 1024;
            float a = 0.f;
#pragma unroll
            for (int i = 0; i < 4; ++i) { const float4 w = *(const float4*)(wrow + lane * 4 + 256 * i); a += xv[i].x * w.x + xv[i].y * w.y + xv[i].z * w.z + xv[i].w * w.w; }
            e[j] = wave_sum(a) * rinv + p.in[I_REB][l * 32 + g * 8 + j];
        }
        int i1 = 0; float v1 = e[0];
#pragma unroll
        for (int i = 1; i < 8; ++i) if (e[i] > v1) { v1 = e[i]; i1 = i; }
        int i2 = -1; float v2 = -INFINITY;
#pragma unroll
        for (int i = 0; i < 8; ++i) if (i != i1 && e[i] > v2) { v2 = e[i]; i2 = i; }
        const float p1 = 1.f, p2 = __expf(v2 - v1);
        const float g1 = pg_top * p1 / (p1 + p2), g2 = pg_top * p2 / (p1 + p2);
        if (lane == 0) {
            const int e1 = g * 8 + i1, e2 = g * 8 + i2;
            const int pos1 = atomicAdd(&cnt[e1], 1); list[e1 * 16384 + pos1] = t * 2;
            const int pos2 = atomicAdd(&cnt[e2], 1); list[e2 * 16384 + pos2] = t * 2 + 1;
            gatew[t * 2] = g1; gatew[t * 2 + 1] = g2;
            WSP(float, OFF_RINV2)[t] = rinv;
        }
    }
}

DI void ph_moe_up_naive(const Params& p, int l, int bid, int nb, unsigned char* smem) {
    float* sA = (float*)smem; float* sB = sA + 16 * 68; int* sTok = (int*)(sB + 16 * 68);
    for (int u = bid; u < 32 * 256 * 8; u += nb) {
    const int nt = u & 7, rb = (u >> 3) & 255, e = u >> 11;
    const int* cnt = WSP(int, OFF_CTL) + CTL_CNT;
    const int n = cnt[e];
    if (rb * 64 >= n) continue;
    int base = 0; for (int i = 0; i < e; ++i) base += cnt[i];
    if (tidx() < 64) { const int r = rb * 64 + tidx(); sTok[tidx()] = r < n ? (WSP(int, OFF_LIST)[e * 16384 + r] >> 1) : -1; }
    __syncthreads();
    const bf* XB = WSP(bf, OFF_XB);
    const float* W = (nt < 4 ? p.in[I_W1] : p.in[I_W3]) + (size_t)(l * 32 + e) * 1024 * 256 + (nt & 3) * 64;
    const float* rinv2 = WSP(float, OFF_RINV2);
    float* H = WSP(float, OFF_H13) + (size_t)(base + rb * 64) * 512 + nt * 64;
    const int* tk = sTok;
    ngemm_tile<false>(1024, [=](int r, int k) { const int t = tk[r]; return t >= 0 ? bf2f(XB[(size_t)t * D + k]) : 0.f; }, [=](int k, int c) { return bf2f(f2bf(W[(size_t)k * 256 + c])); },
               [=](int r, int c, float v) { const int t = tk[r]; if (t >= 0) H[(size_t)r * 512 + c] = v * rinv2[t]; }, sA, sB);
    }
}

DI void ph_moe_act_naive(const Params& p, int bid, int nb) {
    for (int gid = bid * 256 + tidx(); gid < 32768 * 32; gid += nb * 256) {
    const int row = gid >> 5, c8 = (gid & 31) * 8;
    const float* H = WSP(float, OFF_H13) + (size_t)row * 512;
    float v[8];
#pragma unroll
    for (int j = 0; j < 8; ++j) { const float a = H[c8 + j], b = H[256 + c8 + j]; v[j] = a * sigmoidf_(a) * b; }
    store8(WSP(bf, OFF_ACT) + (size_t)row * 256 + c8, v);
    }
}

DI void ph_moe_down_naive(const Params& p, int l, int bid, int nb, unsigned char* smem) {
    float* sA = (float*)smem; float* sB = sA + 16 * 68; int* sEnt = (int*)(sB + 16 * 68);
    for (int u = bid; u < 32 * 256 * 16; u += nb) {
    const int nt = u & 15, rb = (u >> 4) & 255, e = u >> 12;
    const int* cnt = WSP(int, OFF_CTL) + CTL_CNT;
    const int n = cnt[e];
    if (rb * 64 >= n) continue;
    int base = 0; for (int i = 0; i < e; ++i) base += cnt[i];
    if (tidx() < 64) { const int r = rb * 64 + tidx(); sEnt[tidx()] = r < n ? WSP(int, OFF_LIST)[e * 16384 + r] : -1; }
    __syncthreads();
    const bf* A = WSP(bf, OFF_ACT) + (size_t)(base + rb * 64) * 256;
    const float* W = p.in[I_W2] + (size_t)(l * 32 + e) * 256 * 1024 + nt * 64;
    const float* gatew = WSP(float, OFF_GATEW);
    bf* Y = WSP(bf, OFF_Y);
    const int* en = sEnt;
    ngemm_tile<false>(256, [=](int r, int k) { return en[r] >= 0 ? bf2f(A[(size_t)r * 256 + k]) : 0.f; }, [=](int k, int c) { return bf2f(f2bf(W[(size_t)k * 1024 + c])); },
               [=](int r, int c, float v) { const int en_ = en[r]; if (en_ >= 0) Y[((size_t)(en_ & 1) * NT + (en_ >> 1)) * D + nt * 64 + c] = f2bf(v * gatew[en_]); }, sA, sB);
    }
}

DI void ph_combine(const Params& p, int last, int bid, int nb) {
    const int lane = tidx() & 63, gw = bid * 4 + (tidx() >> 6), nw = nb * 4;
    const bf* Y = WSP(bf, OFF_Y);
    float* xo = last ? p.out : WSP(float, OFF_XFA);
    bf* xb = WSP(bf, OFF_XB);
    for (int t = gw; t < NT; t += nw) {
        float ss = 0.f;
#pragma unroll
        for (int i = 0; i < 2; ++i) {
            const int c = (lane + 64 * i) * 8;
            const float4 a = *(const float4*)(p.out + (size_t)t * D + c), b = *(const float4*)(p.out + (size_t)t * D + c + 4);
            const uint4 y0 = *(const uint4*)(Y + (size_t)t * D + c), y1 = *(const uint4*)(Y + ((size_t)NT + t) * D + c);
            float v[8] = {a.x, a.y, a.z, a.w, b.x, b.y, b.z, b.w};
            const unsigned u0[4] = {y0.x, y0.y, y0.z, y0.w}, u1[4] = {y1.x, y1.y, y1.z, y1.w};
#pragma unroll
            for (int e = 0; e < 4; ++e) { v[2 * e] += lo16(u0[e]) + lo16(u1[e]); v[2 * e + 1] += hi16(u0[e]) + hi16(u1[e]); }
#pragma unroll
            for (int j = 0; j < 8; ++j) ss += v[j] * v[j];
            *(float4*)(xo + (size_t)t * D + c) = make_float4(v[0], v[1], v[2], v[3]);
            *(float4*)(xo + (size_t)t * D + c + 4) = make_float4(v[4], v[5], v[6], v[7]);
            if (!last) store8(xb + (size_t)t * D + c, v);
        }
        ss = wave_sum(ss);
        if (!last && lane == 0) WSP(float, OFF_RINV1)[t] = rsqrtf(ss * (1.f / 1024.f) + EPS);
    }
}


#define XB_TMO      128
#define XB_XCNT(j)  (256  + 64 * (j))
#define XB_XSUB(j)  (1280 + 64 * (j))
#define XB_XGEN(j)  (2304 + 64 * (j))
#define XB_TOP      3328
#define XB_TOPGEN   3392
#define XCD_BAR_WORDS 3456
#define XB_SPIN_CAP (1u << 22)
#define LAS __attribute__((address_space(3)))
constexpr size_t OFF_BAR = OFF_CTL + 16384;
static_assert(16384 + XCD_BAR_WORDS * 4 <= 65536, "ctl region");

DI unsigned xb_ld(unsigned* p) { return __hip_atomic_load(p, __ATOMIC_RELAXED, __HIP_MEMORY_SCOPE_AGENT); }
DI unsigned xb_add(unsigned* p, unsigned v) { return __hip_atomic_fetch_add(p, v, __ATOMIC_RELAXED, __HIP_MEMORY_SCOPE_AGENT); }
DI unsigned xb_xcc_id() { return (unsigned)__builtin_amdgcn_s_getreg((3 << 11) | 20) & 0xFu; }
#define XB_SPIN(cond, bar) do { unsigned _sp = 0; while (cond) { __builtin_amdgcn_s_sleep(1); \
    if ((++_sp & 255u) == 0u) { if (xb_ld(&(bar)[XB_TMO])) break; if (_sp > XB_SPIN_CAP) { atomicAdd(&(bar)[XB_TMO], 1u); break; } } } } while (0)

struct XcdBarrier { unsigned* bar; unsigned x; volatile LAS unsigned* st; };

DI XcdBarrier xcd_barrier_post(unsigned* bar, volatile LAS unsigned* st) {
    XcdBarrier b; b.bar = bar; b.x = xb_xcc_id(); b.st = st;
    if (tidx() == 0) (void)xb_add(&bar[XB_XCNT(b.x)], 1u);
    return b;
}
DI void xcd_barrier_complete(unsigned* bar, unsigned x, unsigned& nloc, unsigned& nx) {
    const unsigned G = gridDim.x * gridDim.y * gridDim.z;
    unsigned sum, cnt, mine, sp = 0u;
    for (;;) {
        sum = 0u; cnt = 0u; mine = 0u;
#pragma unroll
        for (unsigned j = 0; j < 16; ++j) { const unsigned c = xb_ld(&bar[XB_XCNT(j)]); sum += c; cnt += (c > 0u) ? 1u : 0u; mine = (j == x) ? c : mine; }
        if (sum == G) break;
        __builtin_amdgcn_s_sleep(1);
        if ((++sp & 255u) == 0u) { if (xb_ld(&bar[XB_TMO])) break; if (sp > XB_SPIN_CAP) { atomicAdd(&bar[XB_TMO], 1u); break; } }
    }
    nloc = mine > 0u ? mine : 1u; nx = cnt > 0u ? cnt : 1u;
}
DI void xcd_barrier(const XcdBarrier& b) {
    asm volatile("s_waitcnt vmcnt(0)" ::: "memory");
    __syncthreads();
    if (tidx() == 0) {
        unsigned* bar = b.bar;
        __builtin_amdgcn_s_waitcnt(0);
        unsigned nloc = b.st[0], nx = b.st[1];
        if (nloc == 0u) { xcd_barrier_complete(bar, b.x, nloc, nx); b.st[0] = nloc; b.st[1] = nx; }
        const unsigned old = xb_add(&bar[XB_XSUB(b.x)], 1u);
        const unsigned gen = old / nloc;
        if (old + 1u == (gen + 1u) * nloc) {
            __builtin_amdgcn_fence(__ATOMIC_RELEASE, "agent");
            asm volatile("s_waitcnt vmcnt(0)" ::: "memory");
            const unsigned og = xb_add(&bar[XB_TOP], 1u);
            const unsigned tg = og / nx;
            if (og + 1u == (tg + 1u) * nx) xb_add(&bar[XB_TOPGEN], 1u);
            else XB_SPIN(xb_ld(&bar[XB_TOPGEN]) == tg, bar);
            __builtin_amdgcn_fence(__ATOMIC_ACQUIRE, "agent");
            xb_add(&bar[XB_XGEN(b.x)], 1u);
            asm volatile("s_waitcnt vmcnt(0)" ::: "memory");
        } else {
            XB_SPIN(xb_ld(&bar[XB_XGEN(b.x)]) == gen, bar);
            __builtin_amdgcn_fence(__ATOMIC_ACQUIRE, "agent");
            asm volatile("s_waitcnt vmcnt(0)" ::: "memory");
        }
    }
    __syncthreads();
}

#define USE_CG_SYNC 0
#ifndef PROBE
#define PROBE 0
#endif
#define FAST_P1 1
#define FAST_ATTN 1
#define FAST_P4 1
#define FAST_MOE 1
#define FAST_MLAUP 1
constexpr int SMEM_BYTES = GEMM_SMEM + 64;
#if USE_CG_SYNC
#define GRID_SYNC() grid.sync()
#else
#define GRID_SYNC() xcd_barrier(xbar)
#endif

__global__ void __launch_bounds__(256, 2) mega_fwd(Params p) {
    extern __shared__ __attribute__((aligned(16))) unsigned char smem[];
#if USE_CG_SYNC
    cg::grid_group grid = cg::this_grid();
#else
    if (tidx() < 8) ((unsigned*)(smem + GEMM_SMEM))[tidx()] = 0u;
    __syncthreads();
    XcdBarrier xbar = xcd_barrier_post((unsigned*)(p.ws + OFF_BAR), (volatile LAS unsigned*)(smem + GEMM_SMEM));
#endif
    const int bid = blockIdx.x, nb = gridDim.x;
    ph_prep_weights(p, bid, nb, smem);
    ph_prep_misc(p, bid, nb);
    ph_prep_x(p, bid, nb);
    GRID_SYNC();
#if PROBE == 9
    for (int i = 0; i < 20; ++i) GRID_SYNC();
#endif
#if PROBE == 8
    ph_prep_weights(p, bid, nb, smem); ph_prep_misc(p, bid, nb); ph_prep_x(p, bid, nb); GRID_SYNC();
#endif
    for (int l = 0; l < 2; ++l) {
        ph_p1(p, l, bid, nb, smem);
        GRID_SYNC();
#if PROBE == 1
        ph_p1(p, l, bid, nb, smem); GRID_SYNC();
#endif
        ph_lru(p, l, 0, bid, nb, smem);
        ph_mla_up(p, l, bid, nb, smem);
        GRID_SYNC();
#if PROBE == 2
        ph_lru(p, l, 0, bid, nb, smem); ph_mla_up(p, l, bid, nb, smem); GRID_SYNC();
#endif
        ph_p3<0>(p, l, l, smem);
        GRID_SYNC();
#if PROBE >= 30 && PROBE < 40
        ph_p3<PROBE - 30>(p, l, 2 + l, smem); GRID_SYNC();
#endif
        ph_p4(p, l, bid, nb, smem);
        GRID_SYNC();
#if PROBE == 4
        ph_p4(p, l, bid, nb, smem); GRID_SYNC();
#endif
        ph_router_fast(p, l, bid, nb, smem);
        GRID_SYNC();
#if PROBE == 5
        if (bid == 0 && tidx() < 32) WSP(int, OFF_CTL)[CTL_CNT + tidx() * 32] = 0;
        GRID_SYNC();
        ph_router_fast(p, l, bid, nb, smem); GRID_SYNC();
#endif
        ph_moe_up(p, l, bid, nb, smem);
        GRID_SYNC();
        ph_moe_down(p, l, bid, nb, smem);
        GRID_SYNC();
#if PROBE == 6
        ph_moe_up(p, l, bid, nb, smem); GRID_SYNC(); ph_moe_down(p, l, bid, nb, smem); GRID_SYNC();
#endif
        ph_combine(p, l == 1, bid, nb);
        if (l == 0) GRID_SYNC();
#if PROBE == 7
        if (l == 0) { ph_combine(p, 0, bid, nb); GRID_SYNC(); }
#endif
    }
}

extern "C" void kernel_launch(void* const* d_in, const int* in_sizes, int n_in, void* d_out, int out_size, void* d_ws, size_t ws_size, hipStream_t stream) {
    if (n_in != N_IN || ws_size < WS_TOTAL || out_size != NT * D) { fprintf(stderr, "kernel_launch: bad sizes n_in %d ws %zu (need %zu) out %d\n", n_in, ws_size, (size_t)WS_TOTAL, out_size); return; }
    static int grid_blocks = 0;
    if (!grid_blocks) {
        int dev = 0, cus = 0, per_cu = 0;
        (void)hipGetDevice(&dev);
        (void)hipDeviceGetAttribute(&cus, hipDeviceAttributeMultiprocessorCount, dev);
        (void)hipFuncSetAttribute((const void*)mega_fwd, hipFuncAttributeMaxDynamicSharedMemorySize, SMEM_BYTES);
        (void)hipOccupancyMaxActiveBlocksPerMultiprocessor(&per_cu, (const void*)mega_fwd, 256, SMEM_BYTES);
        if (per_cu < 1) { fprintf(stderr, "kernel_launch: occupancy query says %d blocks per CU\n", per_cu); return; }
        if (per_cu > 2) per_cu = 2;
        grid_blocks = cus * per_cu;
    }
    Params p{};
    for (int i = 0; i < N_IN; ++i) p.in[i] = (const float*)d_in[i];
    p.out = (float*)d_out; p.ws = (unsigned char*)d_ws;
    (void)hipMemsetAsync((unsigned char*)d_ws + OFF_CTL, 0, 65536, stream);
    void* args[] = {&p};
    hipError_t e = hipLaunchCooperativeKernel((const void*)mega_fwd, dim3(grid_blocks), dim3(256), args, SMEM_BYTES, stream);
    if (e != hipSuccess) fprintf(stderr, "cooperative launch failed: %s (grid %d)\n", hipGetErrorString(e), grid_blocks);
}
```

```cpp
#include <hip/hip_runtime.h>
#include <hip/hip_cooperative_groups.h>
namespace cg = cooperative_groups;
#include <cstdio>
#include <cstdint>

#define DI __device__ __forceinline__
#define TPROBE 0
#define TAMP 8
#define TBLK 0
typedef unsigned short bf;

constexpr int NB = 4, S = 4096, D = 1024, NT = NB * S, NPROJ = 2048;
constexpr float EPS = 1e-6f;
enum { I_X = 0, I_N1G, I_WIN, I_CONVW, I_CONVB, I_WA, I_BA, I_WX, I_BX, I_LAM, I_LOUTG, I_DQG, I_DKG, I_LQ1, I_LK1, I_LQ2, I_LK2,
       I_SUBG, I_CQG, I_CKVG, I_WUQ, I_WUKV, I_MQG, I_MKG, I_MOUTG, I_WOUT, I_N2G, I_RGW, I_RGB, I_REW, I_REB, I_W1, I_W3, I_W2, N_IN };

struct Params { const float* in[N_IN]; float* out; unsigned char* ws; };

constexpr size_t AL(size_t x) { return (x + 255) & ~(size_t)255; }
constexpr size_t OFF_WIN = 0;
constexpr size_t OFF_WOUT = OFF_WIN + (size_t)2 * 2048 * 1024 * 2;
constexpr size_t OFF_WUQ = OFF_WOUT + (size_t)2 * 1024 * 1024 * 2;
constexpr size_t OFF_WUKV = OFF_WUQ + (size_t)2 * 768 * 192 * 2;
constexpr size_t OFF_WAX = OFF_WUKV + (size_t)2 * 768 * 128 * 2;
constexpr size_t OFF_WR = OFF_WAX + (size_t)2 * 2 * 4 * 64 * 64 * 2;
constexpr size_t OFF_ROPE = AL(OFF_WR + (size_t)2 * 64 * 1024 * 2);
constexpr size_t OFF_CTL = OFF_ROPE + (size_t)4096 * 32 * 4;
constexpr size_t OFF_RINV1 = OFF_CTL + 65536;
constexpr size_t OFF_RINV2 = OFF_RINV1 + (size_t)NT * 4;
constexpr size_t OFF_SSQ2 = OFF_RINV2 + (size_t)NT * 4;
constexpr size_t OFF_SSQM = OFF_SSQ2 + (size_t)NT * 8 * 4;
constexpr size_t OFF_TOT = OFF_SSQM + (size_t)NT * 8 * 4;
constexpr size_t OFF_GATEW = OFF_TOT + (size_t)4 * 64 * 2 * 256 * 4;
constexpr size_t OFF_LIST = OFF_GATEW + (size_t)NT * 2 * 4;
constexpr size_t OFF_XFA = OFF_LIST + (size_t)32 * 16384 * 4;
constexpr size_t OFF_XB = OFF_XFA + (size_t)NT * D * 4;
constexpr size_t OFF_MIX = OFF_XB + (size_t)NT * D * 2;
constexpr size_t OFF_STAGE = OFF_MIX + (size_t)NT * D * 2;
constexpr size_t OFF_LX = OFF_STAGE;
constexpr size_t OFF_GG = OFF_LX + (size_t)NT * 256 * 2;
constexpr size_t OFF_DQ = OFF_GG + (size_t)NT * 256 * 2;
constexpr size_t OFF_DK = OFF_DQ + (size_t)NT * 384 * 2;
constexpr size_t OFF_DVT = OFF_DK + (size_t)NT * 384 * 2;
constexpr size_t OFF_CQ = OFF_DVT + (size_t)NT * 384 * 2;
constexpr size_t OFF_CKV = OFF_CQ + (size_t)NT * 192 * 2;
constexpr size_t OFF_KR = OFF_CKV + (size_t)NT * 128 * 2;
constexpr size_t OFF_MQ = OFF_KR + (size_t)NT * 32 * 2;
constexpr size_t OFF_MK = OFF_MQ + (size_t)NT * 576 * 2;
constexpr size_t OFF_MVT = OFF_MK + (size_t)NT * 576 * 2;
constexpr size_t OFF_STAGE_END = OFF_MVT + (size_t)NT * 384 * 2;
constexpr size_t OFF_Y = OFF_STAGE;
constexpr size_t OFF_ACT = OFF_Y + (size_t)2 * NT * D * 2;
constexpr size_t OFF_H13 = OFF_Y;
constexpr size_t WS_TOTAL = OFF_STAGE_END;
static_assert(OFF_ACT + (size_t)(32768 + 128) * 256 * 2 <= OFF_STAGE_END, "alias");
constexpr int CTL_CNT = 0;
constexpr int CTL_LAM = 1024 + 4 * 256;
constexpr int CTL_Q = 1024;

#define WSP(T, off) ((T*)(p.ws + (off)))
#define X1PTR(l) ((l) == 0 ? p.out : WSP(float, OFF_XFA))
#define EWPTR(l) ((bf*)((l) == 0 ? (unsigned char*)WSP(float, OFF_XFA) : (unsigned char*)p.out))
constexpr size_t EW_W3 = (size_t)32 * 262144, EW_W2 = (size_t)64 * 262144;

DI int tidx() { int t = threadIdx.x; asm volatile("" : "+v"(t)); return t; }
DI unsigned xcc_id() { return (unsigned)__builtin_amdgcn_s_getreg((3 << 11) | 20) & 0xFu; }
#if TPROBE
#define TSTART(id) do { if ((id) == TPROBE && blockIdx.x == TBLK && threadIdx.x == 0) *(volatile unsigned long long*)(tp_smem + 8) = __builtin_amdgcn_s_memrealtime(); } while (0)
#define TSTOP(id) do { if ((id) == TPROBE && blockIdx.x == TBLK && threadIdx.x == 0) { volatile unsigned long long* q_ = (volatile unsigned long long*)tp_smem; q_[0] = q_[0] + (__builtin_amdgcn_s_memrealtime() - q_[1]); } } while (0)
#else
#define TSTART(id) do {} while (0)
#define TSTOP(id) do {} while (0)
#endif
#define tp_smem (smem + GEMM_SMEM + 32)
DI float bf2f(bf v) { return __uint_as_float(((unsigned)v) << 16); }
DI bf f2bf(float f) { unsigned u = __float_as_uint(f); u += 0x7fffu + ((u >> 16) & 1u); return (bf)(u >> 16); }
typedef __bf16 hwbf16x2 __attribute__((ext_vector_type(2)));
typedef float f32x2 __attribute__((ext_vector_type(2)));
DI unsigned pack2(float a, float b) { f32x2 v = {a, b}; return __builtin_bit_cast(unsigned, __builtin_convertvector(v, hwbf16x2)); }
DI float lo16(unsigned u) { return __uint_as_float(u << 16); }
DI float hi16(unsigned u) { return __uint_as_float(u & 0xffff0000u); }
DI float wave_sum(float v) { for (int o = 32; o > 0; o >>= 1) v += __shfl_xor(v, o); return v; }
DI float wave_max(float v) { for (int o = 32; o > 0; o >>= 1) v = fmaxf(v, __shfl_xor(v, o)); return v; }
DI float gelu_tanh(float x) {
    const float y2 = 1.5957691216057308f * (x + 0.044715f * x * x * x);
    return x - x * __builtin_amdgcn_rcpf(__expf(y2) + 1.f);
}
DI float sigmoidf_(float x) { return 1.f / (1.f + __expf(-x)); }
DI float lambda_init(int l) { return l == 0 ? 0.2f : 0.35550906757f; }
DI void store8(bf* dst, const float* v) { uint4 u; u.x = pack2(v[0], v[1]); u.y = pack2(v[2], v[3]); u.z = pack2(v[4], v[5]); u.w = pack2(v[6], v[7]); *(uint4*)dst = u; }

template <class SCOL, class GAIN>
DI void tr_tile(const float* src, int lds_, bf* dst, int K, int n0, int k0, SCOL scol, GAIN gain, float* tile) {
    const int tid = tidx();
    const int nn = tid & 63;
    const int sc = scol(n0 + nn);
#pragma unroll
    for (int i = 0; i < 16; ++i) {
        const int kk = (tid >> 6) + 4 * i;
        float v = 0.f;
        if (sc >= 0) v = src[(size_t)(k0 + kk) * lds_ + sc] * gain(k0 + kk);
        tile[kk * 65 + nn] = v;
    }
    __syncthreads();
#pragma unroll
    for (int i = 0; i < 2; ++i) {
        const int id = tid + 256 * i, n = id >> 3, kc = (id & 7) * 8;
        float v[8];
#pragma unroll
        for (int j = 0; j < 8; ++j) v[j] = tile[(kc + j) * 65 + n];
        store8(dst + (size_t)(n0 + n) * K + k0 + kc, v);
    }
    __syncthreads();
}

DI int win_col(int n) {
    if (n < 1856) return n;
    if (n < 1888) return 1984 + (n - 1856);
    if (n < 1920) return -1;
    return 1856 + (n - 1920);
}

constexpr int PW_WIN = 2 * 32 * 16;
constexpr int PW_WOUT = 2 * 16 * 16;
constexpr int PW_WUQ = 2 * 12 * 3;
constexpr int PW_WUKV = 2 * 12 * 2;
constexpr int PW_WAX = 2 * 2 * 4;
constexpr int PW_TOTAL = PW_WIN + PW_WOUT + PW_WUQ + PW_WUKV + PW_WAX;

DI void prep_weights_unit(const Params& p, int u, float* tile) {
    if (u < PW_WIN) {
        const int l = u / 512, r = u % 512, nt = r / 16, kt = r % 16;
        const float* g = p.in[I_N1G] + l * 1024;
        tr_tile(p.in[I_WIN] + (size_t)l * 1024 * 2016, 2016, WSP(bf, OFF_WIN) + (size_t)l * 2048 * 1024, 1024, nt * 64, kt * 64,
                [](int n) { return win_col(n); }, [g](int k) { return g[k]; }, tile);
        return;
    }
    u -= PW_WIN;
    if (u < PW_WOUT) {
        const int l = u / 256, r = u % 256, nt = r / 16, kt = r % 16;
        const float* g_lru = p.in[I_LOUTG] + l * 256; const float* g_sub = p.in[I_SUBG] + l * 64; const float* g_mla = p.in[I_MOUTG] + l * 384;
        const float li = 1.f - lambda_init(l);
        tr_tile(p.in[I_WOUT] + (size_t)l * 1024 * 1024, 1024, WSP(bf, OFF_WOUT) + (size_t)l * 1024 * 1024, 1024, nt * 64, kt * 64,
                [](int n) { return n; },
                [=](int k) { return k < 256 ? g_lru[k] : (k < 640 ? g_sub[(k - 256) & 63] * li : g_mla[k - 640]); }, tile);
        return;
    }
    u -= PW_WOUT;
    if (u < PW_WUQ) {
        const int l = u / 36, r = u % 36, nt = r / 3, kt = r % 3;
        const float* g = p.in[I_CQG] + l * 192;
        tr_tile(p.in[I_WUQ] + (size_t)l * 192 * 576, 576, WSP(bf, OFF_WUQ) + (size_t)l * 768 * 192, 192, nt * 64, kt * 64,
                [](int n) { return (n & 127) < 96 ? (n >> 7) * 96 + (n & 127) : -1; }, [g](int k) { return g[k]; }, tile);
        return;
    }
    u -= PW_WUQ;
    if (u < PW_WUKV) {
        const int l = u / 24, r = u % 24, nt = r / 2, kt = r % 2;
        const float* g = p.in[I_CKVG] + l * 128;
        tr_tile(p.in[I_WUKV] + (size_t)l * 128 * 768, 768, WSP(bf, OFF_WUKV) + (size_t)l * 768 * 128, 128, nt * 64, kt * 64,
                [](int n) { return n; }, [g](int k) { return g[k]; }, tile);
        return;
    }
    u -= PW_WUKV;
    {
        const int l = u / 8, which = (u / 4) & 1, blk = u & 3;
        const float* src = (which ? p.in[I_WX] : p.in[I_WA]) + (size_t)(l * 4 + blk) * 4096;
        tr_tile(src, 64, WSP(bf, OFF_WAX) + (size_t)((l * 2 + which) * 4 + blk) * 4096, 64, 0, 0,
                [](int n) { return n; }, [](int) { return 1.f; }, tile);
    }
}

DI void ph_prep_weights(const Params& p, int bid, int nb, unsigned char* smem) {
    float* tile = (float*)smem;
    for (int u = bid; u < PW_TOTAL; u += nb) prep_weights_unit(p, u, tile);
}

DI void ph_prep_misc(const Params& p, int bid, int nb) {
    const int gid = bid * 256 + tidx(), gsz = nb * 256;
    bf* wr = WSP(bf, OFF_WR);
    for (int i = gid; i < 2 * 64 * 1024; i += gsz) {
        const int l = i >> 16, j = (i >> 10) & 63, k = i & 1023;
        float w = 0.f;
        if (j < 4) w = p.in[I_RGW][(size_t)(l * 1024 + k) * 4 + j];
        else if (j < 36) w = p.in[I_REW][(size_t)(l * 1024 + k) * 32 + (j - 4)];
        wr[i] = f2bf(w);
    }
    float* rope = WSP(float, OFF_ROPE);
    for (int i = gid; i < 4096 * 16; i += gsz) {
        const int s = i >> 4, f = i & 15;
        const float inv_freq = (float)exp2(-(double)f / 16.0 * 13.287712379549449);
        const float angf = (float)s * inv_freq;
        double a = (double)angf;
        const double twopi = 6.283185307179586476925;
        a -= twopi * rint(a / twopi);
        const double hh = 0.5 * a, h2 = hh * hh;
        double sn = 1.0, cs = 1.0, ts = 1.0, tc = 1.0;
#pragma unroll
        for (int n = 1; n <= 10; ++n) {
            tc *= -h2 / (double)((2 * n - 1) * (2 * n));
            ts *= -h2 / (double)((2 * n) * (2 * n + 1));
            cs += tc; sn += ts;
        }
        sn *= hh;
        rope[s * 32 + f] = (float)(cs * cs - sn * sn);
        rope[s * 32 + 16 + f] = (float)(2.0 * sn * cs);
    }
    if (gid < 32) WSP(int, OFF_CTL)[CTL_CNT + gid * 32] = 0;
    if (gid < 2) {
        float d1 = 0.f, d2 = 0.f;
        for (int i = 0; i < 32; ++i) { d1 += p.in[I_LQ1][gid * 32 + i] * p.in[I_LK1][gid * 32 + i]; d2 += p.in[I_LQ2][gid * 32 + i] * p.in[I_LK2][gid * 32 + i]; }
        WSP(float, OFF_CTL)[CTL_LAM + gid] = expf(d1) - expf(d2) + lambda_init(gid);
        float gq = 0.f, gk = 0.f;
        for (int i = 0; i < 32; ++i) { gq = fmaxf(gq, fabsf(p.in[I_DQG][gid * 32 + i])); gk = fmaxf(gk, fabsf(p.in[I_DKG][gid * 32 + i])); }
        WSP(float, OFF_CTL)[CTL_LAM + 2 + gid] = 32.f * gq * gk * 0.17677669529663687f * 1.4426950408889634f * 1.02f;
    }
}

DI void ph_prep_x(const Params& p, int bid, int nb) {
    const int lane = tidx() & 63, gw = bid * 4 + (tidx() >> 6), nw = nb * 4;
    const float* x = p.in[I_X];
    bf* xb = WSP(bf, OFF_XB);
    float* rinv = WSP(float, OFF_RINV1);
    for (int t = gw; t < NT; t += nw) {
        float ss = 0.f;
#pragma unroll
        for (int i = 0; i < 2; ++i) {
            const int c = (lane + 64 * i) * 8;
            const float4 a = *(const float4*)(x + (size_t)t * D + c), b = *(const float4*)(x + (size_t)t * D + c + 4);
            float v[8] = {a.x, a.y, a.z, a.w, b.x, b.y, b.z, b.w};
#pragma unroll
            for (int j = 0; j < 8; ++j) ss += v[j] * v[j];
            store8(xb + (size_t)t * D + c, v);
        }
        ss = wave_sum(ss);
        if (lane == 0) rinv[t] = rsqrtf(ss * (1.f / 1024.f) + EPS);
    }
}

template <bool BT, class LA, class LB, class EPI>
DI void ngemm_tile(int K, LA la, LB lb, EPI epi, float* sA, float* sB) {
    const int tid = tidx(), ty = tid >> 4, tx = tid & 15;
    float acc[4][4];
#pragma unroll
    for (int i = 0; i < 4; ++i)
#pragma unroll
        for (int j = 0; j < 4; ++j) acc[i][j] = 0.f;
    for (int k0 = 0; k0 < K; k0 += 16) {
#pragma unroll
        for (int i = 0; i < 4; ++i) {
            const int e = tid + 256 * i;
            sA[(e & 15) * 68 + (e >> 4)] = la(e >> 4, k0 + (e & 15));
            if (BT) sB[(e & 15) * 68 + (e >> 4)] = lb(k0 + (e & 15), e >> 4);
            else sB[(e >> 6) * 68 + (e & 63)] = lb(k0 + (e >> 6), e & 63);
        }
        __syncthreads();
#pragma unroll
        for (int kk = 0; kk < 16; ++kk) {
            const float4 a = *(const float4*)(sA + kk * 68 + ty * 4), b = *(const float4*)(sB + kk * 68 + tx * 4);
            const float av[4] = {a.x, a.y, a.z, a.w}, bv[4] = {b.x, b.y, b.z, b.w};
#pragma unroll
            for (int i = 0; i < 4; ++i)
#pragma unroll
                for (int j = 0; j < 4; ++j) acc[i][j] += av[i] * bv[j];
        }
        __syncthreads();
    }
#pragma unroll
    for (int i = 0; i < 4; ++i)
#pragma unroll
        for (int j = 0; j < 4; ++j) epi(ty * 4 + i, tx * 4 + j, acc[i][j]);
}

DI void ph_p1_gemm_naive(const Params& p, int l, int chunk, int bid, int nb, unsigned char* smem) {
    float* sA = (float*)smem; float* sB = sA + 16 * 68;
    for (int u = bid; u < 2048; u += nb) {
    const int mt = u / 8, nt = u % 8;
    const bf* A = WSP(bf, OFF_XB) + (size_t)mt * 64 * D;
    const bf* Bt = WSP(bf, OFF_WIN) + (size_t)l * 2048 * 1024 + (size_t)(chunk * 512 + nt * 64) * 1024;
    const float* rinv = WSP(float, OFF_RINV1) + mt * 64;
    float* C = WSP(float, OFF_MIX) + (size_t)mt * 64 * 512 + nt * 64;
    ngemm_tile<true>(1024, [=](int r, int k) { return bf2f(A[(size_t)r * D + k]); }, [=](int k, int c) { return bf2f(Bt[(size_t)c * 1024 + k]); },
               [=](int r, int c, float v) { C[(size_t)r * 512 + c] = v * rinv[r]; }, sA, sB);
    }
}

template <class ACC>
DI void route_tile(const Params& p, int l, int mt, int nt, ACC T) {
    const int tid = tidx();
    const int t0 = mt * 128, b = t0 >> 12, s0 = t0 & 4095;
    if (nt < 4) {
        bf* dst = WSP(bf, nt < 2 ? OFF_LX : OFF_GG);
        const int cb = (nt & 1) * 128;
#pragma unroll
        for (int it = 0; it < 8; ++it) {
            const int id = it * 256 + tid, r = id >> 4, c8 = (id & 15) * 8;
            float v[8];
#pragma unroll
            for (int j = 0; j < 8; ++j) { v[j] = T(r, c8 + j); if (nt >= 2) v[j] = gelu_tanh(v[j]); }
            store8(dst + (size_t)(t0 + r) * 256 + cb + c8, v);
        }
    } else if (nt < 10) {
        const bool isk = nt >= 7;
        const int g0 = (nt - (isk ? 7 : 4)) * 128;
        const float* gain = (isk ? p.in[I_DKG] : p.in[I_DQG]) + l * 32;
        bf* dst = WSP(bf, isk ? OFF_DK : OFF_DQ);
        const int c8 = (tid & 15) * 8, col = g0 + c8, h = col >> 6, m = (col >> 5) & 1, d0 = col & 31;
        float gn[8];
#pragma unroll
        for (int j = 0; j < 8; ++j) gn[j] = gain[d0 + j];
        bf* drow = dst + ((size_t)((b * 6 + h) * 2 + m) * S + s0) * 32 + d0;
#pragma unroll
        for (int it = 0; it < 8; ++it) {
            const int r = it * 16 + (tid >> 4);
            float v[8], ss = 0.f;
#pragma unroll
            for (int j = 0; j < 8; ++j) { v[j] = T(r, c8 + j); ss += v[j] * v[j]; }
            ss += __shfl_xor(ss, 1); ss += __shfl_xor(ss, 2);
            const float rn = rsqrtf(ss * (1.f / 32.f) + EPS);
#pragma unroll
            for (int j = 0; j < 8; ++j) v[j] = v[j] * rn * gn[j];
            store8(drow + (size_t)r * 32, v);
        }
    } else if (nt < 13) {
        const int g0 = (nt - 10) * 128;
        bf* dst = WSP(bf, OFF_DVT);
#pragma unroll
        for (int it = 0; it < 8; ++it) {
            const int id = it * 256 + tid, c = id & 127, rc = id >> 7;
            float v[8];
#pragma unroll
            for (int j = 0; j < 8; ++j) v[j] = T(8 * rc + j, c);
            const int col = g0 + c, h = col >> 6, d = col & 63;
            store8(dst + ((size_t)(b * 6 + h) * 64 + d) * S + s0 + 8 * rc, v);
        }
    } else {
        const int c8 = (tid & 15) * 8;
        bf* drow; size_t ld; bool act = true;
        if (nt == 13) { drow = WSP(bf, OFF_CQ) + c8; ld = 192; }
        else if (nt == 15) { drow = WSP(bf, OFF_CKV) + c8; ld = 128; }
        else if (c8 < 64) { drow = WSP(bf, OFF_CQ) + 128 + c8; ld = 192; }
        else { drow = WSP(bf, OFF_KR) + (c8 - 64); ld = 32; act = c8 < 96; }
#pragma unroll
        for (int it = 0; it < 8; ++it) {
            const int r = it * 16 + (tid >> 4);
            float v[8];
#pragma unroll
            for (int j = 0; j < 8; ++j) v[j] = T(r, c8 + j);
            if (act) store8(drow + (size_t)(t0 + r) * ld, v);
        }
    }
}

DI void ph_p1_route_naive(const Params& p, int l, int chunk, int bid, int nb) {
    for (int u = bid; u < 512; u += nb) {
    const int mt = u / 4, ntl = u % 4;
    const float* C = WSP(float, OFF_MIX) + (size_t)mt * 128 * 512 + ntl * 128;
    route_tile(p, l, mt, chunk * 4 + ntl, [=](int r, int c) { return C[(size_t)r * 512 + c]; });
    }
}


typedef short bf16x8 __attribute__((ext_vector_type(8)));
typedef short s16x4 __attribute__((ext_vector_type(4)));
typedef float f32x16 __attribute__((ext_vector_type(16)));
typedef __attribute__((address_space(3))) s16x4 lds_s16x4;
#define MFMA32(a, b, c) __builtin_amdgcn_mfma_f32_32x32x16_bf16((a), (b), (c), 0, 0, 0)
constexpr int G_A_BYTES = 16384, G_B_BYTES = 20480;
constexpr int G_OFF_B = 2 * G_A_BYTES;
constexpr int G_LOOP_BYTES = 2 * G_A_BYTES + 2 * G_B_BYTES;
constexpr int G_OFF_AUX = G_LOOP_BYTES;
constexpr int GEMM_SMEM = G_LOOP_BYTES + 3072;

DI unsigned cvt_pk_bf16(float a, float b) { return pack2(a, b); }

struct RowLoader {
    const bf* base; size_t ld;
    DI uint4 load(int i, int kt) const { return *(const uint4*)(base + (size_t)(32 * i) * ld + kt * 64); }
};
struct GatherLoader {
    const bf* rp[4];
    DI uint4 load(int i, int kt) const { return rp[i] ? *(const uint4*)(rp[i] + kt * 64) : make_uint4(0, 0, 0, 0); }
};
struct TrLoader {
    const float* base; size_t ldn;
    DI float4 load(int i, int kt) const { return *(const float4*)(base + (size_t)(kt * 64 + 8 * i) * ldn); }
};
struct TrLoaderBf {
    const bf* base; size_t ldn;
    DI uint4 load(int i, int kt) const { return *(const uint4*)(base + (size_t)(kt * 64 + 16 * i) * ldn); }
};

template <int BMODE, class AL, class BL>
DI void g_issue(uint4 (&ra)[4], uint4 (&rb0)[4], float4 (&rb1)[8], const AL& al, const BL& bl, int kt) {
#pragma unroll
    for (int i = 0; i < 4; ++i) ra[i] = al.load(i, kt);
    if constexpr (BMODE == 0 || BMODE == 2) {
#pragma unroll
        for (int i = 0; i < 4; ++i) rb0[i] = bl.load(i, kt);
    } else {
#pragma unroll
        for (int i = 0; i < 8; ++i) rb1[i] = bl.load(i, kt);
    }
}
template <int BMODE>
DI void g_commit(const uint4 (&ra)[4], const uint4 (&rb0)[4], const float4 (&rb1)[8], unsigned char* dA, unsigned char* dB, int a_wr, int b_wr1) {
#pragma unroll
    for (int i = 0; i < 4; ++i) *(uint4*)(dA + a_wr + i * 4096) = ra[i];
    if constexpr (BMODE == 0) {
#pragma unroll
        for (int i = 0; i < 4; ++i) *(uint4*)(dB + a_wr + i * 4096) = rb0[i];
    } else if constexpr (BMODE == 2) {
        const int b_wr2 = (tidx() >> 4) * 320 + (tidx() & 15) * 16;
#pragma unroll
        for (int i = 0; i < 4; ++i) *(uint4*)(dB + b_wr2 + i * 5120) = rb0[i];
    } else {
#pragma unroll
        for (int i = 0; i < 8; ++i) *(uint2*)(dB + b_wr1 + i * 2560) = make_uint2(cvt_pk_bf16(rb1[i].x, rb1[i].y), cvt_pk_bf16(rb1[i].z, rb1[i].w));
    }
}
template <int BMODE, int GPV = 0>
DI void g_compute(f32x16 (&acc)[2][2], const unsigned char* sA, const unsigned char* sB, int a_rd, int b_rd0, int b_rd1, int h, int sw) {
    if (GPV == 14) { a_rd = 0; b_rd0 = 0; sw = 0; h = 0; }
#pragma unroll
    for (int ks = 0; ks < 4; ++ks) {
        const int co = ((2 * ks + h) ^ sw) << 4;
        bf16x8 a[2], b[2];
#pragma unroll
        for (int mi = 0; mi < 2; ++mi) a[mi] = *(const bf16x8*)(sA + a_rd + mi * 4096 + co);
        if constexpr (BMODE == 0) {
#pragma unroll
            for (int ni = 0; ni < 2; ++ni) b[ni] = *(const bf16x8*)(sB + b_rd0 + ni * 4096 + co);
        } else {
#pragma unroll
            for (int ni = 0; ni < 2; ++ni) {
                const s16x4 lo = __builtin_amdgcn_ds_read_tr16_b64_v4i16((lds_s16x4*)(sB + b_rd1 + ks * 5120 + ni * 64));
                const s16x4 hi = __builtin_amdgcn_ds_read_tr16_b64_v4i16((lds_s16x4*)(sB + b_rd1 + ks * 5120 + 1280 + ni * 64));
                b[ni] = __builtin_shufflevector(lo, hi, 0, 1, 2, 3, 4, 5, 6, 7);
            }
        }
        if (GPV == 16) { asm volatile("" :: "v"(a[0]), "v"(a[1]), "v"(b[0]), "v"(b[1])); continue; }
#pragma unroll
        for (int mi = 0; mi < 2; ++mi)
#pragma unroll
            for (int ni = 0; ni < 2; ++ni) acc[mi][ni] = MFMA32(a[mi], b[ni], acc[mi][ni]);
    }
}
#define GREGS uint4 raA[4], rbA[4], raB[4], rbB[4]; float4 rfA[8], rfB[8]
#define GREGS_P raA, rbA, rfA, raB, rbB, rfB
#define GREGS_T uint4 (&raA)[4], uint4 (&rbA)[4], float4 (&rfA)[8], uint4 (&raB)[4], uint4 (&rbB)[4], float4 (&rfB)[8]
template <int BMODE, class AL, class BL>
DI void g_prefetch(GREGS_T, const AL& al, const BL& bl, int nk) {
    g_issue<BMODE>(raA, rbA, rfA, al, bl, 0);
    __builtin_amdgcn_sched_barrier(0);
    g_issue<BMODE>(raB, rbB, rfB, al, bl, min(1, nk - 1));
    __builtin_amdgcn_sched_barrier(0);
}
struct NoMid { DI void operator()(f32x16 (&)[2][2], int) const {} };
template <int BMODE, class AL, class BL, class MID, int GPV = 0>
DI void gemm_run(f32x16 (&acc)[2][2], int nk, const AL& al, const BL& bl, unsigned char* smem, GREGS_T, const MID& mid) {
    const int tid = tidx(), lane = tid & 63, wv = tid >> 6, wr = wv >> 1, wc = wv & 1;
    const int r31 = lane & 31, h = lane >> 5, sw = (r31 >> 1) & 7;
    const int a_wr = (tid >> 3) * 128 + (((tid & 7) ^ ((tid >> 4) & 7)) << 4);
    const int b_wr1 = (tid >> 5) * 320 + (tid & 31) * 8;
    const int a_rd = (wr * 64 + r31) * 128, b_rd0 = (wc * 64 + r31) * 128;
    const int b_rd1 = (8 * h + ((lane & 15) >> 2)) * 320 + (wc * 64 + 16 * ((lane >> 4) & 1) + 4 * (lane & 3)) * 2;
    unsigned char* const sA0 = smem; unsigned char* const sA1 = smem + G_A_BYTES;
    unsigned char* const sB0 = smem + G_OFF_B; unsigned char* const sB1 = smem + G_OFF_B + G_B_BYTES;
    g_commit<BMODE>(raA, rbA, rfA, sA0, sB0, a_wr, b_wr1);
    __syncthreads();
#pragma unroll 1
    for (int kt = 0; kt < nk; kt += 2) {
        g_issue<BMODE>(raA, rbA, rfA, al, bl, min(kt + 2, nk - 1));
        __builtin_amdgcn_sched_barrier(0);
        g_compute<BMODE, GPV>(acc, sA0, sB0, a_rd, b_rd0, b_rd1, h, sw);
        mid(acc, kt);
        if (GPV != 15) g_commit<BMODE>(raB, rbB, rfB, sA1, sB1, a_wr, b_wr1);
        __syncthreads();
        if (kt + 1 >= nk) break;
        g_issue<BMODE>(raB, rbB, rfB, al, bl, min(kt + 3, nk - 1));
        __builtin_amdgcn_sched_barrier(0);
        g_compute<BMODE, GPV>(acc, sA1, sB1, a_rd, b_rd0, b_rd1, h, sw);
        mid(acc, kt + 1);
        if (GPV != 15) g_commit<BMODE>(raA, rbA, rfA, sA0, sB0, a_wr, b_wr1);
        __syncthreads();
    }
}

DI void acc_zero(f32x16 (&acc)[2][2]) {
#pragma unroll
    for (int mi = 0; mi < 2; ++mi)
#pragma unroll
        for (int ni = 0; ni < 2; ++ni)
#pragma unroll
            for (int r = 0; r < 16; ++r) acc[mi][ni][r] = 0.f;
}
DI void acc_stage(const f32x16 (&acc)[2][2], float* sC) {
    const int lane = tidx() & 63, wv = tidx() >> 6, wr = wv >> 1, wc = wv & 1, r31 = lane & 31, h = lane >> 5;
#pragma unroll
    for (int mi = 0; mi < 2; ++mi)
#pragma unroll
        for (int ni = 0; ni < 2; ++ni)
#pragma unroll
            for (int r = 0; r < 16; ++r)
                sC[(wr * 64 + mi * 32 + (r & 3) + 8 * (r >> 2) + 4 * h) * 128 + wc * 64 + ni * 32 + r31] = acc[mi][ni][r];
    __syncthreads();
}

template <int GPV>
DI void ph_p1(const Params& p, int l, int bid, int nb, unsigned char* smem) {
    const int tid = tidx();
    const bf* XB = WSP(bf, OFF_XB) + (size_t)(tid >> 3) * 1024 + (tid & 7) * 8;
    const bf* W = WSP(bf, OFF_WIN) + (size_t)l * 2048 * 1024 + (size_t)(tid >> 3) * 1024 + (tid & 7) * 8;
    const float* rinv = WSP(float, OFF_RINV1);
    float* sC = (float*)smem; float* sRV = (float*)(smem + G_OFF_AUX);
    if (bid >= 2048) return;
    GREGS;
#define P1_NT(u) ((((u) & 15) + 5 * ((u) >> 9)) & 15)
    RowLoader al{XB + (size_t)((bid >> 4) * 128) * 1024, 1024}, bl{W + (size_t)(P1_NT(bid) * 128) * 1024, 1024};
    float rvn = rinv[(bid >> 4) * 128 + (tid & 127)];
    g_prefetch<0>(GREGS_P, al, bl, 16);
    for (int u = bid; u < 2048; u += nb) {
        const int mt = u >> 4, nt = P1_NT(u);
        if (tid < 128) sRV[tid] = rvn;
        f32x16 acc[2][2];
        acc_zero(acc);
        TSTART(1);
        gemm_run<0, RowLoader, RowLoader, NoMid, GPV>(acc, 16, al, bl, smem, GREGS_P, NoMid());
        TSTOP(1);
        TSTART(2);
        if (GPV == 0) acc_stage(acc, sC); else asm volatile("" :: "v"(acc[0][0]), "v"(acc[0][1]), "v"(acc[1][0]), "v"(acc[1][1]));
        const int un = u + nb < 2048 ? u + nb : u;
        al.base = XB + (size_t)((un >> 4) * 128) * 1024; bl.base = W + (size_t)(P1_NT(un) * 128) * 1024;
        rvn = rinv[(un >> 4) * 128 + (tid & 127)];
        g_prefetch<0>(GREGS_P, al, bl, 16);
        if (GPV == 0) route_tile(p, l, mt, nt, [=](int r, int c) { return sC[r * 128 + c] * sRV[r]; });
        __syncthreads();
        TSTOP(2);
    }
}

struct RowLoaderRot {
    const bf* base; size_t ld;
    DI uint4 load(int i, int kt) const { return *(const uint4*)(base + (size_t)(32 * i) * ld + ((kt + 10) & 15) * 64); }
};
struct MlaScale {
    const float* sRN; int rowbase;
    DI void operator()(f32x16 (&acc)[2][2], int kt) const {
        if (kt != 5) return;
#pragma unroll
        for (int mi = 0; mi < 2; ++mi)
#pragma unroll
            for (int r = 0; r < 16; ++r) {
                const float sc = sRN[rowbase + mi * 32 + (r & 3) + 8 * (r >> 2)];
                acc[mi][0][r] *= sc; acc[mi][1][r] *= sc;
            }
    }
};
DI void ph_p4(const Params& p, int l, int bid, int nb, unsigned char* smem) {
    const int tid = tidx(), lane = tid & 63, wv = tid >> 6, wr = wv >> 1, h = lane >> 5;
    if (bid == 0 && tid < 32) WSP(int, OFF_CTL)[CTL_CNT + tid * 32] = 0;
    const bf* MIX = WSP(bf, OFF_MIX) + (size_t)(tid >> 3) * 1024 + (tid & 7) * 8;
    const bf* W = WSP(bf, OFF_WOUT) + (size_t)l * 1024 * 1024 + (size_t)(tid >> 3) * 1024 + (tid & 7) * 8;
    const float* xin = l == 0 ? p.in[I_X] : WSP(float, OFF_XFA);
    float* x1p = X1PTR(l);
    const float* g2 = p.in[I_N2G] + l * 1024;
    bf* xb1 = WSP(bf, OFF_XB);
    float* sC = (float*)smem; float* sRN = (float*)(smem + G_OFF_AUX);
    if (bid >= 1024) return;
    GREGS;
    RowLoaderRot al{MIX + (size_t)((bid >> 3) * 128) * 1024, 1024}, bl{W + (size_t)((bid & 7) * 128) * 1024, 1024};
    float4 sqa; float2 sqb;
    { const float* sq = WSP(float, OFF_SSQM) + (size_t)((bid >> 3) * 128 + (tid & 127)) * 8; sqa = *(const float4*)sq; sqb = *(const float2*)(sq + 4); }
    g_prefetch<0>(GREGS_P, al, bl, 16);
    for (int u = bid; u < 1024; u += nb) {
        const int mt = u >> 3, nt = u & 7;
        if (tid < 128) sRN[tid] = rsqrtf((sqa.x + sqa.y + sqa.z + sqa.w + sqb.x + sqb.y) * (1.f / 384.f) + EPS);
        f32x16 acc[2][2];
        acc_zero(acc);
        gemm_run<0>(acc, 16, al, bl, smem, GREGS_P, MlaScale{sRN, wr * 64 + 4 * h});
        acc_stage(acc, sC);
        const int un = u + nb < 1024 ? u + nb : u;
        al.base = MIX + (size_t)((un >> 3) * 128) * 1024; bl.base = W + (size_t)((un & 7) * 128) * 1024;
        { const float* sq = WSP(float, OFF_SSQM) + (size_t)((un >> 3) * 128 + (tid & 127)) * 8; sqa = *(const float4*)sq; sqb = *(const float2*)(sq + 4); }
        g_prefetch<0>(GREGS_P, al, bl, 16);
        const float4 ga = *(const float4*)(g2 + nt * 128 + (tid & 15) * 8), gb = *(const float4*)(g2 + nt * 128 + (tid & 15) * 8 + 4);
#pragma unroll 4
        for (int it = 0; it < 8; ++it) {
            const int id = it * 256 + tid, r = id >> 4, c8 = (id & 15) * 8;
            const size_t o = (size_t)(mt * 128 + r) * 1024 + nt * 128 + c8;
            const float4 x0 = *(const float4*)(xin + o), x1 = *(const float4*)(xin + o + 4);
            const float4 c0 = *(const float4*)(sC + r * 128 + c8), c1 = *(const float4*)(sC + r * 128 + c8 + 4);
            float v[8] = {x0.x + c0.x, x0.y + c0.y, x0.z + c0.z, x0.w + c0.w, x1.x + c1.x, x1.y + c1.y, x1.z + c1.z, x1.w + c1.w};
            *(float4*)(x1p + o) = make_float4(v[0], v[1], v[2], v[3]);
            *(float4*)(x1p + o + 4) = make_float4(v[4], v[5], v[6], v[7]);
            float ss = 0.f;
#pragma unroll
            for (int j = 0; j < 8; ++j) ss += v[j] * v[j];
            ss += __shfl_xor(ss, 1); ss += __shfl_xor(ss, 2); ss += __shfl_xor(ss, 4); ss += __shfl_xor(ss, 8);
            if ((id & 15) == 0) WSP(float, OFF_SSQ2)[(size_t)(mt * 128 + r) * 8 + nt] = ss;
            const float gg[8] = {ga.x, ga.y, ga.z, ga.w, gb.x, gb.y, gb.z, gb.w};
#pragma unroll
            for (int j = 0; j < 8; ++j) v[j] *= gg[j];
            store8(xb1 + o, v);
        }
        __syncthreads();
    }
}

DI void ph_router_fast(const Params& p, int l, int bid, int nb, unsigned char* smem) {
    const int tid = tidx(), lane = tid & 63, w = tid >> 6, r31 = lane & 31, h = lane >> 5;
    const bf* WR = WSP(bf, OFF_WR) + (size_t)l * 64 * 1024;
    const bf* XB = WSP(bf, OFF_XB);
    float* sP = (float*)smem;
    int* cnt = WSP(int, OFF_CTL) + CTL_CNT;
    int* list = WSP(int, OFF_LIST);
    float* gatew = WSP(float, OFF_GATEW);
    for (int u = bid; u < NT / 32; u += nb) {
        const int t0 = u * 32;
        f32x16 acc[2];
#pragma unroll
        for (int mi = 0; mi < 2; ++mi)
#pragma unroll
            for (int r = 0; r < 16; ++r) acc[mi][r] = 0.f;
        const bf* xa = XB + (size_t)(t0 + r31) * 1024 + w * 256 + 8 * h;
        const bf* wa = WR + (size_t)r31 * 1024 + w * 256 + 8 * h;
#pragma unroll 4
        for (int ks = 0; ks < 16; ++ks) {
            const bf16x8 xb = *(const bf16x8*)(xa + 16 * ks);
            const bf16x8 a0 = *(const bf16x8*)(wa + 16 * ks), a1 = *(const bf16x8*)(wa + 32 * 1024 + 16 * ks);
            acc[0] = MFMA32(a0, xb, acc[0]);
            acc[1] = MFMA32(a1, xb, acc[1]);
        }
#pragma unroll
        for (int mi = 0; mi < 2; ++mi)
#pragma unroll
            for (int r = 0; r < 16; ++r) sP[(w * 64 + mi * 32 + (r & 3) + 8 * (r >> 2) + 4 * h) * 33 + r31] = acc[mi][r];
        __syncthreads();
        if (tid < 32) {
            const int t = t0 + tid;
            const float* sq = WSP(float, OFF_SSQ2) + (size_t)t * 8;
            const float rinv = rsqrtf((sq[0] + sq[1] + sq[2] + sq[3] + sq[4] + sq[5] + sq[6] + sq[7]) * (1.f / 1024.f) + EPS);
            float lg[4];
#pragma unroll
            for (int j = 0; j < 4; ++j) lg[j] = (sP[j * 33 + tid] + sP[(64 + j) * 33 + tid] + sP[(128 + j) * 33 + tid] + sP[(192 + j) * 33 + tid]) * rinv + p.in[I_RGB][l * 4 + j];
            int g = 0; float gm = lg[0];
#pragma unroll
            for (int j = 1; j < 4; ++j) if (lg[j] > gm) { gm = lg[j]; g = j; }
            float gs = 0.f;
#pragma unroll
            for (int j = 0; j < 4; ++j) gs += __expf(lg[j] - gm);
            const float pg_top = 1.f / gs;
            float e[8];
#pragma unroll
            for (int j = 0; j < 8; ++j) {
                const int jj = 4 + g * 8 + j;
                e[j] = (sP[jj * 33 + tid] + sP[(64 + jj) * 33 + tid] + sP[(128 + jj) * 33 + tid] + sP[(192 + jj) * 33 + tid]) * rinv + p.in[I_REB][l * 32 + g * 8 + j];
            }
            int i1 = 0; float v1 = e[0];
#pragma unroll
            for (int i = 1; i < 8; ++i) if (e[i] > v1) { v1 = e[i]; i1 = i; }
            int i2 = -1; float v2 = -INFINITY;
#pragma unroll
            for (int i = 0; i < 8; ++i) if (i != i1 && e[i] > v2) { v2 = e[i]; i2 = i; }
            const float p2 = __expf(v2 - v1);
            const float g1 = pg_top / (1.f + p2), g2 = pg_top * p2 / (1.f + p2);
            const int e1 = g * 8 + i1, e2 = g * 8 + i2;
            int* sCnt = (int*)(smem + 40960); int* sBase = sCnt + 32;
            sCnt[tid] = 0;
            const int rk1 = atomicAdd(&sCnt[e1], 1);
            const int rk2 = atomicAdd(&sCnt[e2], 1);
            const int mine = sCnt[tid];
            if (mine > 0) sBase[tid] = atomicAdd(&cnt[tid * 32], mine);
            list[e1 * 16384 + sBase[e1] + rk1] = t * 2;
            list[e2 * 16384 + sBase[e2] + rk2] = t * 2 + 1;
            gatew[t * 2] = g1; gatew[t * 2 + 1] = g2;
            WSP(float, OFF_RINV2)[t] = rinv;
        }
        __syncthreads();
    }
}

DI void moe_sched_init(const Params& p, int* aux) {
    if (tidx() == 0) {
        const int* cnt = WSP(int, OFF_CTL) + CTL_CNT;
        int rb = 0, base = 0;
        for (int e = 0; e < 32; ++e) { const int c = cnt[e * 32]; aux[e] = c; aux[32 + e] = rb; aux[65 + e] = base; rb += (c + 127) >> 7; base += c; }
        aux[64] = rb; aux[97] = base;
    }
    __syncthreads();
}
struct MoeUnit { int e, base; };
DI MoeUnit moe_unit(const Params& p, const int* aux, int rbg, int* sEnt, int which) {
    int e = 0;
    while (aux[33 + e] <= rbg) ++e;
    const int rb = rbg - aux[32 + e];
    const int n = aux[e] - rb * 128;
    if (tidx() < 128) {
        const int en = (int)tidx() < n ? WSP(int, OFF_LIST)[e * 16384 + rb * 128 + tidx()] : -1;
        sEnt[tidx()] = en;
        ((float*)sEnt)[128 + tidx()] = en >= 0 ? (which ? WSP(float, OFF_GATEW)[en] : WSP(float, OFF_RINV2)[en >> 1]) : 0.f;
    }
    __syncthreads();
    MoeUnit mu; mu.e = e; mu.base = aux[65 + e] + rb * 128;
    return mu;
}
DI GatherLoader moe_up_aload(const Params& p, const int* sEnt) {
    const int tid = tidx();
    GatherLoader al;
#pragma unroll
    for (int i = 0; i < 4; ++i) { const int en = sEnt[(tid >> 3) + 32 * i]; al.rp[i] = en >= 0 ? WSP(bf, OFF_XB) + (size_t)(en >> 1) * 1024 + (tid & 7) * 8 : nullptr; }
    return al;
}
DI TrLoaderBf moe_up_bload(const Params& p, int l, int e, int q) {
    const int tid = tidx(), n8 = tid & 15;
    return TrLoaderBf{EWPTR(l) + (n8 < 8 ? 0 : EW_W3) + (size_t)e * 262144 + (size_t)(tid >> 4) * 256 + q * 64 + (n8 & 7) * 8, 256};
}

DI void ph_moe_up(const Params& p, int l, int bid, int nb, unsigned char* smem) {
    const int tid = tidx();
    int* aux = (int*)(smem + G_OFF_AUX); int* sEnt0 = aux + 128;
    float* sC = (float*)smem;
    moe_sched_init(p, aux);
    const int units = aux[64] * 4;
    bf* ACT = WSP(bf, OFF_ACT);
    if (bid >= units) return;
    GREGS;
    int par = 0;
    MoeUnit mu = moe_unit(p, aux, bid >> 2, sEnt0, 0);
    GatherLoader al = moe_up_aload(p, sEnt0);
    TrLoaderBf bl = moe_up_bload(p, l, mu.e, bid & 3);
    g_prefetch<2>(GREGS_P, al, bl, 16);
    for (int u = bid; u < units; u += nb) {
        const int q = u & 3;
        const int* sEnt = sEnt0 + par * 256;
        f32x16 acc[2][2];
        acc_zero(acc);
        gemm_run<2>(acc, 16, al, bl, smem, GREGS_P, NoMid());
        acc_stage(acc, sC);
        const int un = u + nb < units ? u + nb : u;
        int* sEntN = sEnt0 + (par ^ 1) * 256;
        const MoeUnit mun = moe_unit(p, aux, un >> 2, sEntN, 0);
        al = moe_up_aload(p, sEntN); bl = moe_up_bload(p, l, mun.e, un & 3);
        g_prefetch<2>(GREGS_P, al, bl, 16);
#pragma unroll 2
        for (int it = 0; it < 4; ++it) {
            const int id = it * 256 + tid, r = id >> 3, c8 = (id & 7) * 8;
            const int en = sEnt[r];
            if (en >= 0) {
                const float rs = ((const float*)sEnt)[128 + r];
                float v[8];
#pragma unroll
                for (int j = 0; j < 8; ++j) { const float a = sC[r * 128 + c8 + j] * rs, b = sC[r * 128 + 64 + c8 + j] * rs; v[j] = a * sigmoidf_(a) * b; }
                store8(ACT + (size_t)(mu.base + r) * 256 + q * 64 + c8, v);
            }
        }
        __syncthreads();
        mu = mun; par ^= 1;
    }
}

DI void ph_moe_down(const Params& p, int l, int bid, int nb, unsigned char* smem) {
    const int tid = tidx();
    int* aux = (int*)(smem + G_OFF_AUX); int* sEnt0 = aux + 128;
    float* sC = (float*)smem;
    moe_sched_init(p, aux);
    const int units = aux[64] * 8;
    const bf* ACT = WSP(bf, OFF_ACT) + (size_t)(tid >> 3) * 256 + (tid & 7) * 8;
    const bf* W2 = EWPTR(l) + EW_W2 + (size_t)(tid >> 4) * 1024 + (tid & 15) * 8;
    bf* Y = WSP(bf, OFF_Y);
    if (bid >= units) return;
    GREGS;
    int par = 0;
    MoeUnit mu = moe_unit(p, aux, bid >> 3, sEnt0, 1);
    RowLoader al{ACT + (size_t)mu.base * 256, 256};
    TrLoaderBf bl{W2 + (size_t)mu.e * 262144 + (bid & 7) * 128, 1024};
    g_prefetch<2>(GREGS_P, al, bl, 4);
    for (int u = bid; u < units; u += nb) {
        const int nt = u & 7;
        const int* sEnt = sEnt0 + par * 256;
        f32x16 acc[2][2];
        acc_zero(acc);
        gemm_run<2>(acc, 4, al, bl, smem, GREGS_P, NoMid());
        acc_stage(acc, sC);
        const int un = u + nb < units ? u + nb : u;
        const MoeUnit mun = moe_unit(p, aux, un >> 3, sEnt0 + (par ^ 1) * 256, 1);
        al.base = ACT + (size_t)mun.base * 256; bl.base = W2 + (size_t)mun.e * 262144 + (un & 7) * 128;
        g_prefetch<2>(GREGS_P, al, bl, 4);
#pragma unroll 2
        for (int it = 0; it < 8; ++it) {
            const int id = it * 256 + tid, r = id >> 4, c8 = (id & 15) * 8;
            const int en = sEnt[r];
            if (en >= 0) {
                const float gw = ((const float*)sEnt)[128 + r];
                float v[8];
#pragma unroll
                for (int j = 0; j < 8; ++j) v[j] = sC[r * 128 + c8 + j] * gw;
                store8(Y + ((size_t)(en & 1) * NT + (en >> 1)) * 1024 + nt * 128 + c8, v);
            }
        }
        __syncthreads();
        mu = mun; par ^= 1;
    }
}

template <bool ISQ>
DI void mla_up_rms(const Params& p, int t0, float* sRN) {
    constexpr int KD = ISQ ? 192 : 128, NCH = KD / 16;
    const int tid = tidx(), r = tid >> 1, half = tid & 1;
    const uint4* src = (const uint4*)((ISQ ? WSP(bf, OFF_CQ) : WSP(bf, OFF_CKV)) + (size_t)(t0 + r) * KD + half * (KD / 2));
    uint4 v[NCH];
#pragma unroll
    for (int i = 0; i < NCH; ++i) v[i] = src[i];
    float ss = 0.f;
#pragma unroll
    for (int i = 0; i < NCH; ++i) { const unsigned w[4] = {v[i].x, v[i].y, v[i].z, v[i].w};
#pragma unroll
        for (int e = 0; e < 4; ++e) { const float a = lo16(w[e]), c = hi16(w[e]); ss += a * a + c * c; } }
    ss += __shfl_xor(ss, 1);
    if (!half) sRN[r] = rsqrtf(ss * (1.f / (float)KD) + EPS);
}
template <bool ISQ>
DI void mla_up_epi(const Params& p, int l, int mt, int hd, const float* sC, const float* sRN) {
    const int tid = tidx();
    const int t0 = mt * 128, b = t0 >> 12, s0 = t0 & 4095;
    const float* gain = (ISQ ? p.in[I_MQG] : p.in[I_MKG]) + l * 96;
    const int c8 = (tid & 15) * 8, rb = tid >> 4;
    const bool act = c8 < 96, rot = act && c8 >= 64, first = c8 < 80;
    const int pc = first ? c8 + 16 : c8 - 16;
    float gown[8], gpar[8];
#pragma unroll
    for (int jj = 0; jj < 8; ++jj) { gown[jj] = act ? gain[c8 + jj] : 0.f; gpar[jj] = rot ? gain[pc + jj] : 0.f; }
    const bf* KR = WSP(bf, OFF_KR);
    const float* ropet = WSP(float, OFF_ROPE);
    bf* dst = WSP(bf, ISQ ? OFF_MQ : OFF_MK) + ((size_t)(b * 6 + hd) * S + s0) * 96 + c8;
#pragma unroll 1
    for (int it = 0; it < 8; ++it) {
        const int r = it * 16 + rb, t = t0 + r;
        const float rl = sRN[r];
        float v[8], w[8];
#pragma unroll
        for (int jj = 0; jj < 8; ++jj) { v[jj] = 0.f; w[jj] = 0.f; }
        if (act && (ISQ || c8 < 64)) {
            const float4 a0 = *(const float4*)(sC + r * 128 + c8), a1 = *(const float4*)(sC + r * 128 + c8 + 4);
            v[0] = a0.x * rl; v[1] = a0.y * rl; v[2] = a0.z * rl; v[3] = a0.w * rl; v[4] = a1.x * rl; v[5] = a1.y * rl; v[6] = a1.z * rl; v[7] = a1.w * rl;
            if (rot) {
                const float4 b0 = *(const float4*)(sC + r * 128 + pc), b1 = *(const float4*)(sC + r * 128 + pc + 4);
                w[0] = b0.x * rl; w[1] = b0.y * rl; w[2] = b0.z * rl; w[3] = b0.w * rl; w[4] = b1.x * rl; w[5] = b1.y * rl; w[6] = b1.z * rl; w[7] = b1.w * rl;
            }
        } else if (rot) {
            const uint4 ko = *(const uint4*)(KR + (size_t)t * 32 + (c8 - 64)), kp = *(const uint4*)(KR + (size_t)t * 32 + (pc - 64));
            v[0] = lo16(ko.x); v[1] = hi16(ko.x); v[2] = lo16(ko.y); v[3] = hi16(ko.y); v[4] = lo16(ko.z); v[5] = hi16(ko.z); v[6] = lo16(ko.w); v[7] = hi16(ko.w);
            w[0] = lo16(kp.x); w[1] = hi16(kp.x); w[2] = lo16(kp.y); w[3] = hi16(kp.y); w[4] = lo16(kp.z); w[5] = hi16(kp.z); w[6] = lo16(kp.w); w[7] = hi16(kp.w);
        }
        float ss = 0.f;
#pragma unroll
        for (int jj = 0; jj < 8; ++jj) ss += v[jj] * v[jj];
        ss += __shfl_xor(ss, 1); ss += __shfl_xor(ss, 2); ss += __shfl_xor(ss, 4); ss += __shfl_xor(ss, 8);
        const float rn = rsqrtf(ss * (1.f / 96.f) + EPS);
        if (act) {
            float o[8];
            if (!rot) {
#pragma unroll
                for (int jj = 0; jj < 8; ++jj) o[jj] = v[jj] * rn * gown[jj];
            } else {
                const float* rp_ = ropet + (size_t)(s0 + r) * 32 + (c8 & 15);
                const float4 c0 = *(const float4*)(rp_), c1 = *(const float4*)(rp_ + 4), n0 = *(const float4*)(rp_ + 16), n1 = *(const float4*)(rp_ + 20);
                const float cs[8] = {c0.x, c0.y, c0.z, c0.w, c1.x, c1.y, c1.z, c1.w}, sn[8] = {n0.x, n0.y, n0.z, n0.w, n1.x, n1.y, n1.z, n1.w};
#pragma unroll
                for (int jj = 0; jj < 8; ++jj) {
                    const float mine = v[jj] * rn * gown[jj], other = w[jj] * rn * gpar[jj];
                    o[jj] = first ? mine * cs[jj] - other * sn[jj] : other * sn[jj] + mine * cs[jj];
                }
            }
            store8(dst + (size_t)r * 96, o);
        }
    }
    if (!ISQ) {
        bf* mvt = WSP(bf, OFF_MVT);
#pragma unroll 2
        for (int it = 0; it < 4; ++it) {
            const int id = it * 256 + tid, c = id & 63, rc = id >> 6;
            float v[8];
#pragma unroll
            for (int jj = 0; jj < 8; ++jj) v[jj] = sC[(8 * rc + jj) * 128 + 64 + c] * sRN[8 * rc + jj];
            store8(mvt + ((size_t)(b * 6 + hd) * 64 + c) * S + s0 + 8 * rc, v);
        }
    }
}
DI void mla_up_loaders(const Params& p, int l, int u, RowLoader& al, RowLoader& bl) {
    const int tid = tidx(), mt = u / 12, j = u % 12;
    if (j < 6) {
        al = RowLoader{WSP(bf, OFF_CQ) + (size_t)(mt * 128 + (tid >> 3)) * 192 + (tid & 7) * 8, 192};
        bl = RowLoader{WSP(bf, OFF_WUQ) + (size_t)l * 768 * 192 + (size_t)(j * 128 + (tid >> 3)) * 192 + (tid & 7) * 8, 192};
    } else {
        al = RowLoader{WSP(bf, OFF_CKV) + (size_t)(mt * 128 + (tid >> 3)) * 128 + (tid & 7) * 8, 128};
        bl = RowLoader{WSP(bf, OFF_WUKV) + (size_t)l * 768 * 128 + (size_t)((j - 6) * 128 + (tid >> 3)) * 128 + (tid & 7) * 8, 128};
    }
}
DI void lru_tile_fast(const Params& p, int l, int b, int tile, int mode, unsigned char* smem) {
    const int tid = tidx(), c = tid, lane = tid & 63, n = tid >> 6, r31 = lane & 31, h = lane >> 5;
    unsigned char* sXC = smem; float* sA = (float*)(smem + 16384); bf* sG = (bf*)(smem + 49152);
    const bf* LX = WSP(bf, OFF_LX); const bf* GGp = WSP(bf, OFF_GG);
    const float cw0 = p.in[I_CONVW][(l * 4 + 0) * 256 + c], cw1 = p.in[I_CONVW][(l * 4 + 1) * 256 + c], cw2 = p.in[I_CONVW][(l * 4 + 2) * 256 + c],
                cw3 = p.in[I_CONVW][(l * 4 + 3) * 256 + c], cb = p.in[I_CONVB][l * 256 + c];
    float gba[2], gbx[2], gc8[2];
#pragma unroll
    for (int ni = 0; ni < 2; ++ni) {
        const int ch = 64 * n + 32 * ni + r31;
        gba[ni] = p.in[I_BA][l * 256 + ch]; gbx[ni] = p.in[I_BX][l * 256 + ch];
        gc8[ni] = 8.f * log1pf(__expf(-p.in[I_LAM][l * 256 + ch]));
    }
    bf16x8 wb[2][2][4];
#pragma unroll
    for (int g = 0; g < 2; ++g)
#pragma unroll
        for (int ni = 0; ni < 2; ++ni)
#pragma unroll
            for (int ks = 0; ks < 4; ++ks)
                wb[g][ni][ks] = *(const bf16x8*)(WSP(bf, OFF_WAX) + (size_t)(((l * 2 + g) * 4 + n) * 64 + 32 * ni + r31) * 64 + 16 * ks + 8 * h);
    const int tb = b * S + tile * 64;
    float xm3 = 0.f, xm2 = 0.f, xm1 = 0.f;
    if (tile > 0) { xm3 = bf2f(LX[(size_t)(tb - 3) * 256 + c]); xm2 = bf2f(LX[(size_t)(tb - 2) * 256 + c]); xm1 = bf2f(LX[(size_t)(tb - 1) * 256 + c]); }
    float hs = 0.f, aprod = 1.f;
    if (mode == 1) {
        const float* TOT = WSP(float, OFF_TOT) + (size_t)(b * 64) * 512;
#pragma unroll 8
        for (int i = 0; i < tile; ++i) hs = TOT[i * 512 + c] * hs + TOT[i * 512 + 256 + c];
    }
    const int xoff = (c & 7) * 2, xch = (c & 63) >> 3;
#pragma unroll 1
    for (int half = 0; half < 2; ++half) {
        const int t0 = tb + half * 32;
        float xc[32];
#pragma unroll
        for (int t = 0; t < 32; ++t) {
            const float x0 = bf2f(LX[(size_t)(t0 + t) * 256 + c]);
            xc[t] = cw0 * xm3 + cw1 * xm2 + cw2 * xm1 + cw3 * x0 + cb;
            xm3 = xm2; xm2 = xm1; xm1 = x0;
            *(bf*)(sXC + (n * 32 + t) * 128 + ((xch ^ ((t >> 1) & 7)) << 4) + xoff) = f2bf(xc[t]);
        }
        __syncthreads();
        f32x16 acc[2][2];
#pragma unroll
        for (int g = 0; g < 2; ++g)
#pragma unroll
            for (int ni = 0; ni < 2; ++ni)
#pragma unroll
                for (int r = 0; r < 16; ++r) acc[g][ni][r] = 0.f;
#pragma unroll
        for (int ks = 0; ks < 4; ++ks) {
            const bf16x8 a = *(const bf16x8*)(sXC + (n * 32 + r31) * 128 + (((2 * ks + h) ^ ((r31 >> 1) & 7)) << 4));
#pragma unroll
            for (int g = 0; g < 2; ++g)
#pragma unroll
                for (int ni = 0; ni < 2; ++ni) acc[g][ni] = MFMA32(a, wb[g][ni][ks], acc[g][ni]);
        }
#pragma unroll
        for (int ni = 0; ni < 2; ++ni)
#pragma unroll
            for (int r = 0; r < 16; ++r) {
                const int t = (r & 3) + 8 * (r >> 2) + 4 * h, ch = 64 * n + 32 * ni + r31;
                const float rg = sigmoidf_(acc[0][ni][r] + gba[ni]), ig = sigmoidf_(acc[1][ni][r] + gbx[ni]);
                const float la = -gc8[ni] * rg, y = 2.f * la;
                const float av = __expf(la);
                const float em = y > -0.3f ? y * (1.f + y * (0.5f + y * (0.16666667f + y * 0.041666668f))) : av * av - 1.f;
                sA[t * 256 + ch] = av;
                sG[t * 256 + ch] = f2bf(sqrtf(fmaxf(-em, 0.f)) * ig);
            }
        __syncthreads();
#pragma unroll
        for (int t = 0; t < 32; ++t) {
            const float a = sA[t * 256 + c];
            hs = a * hs + bf2f(sG[t * 256 + c]) * xc[t];
            aprod *= a;
            if (mode == 1) sA[t * 256 + c] = hs * bf2f(GGp[(size_t)(t0 + t) * 256 + c]);
        }
        __syncthreads();
        if (mode == 1) {
            bf* MIX = WSP(bf, OFF_MIX);
#pragma unroll 1
            for (int q = 0; q < 8; ++q) {
                const int t = n * 8 + q;
                const float4 y = *(const float4*)(sA + t * 256 + 4 * lane);
                const float rn = rsqrtf(wave_sum(y.x * y.x + y.y * y.y + y.z * y.z + y.w * y.w) * (1.f / 256.f) + EPS);
                uint2 pk; pk.x = pack2(y.x * rn, y.y * rn); pk.y = pack2(y.z * rn, y.w * rn);
                *(uint2*)(MIX + (size_t)(t0 + t) * 1024 + 4 * lane) = pk;
            }
            __syncthreads();
        }
    }
    if (mode == 0) {
        float* TOT = WSP(float, OFF_TOT) + (size_t)(b * 64 + tile) * 512;
        TOT[c] = aprod; TOT[256 + c] = hs;
    }
}

DI void ph_lru(const Params& p, int l, int mode, int bid, int nb, unsigned char* smem) {
    float* sXC = (float*)smem; float* sY = sXC + 16 * 256;
    for (int u = bid; u < 256; u += nb) lru_tile_fast(p, l, u >> 6, u & 63, mode, smem);
}


DI int pi_row(int r) { return (r & 0x13) | ((r & 4) << 1) | ((r & 8) >> 1); }
DI float fexp2(float x) { return __builtin_amdgcn_exp2f(x); }


template <int KD>
DI void att_issue(uint4& k0r, uint4& k1r, uint4& k2r, uint4& v0r, uint4& v1r, const bf* Kg, const bf* Vg, int j) {
    const int tid = tidx(), k0 = j * 64;
    const bf* src = Kg + (size_t)k0 * KD + tid * 8;
    k0r = *(const uint4*)(src);
    if (KD == 96) { k1r = *(const uint4*)(src + 2048); k2r = *(const uint4*)(src + 4096); }
    const bf* vs = Vg + (size_t)(tid >> 3) * S + k0 + (tid & 7) * 8;
    v0r = *(const uint4*)(vs); v1r = *(const uint4*)(vs + (size_t)32 * S);
}
template <int KD>
DI void att_commit(const uint4& k0r, const uint4& k1r, const uint4& k2r, const uint4& v0r, const uint4& v1r, unsigned char* base) {
    constexpr int KRS = KD == 96 ? 208 : 80, KOFF_V = 64 * KRS;
    const int tid = tidx();
    if (KD == 96) {
        const int i0 = tid, i1 = tid + 256, i2 = tid + 512;
        *(uint4*)(base + (i0 / 12) * 208 + (i0 % 12) * 16) = k0r;
        *(uint4*)(base + (i1 / 12) * 208 + (i1 % 12) * 16) = k1r;
        *(uint4*)(base + (i2 / 12) * 208 + (i2 % 12) * 16) = k2r;
    } else {
        *(uint4*)(base + (tid >> 2) * 80 + (tid & 3) * 16) = k0r;
    }
    const int d = tid >> 3, ch = tid & 7;
    const int voff = KOFF_V + d * 128 + ((ch ^ ((d >> 1) & 7)) << 4);
    *(uint4*)(base + voff) = v0r;
    *(uint4*)(base + voff + 4096) = v1r;
}

template <int KD, bool BIAS, int VAR>
DI void attn_tile(const unsigned char* base, bool diag, float T, float slc, const bf16x8 (&qf)[KD / 16], f32x16 (&O)[2], float& mrun, float& lrun,
                  int krow, int vsw, int w, int r31, int h) {
    constexpr int KRS = KD == 96 ? 208 : 80, KOFF_V = 64 * KRS, NKS = KD / 16;
    constexpr float C = (KD == 96 ? 0.10206207261596575f : 0.17677669529663687f) * 1.4426950408889634f;
    f32x16 sc[2];
    bf16x8 kf[2][NKS];
#pragma unroll
    for (int kb2 = 0; kb2 < 2; ++kb2) {
#pragma unroll
        for (int r = 0; r < 16; ++r) sc[kb2][r] = 0.f;
#pragma unroll
        for (int ks = 0; ks < NKS; ++ks) kf[kb2][ks] = *(const bf16x8*)(base + kb2 * 32 * KRS + krow + ks * 32);
    }
    __builtin_amdgcn_sched_barrier(0);
    if (VAR != 4) {
#pragma unroll
    for (int ks = 0; ks < NKS; ++ks)
#pragma unroll
        for (int kb2 = 0; kb2 < 2; ++kb2) sc[kb2] = MFMA32(kf[kb2][ks], qf[ks], sc[kb2]);
    } else { asm volatile("" :: "v"(kf[0][0]), "v"(kf[1][NKS - 1])); }
    bf16x8 vf[2][4];
#pragma unroll
    for (int db = 0; db < 2; ++db)
#pragma unroll
        for (int s4 = 0; s4 < 4; ++s4) vf[db][s4] = *(const bf16x8*)(base + KOFF_V + (32 * db + r31) * 128 + (((2 * s4 + h) ^ vsw) << 4));
    __builtin_amdgcn_sched_barrier(0);
    if (BIAS) {
        const int ql2 = diag ? 2 * ((w & 1) * 32 + r31) : 4096;
#pragma unroll
        for (int kb2 = 0; kb2 < 2; ++kb2)
#pragma unroll
            for (int r = 0; r < 16; ++r) {
                const int kl = 32 * kb2 + 16 * (r >> 3) + 8 * h + (r & 7);
                sc[kb2][r] = fmaf(slc, (float)min(kl, ql2 - kl), sc[kb2][r]);
            }
    }
    float mx = sc[0][0];
    if (VAR != 1) {
#pragma unroll
    for (int kb2 = 0; kb2 < 2; ++kb2)
#pragma unroll
        for (int r = 0; r < 16; ++r) mx = fmaxf(mx, sc[kb2][r]);
    mx = fmaxf(mx, __shfl_xor(mx, 32));
    }
    const float mnew = VAR == 1 ? mrun : fmaxf(mrun, mx * C + T);
    const float alpha = VAR == 1 ? 1.f : fexp2(mrun - mnew), off = T - mnew;
    float ls = 0.f;
    bf16x8 pf[4];
#pragma unroll
    for (int kb2 = 0; kb2 < 2; ++kb2)
#pragma unroll
        for (int s2 = 0; s2 < 2; ++s2) {
            float pv[8];
#pragma unroll
            for (int jj = 0; jj < 8; ++jj) { pv[jj] = VAR == 1 ? sc[kb2][8 * s2 + jj] : fexp2(fmaf(sc[kb2][8 * s2 + jj], C, off)); ls += pv[jj]; }
            uint4 pk; pk.x = pack2(pv[0], pv[1]); pk.y = pack2(pv[2], pv[3]); pk.z = pack2(pv[4], pv[5]); pk.w = pack2(pv[6], pv[7]);
            pf[2 * kb2 + s2] = __builtin_bit_cast(bf16x8, pk);
        }
    mrun = mnew; lrun = lrun * alpha + ls;
#pragma unroll
    for (int db = 0; db < 2; ++db)
#pragma unroll
        for (int r = 0; r < 16; ++r) O[db][r] *= alpha;
    if (VAR != 4) {
#pragma unroll
    for (int s4 = 0; s4 < 4; ++s4)
#pragma unroll
        for (int db = 0; db < 2; ++db) O[db] = MFMA32(vf[db][s4], pf[s4], O[db]);
    } else { asm volatile("" :: "v"(vf[0][0]), "v"(vf[1][3]), "v"(pf[0]), "v"(pf[3])); }
}

template <int KD, bool BIAS, int VAR>
DI void attn_pass(const bf* Kg, const bf* Vg, const bf* qrow, float sl2, int qb, int jstart, unsigned char* smem, f32x16 (&O)[2], float& lsum) {
    constexpr int KRS = KD == 96 ? 208 : 80, KOFF_V = 64 * KRS, BUF = KOFF_V + 8192, NKS = KD / 16;
    constexpr float C = (KD == 96 ? 0.10206207261596575f : 0.17677669529663687f) * 1.4426950408889634f;
    const int tid = tidx(), lane = tid & 63, w = tid >> 6, r31 = lane & 31, h = lane >> 5;
    const int mychunk = 2 * qb + (w >> 1), nt = 2 * qb + 2;
    bf16x8 qf[NKS];
#pragma unroll
    for (int ks = 0; ks < NKS; ++ks) qf[ks] = *(const bf16x8*)(qrow + 16 * ks);
    float mrun = -1e30f, lrun = 0.f;
#pragma unroll
    for (int db = 0; db < 2; ++db)
#pragma unroll
        for (int r = 0; r < 16; ++r) O[db][r] = 0.f;
    uint4 ak0, ak1, ak2, av0, av1, bk0, bk1, bk2, bv0, bv1;
    ak1 = make_uint4(0, 0, 0, 0); ak2 = ak1; bk1 = ak1; bk2 = ak1;
    att_issue<KD>(ak0, ak1, ak2, av0, av1, Kg, Vg, jstart);
    att_issue<KD>(bk0, bk1, bk2, bv0, bv1, Kg, Vg, jstart + 1);
    att_commit<KD>(ak0, ak1, ak2, av0, av1, smem);
    __syncthreads();
    const int krow = pi_row(r31) * KRS + h * 16;
    const int vsw = (r31 >> 1) & 7;
    const float slc = sl2 * (1.f / C);
#pragma unroll 1
    for (int j = jstart; j < nt; j += 2) {
        if (VAR != 2 && VAR != 3) att_issue<KD>(ak0, ak1, ak2, av0, av1, Kg, Vg, min(j + 2, nt - 1));
        if (j <= mychunk) attn_tile<KD, BIAS, VAR>(smem, j == mychunk, BIAS ? -sl2 * 64.f * (float)(mychunk - j) : 0.f, slc, qf, O, mrun, lrun, krow, vsw, w, r31, h);
        if (VAR != 3) att_commit<KD>(bk0, bk1, bk2, bv0, bv1, smem + BUF);
        __syncthreads();
        if (VAR != 2 && VAR != 3) att_issue<KD>(bk0, bk1, bk2, bv0, bv1, Kg, Vg, min(j + 3, nt - 1));
        if (j + 1 <= mychunk) attn_tile<KD, BIAS, VAR>(smem + BUF, j + 1 == mychunk, BIAS ? -sl2 * 64.f * (float)(mychunk - j - 1) : 0.f, slc, qf, O, mrun, lrun, krow, vsw, w, r31, h);
        if (VAR != 3) att_commit<KD>(ak0, ak1, ak2, av0, av1, smem);
        __syncthreads();
    }
    lsum = lrun + __shfl_xor(lrun, 32);
}

DI void attn_store(const f32x16 (&o)[2], float osc, unsigned char* stg, bf* dst  ) {
    const int lane = tidx() & 63, r31 = lane & 31, h = lane >> 5;
#pragma unroll
    for (int db = 0; db < 2; ++db)
#pragma unroll
        for (int g = 0; g < 4; ++g) {
            uint2 pk; pk.x = pack2(o[db][4 * g] * osc, o[db][4 * g + 1] * osc); pk.y = pack2(o[db][4 * g + 2] * osc, o[db][4 * g + 3] * osc);
            *(uint2*)(stg + r31 * 144 + (32 * db + 8 * g + 4 * h) * 2) = pk;
        }
#pragma unroll
    for (int i = 0; i < 4; ++i) {
        const int id = lane + 64 * i, row = id >> 3, ch = id & 7;
        *(uint4*)(dst + (size_t)row * 1024 + ch * 8) = *(const uint4*)(stg + row * 144 + ch * 16);
    }
}
constexpr int ATT_STG = 2 * (64 * 208 + 8192);

template <int VAR>
DI void mla_unit(const Params& p, int l, int bh, int qb, unsigned char* smem) {
    const int lane = tidx() & 63, w = tidx() >> 6, r31 = lane & 31, h = lane >> 5;
    const int b = bh / 6, hd = bh % 6, q = qb * 128 + 32 * w + r31;
    f32x16 O[2]; float lsum;
    attn_pass<96, false, VAR>(WSP(bf, OFF_MK) + (size_t)bh * S * 96, WSP(bf, OFF_MVT) + (size_t)bh * 64 * S,
                         WSP(bf, OFF_MQ) + ((size_t)bh * S + q) * 96 + 8 * h, 0.f, qb, 0, smem, O, lsum);
    const float inv = 1.f / lsum;
    float ss = 0.f;
#pragma unroll
    for (int db = 0; db < 2; ++db)
#pragma unroll
        for (int r = 0; r < 16; ++r) { O[db][r] *= inv; ss += O[db][r] * O[db][r]; }
    ss += __shfl_xor(ss, 32);
    const int trow = b * S + qb * 128 + 32 * w;
    if (VAR == 0 && h == 0) WSP(float, OFF_SSQM)[(size_t)(trow + r31) * 8 + hd] = ss;
    attn_store(O, 1.f, smem + ATT_STG + w * (32 * 144), WSP(bf, VAR == 0 ? OFF_MIX : OFF_XB) + (size_t)trow * 1024 + 640 + hd * 64);
}

template <int VAR>
DI void diff_unit(const Params& p, int l, int bh, int qb, unsigned char* smem) {
    const int lane = tidx() & 63, w = tidx() >> 6, r31 = lane & 31, h = lane >> 5;
    const int b = bh / 6, hd = bh % 6, q = qb * 128 + 32 * w + r31;
    const float sl2 = exp2f(-8.f * (float)(hd + 1) / 6.f) * 1.4426950408889634f;
    const bf* Vg = WSP(bf, OFF_DVT) + (size_t)bh * 64 * S;
    const float smax2 = WSP(float, OFF_CTL)[CTL_LAM + 2 + l];
    const int ncut = (int)((160.f + 2.f * smax2) / (sl2 * 64.f)) + 2;
    const int jstart = max(0, 2 * qb - ncut) & ~1;
    f32x16 O1[2]; float l1;
    unsigned o0p[16];
    {
        float l0;
        attn_pass<32, true, VAR>(WSP(bf, OFF_DK) + (size_t)(bh * 2) * S * 32, Vg, WSP(bf, OFF_DQ) + ((size_t)(bh * 2) * S + q) * 32 + 8 * h, sl2, qb, jstart, smem, O1, l0);
        const float inv = 1.f / l0;
#pragma unroll
        for (int db = 0; db < 2; ++db)
#pragma unroll
            for (int r = 0; r < 8; ++r) o0p[db * 8 + r] = pack2(O1[db][2 * r] * inv, O1[db][2 * r + 1] * inv);
    }
    attn_pass<32, true, VAR>(WSP(bf, OFF_DK) + (size_t)(bh * 2 + 1) * S * 32, Vg, WSP(bf, OFF_DQ) + ((size_t)(bh * 2 + 1) * S + q) * 32 + 8 * h, sl2, qb, jstart, smem, O1, l1);
    const float lam1 = WSP(float, OFF_CTL)[CTL_LAM + l] / l1;
    float ss = 0.f;
#pragma unroll
    for (int db = 0; db < 2; ++db)
#pragma unroll
        for (int r = 0; r < 8; ++r) {
            const float v0 = lo16(o0p[db * 8 + r]) - lam1 * O1[db][2 * r], v1 = hi16(o0p[db * 8 + r]) - lam1 * O1[db][2 * r + 1];
            O1[db][2 * r] = v0; O1[db][2 * r + 1] = v1; ss += v0 * v0 + v1 * v1;
        }
    ss += __shfl_xor(ss, 32);
    const int trow = b * S + qb * 128 + 32 * w;
    attn_store(O1, rsqrtf(ss * (1.f / 64.f) + EPS), smem + ATT_STG + w * (32 * 144), WSP(bf, VAR == 0 ? OFF_MIX : OFF_XB) + (size_t)trow * 1024 + 256 + hd * 64);
}

DI int q_next(int* head, int* sU) {
    if (tidx() == 0) *sU = atomicAdd(head, 1);
    __syncthreads();
    const int u = *sU;
    __syncthreads();
    return u;
}
DI void ph_p2(const Params& p, int l, unsigned char* smem) {
    int* head = WSP(int, OFF_CTL) + CTL_Q + 5 * 256 + l * 32;
    int* sU = (int*)(smem + GEMM_SMEM + 16);
    float* sC = (float*)smem; float* sRN0 = (float*)(smem + G_OFF_AUX);
    constexpr int NLRU = 256, UNITS = NLRU + 128 * 12;
    int u = q_next(head, sU);
    while (u < NLRU) { lru_tile_fast(p, l, u >> 6, u & 63, 0, smem); u = q_next(head, sU); }
    if (u >= UNITS) return;
    GREGS;
    RowLoader al, bl;
    { const int m = u - NLRU;
      mla_up_loaders(p, l, m, al, bl);
      if (m % 12 < 6) mla_up_rms<true>(p, (m / 12) * 128, sRN0); else mla_up_rms<false>(p, (m / 12) * 128, sRN0);
      g_prefetch<0>(GREGS_P, al, bl, m % 12 < 6 ? 3 : 2); }
    int par = 0;
    for (;;) {
        const int m = u - NLRU, mt = m / 12, j = m % 12;
        const float* sRN = sRN0 + par * 128;
        f32x16 acc[2][2];
        acc_zero(acc);
        gemm_run<0>(acc, j < 6 ? 3 : 2, al, bl, smem, GREGS_P, NoMid());
        acc_stage(acc, sC);
        const int un = q_next(head, sU);
        const int mn = (un < UNITS ? un : u) - NLRU;
        mla_up_loaders(p, l, mn, al, bl);
        if (mn % 12 < 6) mla_up_rms<true>(p, (mn / 12) * 128, sRN0 + (par ^ 1) * 128); else mla_up_rms<false>(p, (mn / 12) * 128, sRN0 + (par ^ 1) * 128);
        g_prefetch<0>(GREGS_P, al, bl, mn % 12 < 6 ? 3 : 2);
        if (j < 6) mla_up_epi<true>(p, l, mt, j, sC, sRN); else mla_up_epi<false>(p, l, mt, j - 6, sC, sRN);
        __syncthreads();
        if (un >= UNITS) break;
        u = un; par ^= 1;
    }
}

constexpr int P3_NCONV = 384;
constexpr int P3_QLEN = 192 + 32 + P3_NCONV;
template <int VAR>
DI void ph_p3(const Params& p, int l, int qslot, unsigned char* smem) {
    int* qheads = WSP(int, OFF_CTL) + CTL_Q + qslot * 256;
    int* sU = (int*)(smem + GEMM_SMEM + 16);
    float* sXC = (float*)smem; float* sY = sXC + 16 * 256;
    const int x0 = (int)(xcc_id() & 7u);
    int qi = 0;
    for (;;) {
        const int x = (x0 + qi) & 7;
        if (tidx() == 0) *sU = atomicAdd(qheads + x * 32, 1);
        __syncthreads();
        const int u = *sU;
        __syncthreads();
        if (u >= P3_QLEN) { if (++qi == 8) break; continue; }
        if (u >= 224) {
            if (VAR == 0) {
                const size_t e0 = ((size_t)(x * P3_NCONV + (u - 224))) * 8192 + (size_t)tidx() * 8;
                const int m = (int)(e0 >> 23);
                const float* src = (m == 0 ? p.in[I_W1] : (m == 1 ? p.in[I_W3] : p.in[I_W2])) + (size_t)l * 8388608 + (e0 & 8388607);
                bf* dst = EWPTR(l) + e0;
                float4 v[8];
#pragma unroll
                for (int i = 0; i < 4; ++i) { v[2 * i] = *(const float4*)(src + i * 2048); v[2 * i + 1] = *(const float4*)(src + i * 2048 + 4); }
#pragma unroll
                for (int i = 0; i < 4; ++i) {
                    const float f[8] = {v[2 * i].x, v[2 * i].y, v[2 * i].z, v[2 * i].w, v[2 * i + 1].x, v[2 * i + 1].y, v[2 * i + 1].z, v[2 * i + 1].w};
                    store8(dst + i * 2048, f);
                }
            }
        } else if (u < 96 || u >= 128) {
            const int a = u < 96 ? u : u - 32;
            const int qb = 31 - a / 6, c = a % 6, bh = x + 8 * (c % 3);
            if (c < 3) diff_unit<VAR>(p, l, bh, qb, smem);
            else mla_unit<VAR>(p, l, bh, qb, smem);
        } else {
            const int v = x * 32 + (u - 96);
            if (VAR == 0) lru_tile_fast(p, l, v >> 6, v & 63, 1, smem);
        }
    }
}

DI void ph_mla_up_naive(const Params& p, int l, int bid, int nb, unsigned char* smem) {
    float (*sCQ)[192] = (float (*)[192])smem; float (*sCKV)[128] = (float (*)[128])(smem + 4 * 192 * 4);
    float (*sQ)[576] = (float (*)[576])(smem + 4 * 320 * 4); float (*sKV)[768] = (float (*)[768])(smem + 4 * 896 * 4);
    const int tid = tidx(), lane = tid & 63, wv = tid >> 6;
    for (int u = bid; u < NT / 4; u += nb) {
    const int t0 = u * 4;
    {
        const int t = t0 + wv;
        const bf* cq = WSP(bf, OFF_CQ) + (size_t)t * 192; const bf* ckv = WSP(bf, OFF_CKV) + (size_t)t * 128;
        float a0 = bf2f(cq[lane]), a1 = bf2f(cq[lane + 64]), a2 = bf2f(cq[lane + 128]);
        float ss = wave_sum(a0 * a0 + a1 * a1 + a2 * a2);
        float rn = rsqrtf(ss * (1.f / 192.f) + EPS);
        sCQ[wv][lane] = a0 * rn; sCQ[wv][lane + 64] = a1 * rn; sCQ[wv][lane + 128] = a2 * rn;
        float b0 = bf2f(ckv[lane]), b1 = bf2f(ckv[lane + 64]);
        ss = wave_sum(b0 * b0 + b1 * b1);
        rn = rsqrtf(ss * (1.f / 128.f) + EPS);
        sCKV[wv][lane] = b0 * rn; sCKV[wv][lane + 64] = b1 * rn;
    }
    __syncthreads();
    const bf* WUQ = WSP(bf, OFF_WUQ) + (size_t)l * 768 * 192;
    const bf* WUKV = WSP(bf, OFF_WUKV) + (size_t)l * 768 * 128;
    for (int n = tid; n < 576; n += 256) {
        float acc[4] = {0.f, 0.f, 0.f, 0.f};
        for (int k = 0; k < 192; ++k) { const float w = bf2f(WUQ[(size_t)((n / 96) * 128 + n % 96) * 192 + k]);
#pragma unroll
            for (int q = 0; q < 4; ++q) acc[q] += sCQ[q][k] * w; }
#pragma unroll
        for (int q = 0; q < 4; ++q) sQ[q][n] = acc[q];
    }
    for (int n = tid; n < 768; n += 256) {
        float acc[4] = {0.f, 0.f, 0.f, 0.f};
        for (int k = 0; k < 128; ++k) { const float w = bf2f(WUKV[(size_t)n * 128 + k]);
#pragma unroll
            for (int q = 0; q < 4; ++q) acc[q] += sCKV[q][k] * w; }
#pragma unroll
        for (int q = 0; q < 4; ++q) sKV[q][n] = acc[q];
    }
    __syncthreads();
    if (tid < 48) {
        const int tok = tid / 12, h = (tid % 12) >> 1, which = tid & 1;
        const int t = t0 + tok, b = t >> 12, s = t & 4095;
        const float* rope = WSP(float, OFF_ROPE) + s * 32;
        const float* gain = (which ? p.in[I_MKG] : p.in[I_MQG]) + l * 96;
        const bf* kr = WSP(bf, OFF_KR) + (size_t)t * 32;
        bf* dst = WSP(bf, which ? OFF_MK : OFF_MQ) + ((size_t)(b * 6 + h) * S + s) * 96;
        float ss = 0.f;
        for (int d = 0; d < 96; ++d) {
            const float v = which ? (d < 64 ? sKV[tok][h * 128 + d] : bf2f(kr[d - 64])) : sQ[tok][h * 96 + d];
            ss += v * v;
        }
        const float rn = rsqrtf(ss * (1.f / 96.f) + EPS);
        for (int d = 0; d < 64; ++d) {
            const float v = which ? sKV[tok][h * 128 + d] : sQ[tok][h * 96 + d];
            dst[d] = f2bf(v * rn * gain[d]);
        }
        for (int i = 0; i < 16; ++i) {
            const float x1 = (which ? bf2f(kr[i]) : sQ[tok][h * 96 + 64 + i]) * rn * gain[64 + i];
            const float x2 = (which ? bf2f(kr[16 + i]) : sQ[tok][h * 96 + 80 + i]) * rn * gain[80 + i];
            const float cs = rope[i], sn = rope[16 + i];
            dst[64 + i] = f2bf(x1 * cs - x2 * sn);
            dst[80 + i] = f2bf(x1 * sn + x2 * cs);
        }
    }
    bf* mvt = WSP(bf, OFF_MVT);
    for (int e = tid; e < 4 * 384; e += 256) {
        const int tok = e / 384, r = e % 384, h = r >> 6, d = r & 63;
        const int t = t0 + tok, b = t >> 12, s = t & 4095;
        mvt[((size_t)(b * 6 + h) * 64 + d) * S + s] = f2bf(sKV[tok][h * 128 + 64 + d]);
    }
    __syncthreads();
    }
}

DI float rdlane(float v, int j) { return __int_as_float(__builtin_amdgcn_readlane(__float_as_int(v), j)); }

DI void ph_diff_attn_naive(const Params& p, int l, int bid, int nb) {
    for (int u = bid; u < NB * 6 * S / 4; u += nb) {
    const int lane = tidx() & 63, gw = u * 4 + (tidx() >> 6);
    const int q = gw & 4095, bh = gw >> 12, h = bh % 6, b = bh / 6;
    const bf* DQ = WSP(bf, OFF_DQ); const bf* DK = WSP(bf, OFF_DK); const bf* DVT = WSP(bf, OFF_DVT);
    float lam;
    {
        float d1 = 0.f, d2 = 0.f;
        for (int i = 0; i < 32; ++i) { d1 += p.in[I_LQ1][l * 32 + i] * p.in[I_LK1][l * 32 + i]; d2 += p.in[I_LQ2][l * 32 + i] * p.in[I_LK2][l * 32 + i]; }
        lam = expf(d1) - expf(d2) + lambda_init(l);
    }
    const float slope = exp2f(-8.f * (float)(h + 1) / 6.f);
    const float scale = 0.17677669529663687f;
    float q0[32], q1[32];
    {
        const bf* a = DQ + ((size_t)(bh * 2 + 0) * S + q) * 32; const bf* c = DQ + ((size_t)(bh * 2 + 1) * S + q) * 32;
#pragma unroll
        for (int d = 0; d < 32; ++d) { q0[d] = bf2f(a[d]); q1[d] = bf2f(c[d]); }
    }
    float m0 = -INFINITY, m1 = -INFINITY, l0 = 0.f, l1 = 0.f, o0 = 0.f, o1 = 0.f;
    const int nkb = (q >> 6) + 1;
    for (int kb = 0; kb < nkb; ++kb) {
        const int k = kb * 64 + lane;
        const uint4* ka = (const uint4*)(DK + ((size_t)(bh * 2 + 0) * S + k) * 32);
        const uint4* kc = (const uint4*)(DK + ((size_t)(bh * 2 + 1) * S + k) * 32);
        float s0 = 0.f, s1 = 0.f;
#pragma unroll
        for (int i = 0; i < 4; ++i) {
            const uint4 u = ka[i], w = kc[i];
            const unsigned uu[4] = {u.x, u.y, u.z, u.w}, ww[4] = {w.x, w.y, w.z, w.w};
#pragma unroll
            for (int e = 0; e < 4; ++e) {
                s0 += q0[i * 8 + e * 2] * lo16(uu[e]) + q0[i * 8 + e * 2 + 1] * hi16(uu[e]);
                s1 += q1[i * 8 + e * 2] * lo16(ww[e]) + q1[i * 8 + e * 2 + 1] * hi16(ww[e]);
            }
        }
        const float bias = -slope * fabsf((float)(q - k));
        s0 = s0 * scale + bias; s1 = s1 * scale + bias;
        const float n0 = fmaxf(m0, wave_max(s0)), n1 = fmaxf(m1, wave_max(s1));
        const float a0 = __expf(m0 - n0), a1 = __expf(m1 - n1);
        const float p0 = __expf(s0 - n0), p1 = __expf(s1 - n1);
        l0 = l0 * a0 + p0; l1 = l1 * a1 + p1; o0 *= a0; o1 *= a1; m0 = n0; m1 = n1;
        const uint4* vp = (const uint4*)(DVT + ((size_t)bh * 64 + lane) * S + kb * 64);
        uint4 v[8];
#pragma unroll
        for (int i = 0; i < 8; ++i) v[i] = vp[i];
#pragma unroll
        for (int i = 0; i < 8; ++i) {
            const unsigned vv[4] = {v[i].x, v[i].y, v[i].z, v[i].w};
#pragma unroll
            for (int e = 0; e < 4; ++e) {
                const int j = i * 8 + e * 2;
                const float va = lo16(vv[e]), vb = hi16(vv[e]);
                o0 += rdlane(p0, j) * va + rdlane(p0, j + 1) * vb;
                o1 += rdlane(p1, j) * va + rdlane(p1, j + 1) * vb;
            }
        }
    }
    const float L0 = wave_sum(l0), L1 = wave_sum(l1);
    const float o = o0 / L0 - lam * (o1 / L1);
    const float ss = wave_sum(o * o);
    WSP(bf, OFF_MIX)[(size_t)(b * S + q) * 1024 + 256 + h * 64 + lane] = f2bf(o * rsqrtf(ss * (1.f / 64.f) + EPS));
    }
}

DI void ph_mla_attn_naive(const Params& p, int l, int bid, int nb) {
    for (int u = bid; u < NB * 6 * S / 4; u += nb) {
    const int lane = tidx() & 63, gw = u * 4 + (tidx() >> 6);
    const int q = gw & 4095, bh = gw >> 12, h = bh % 6, b = bh / 6;
    const bf* MQ = WSP(bf, OFF_MQ); const bf* MK = WSP(bf, OFF_MK); const bf* MVT = WSP(bf, OFF_MVT);
    const float scale = 0.10206207261596575f;
    float qv[96];
    {
        const bf* a = MQ + ((size_t)bh * S + q) * 96;
#pragma unroll
        for (int d = 0; d < 96; ++d) qv[d] = bf2f(a[d]);
    }
    float m0 = -INFINITY, l0 = 0.f, o0 = 0.f;
    const int nkb = (q >> 6) + 1;
    for (int kb = 0; kb < nkb; ++kb) {
        const int k = kb * 64 + lane;
        const uint4* ka = (const uint4*)(MK + ((size_t)bh * S + k) * 96);
        float s0 = 0.f;
#pragma unroll
        for (int i = 0; i < 12; ++i) {
            const uint4 u = ka[i];
            const unsigned uu[4] = {u.x, u.y, u.z, u.w};
#pragma unroll
            for (int e = 0; e < 4; ++e) s0 += qv[i * 8 + e * 2] * lo16(uu[e]) + qv[i * 8 + e * 2 + 1] * hi16(uu[e]);
        }
        s0 *= scale;
        const float n0 = fmaxf(m0, wave_max(s0));
        const float a0 = __expf(m0 - n0), p0 = __expf(s0 - n0);
        l0 = l0 * a0 + p0; o0 *= a0; m0 = n0;
        const uint4* vp = (const uint4*)(MVT + ((size_t)bh * 64 + lane) * S + kb * 64);
        uint4 v[8];
#pragma unroll
        for (int i = 0; i < 8; ++i) v[i] = vp[i];
#pragma unroll
        for (int i = 0; i < 8; ++i) {
            const unsigned vv[4] = {v[i].x, v[i].y, v[i].z, v[i].w};
#pragma unroll
            for (int e = 0; e < 4; ++e) {
                const int j = i * 8 + e * 2;
                o0 += rdlane(p0, j) * lo16(vv[e]) + rdlane(p0, j + 1) * hi16(vv[e]);
            }
        }
    }
    const float o = o0 / wave_sum(l0);
    const float ss = wave_sum(o * o);
    const int t = b * S + q;
    WSP(bf, OFF_MIX)[(size_t)t * 1024 + 640 + h * 64 + lane] = f2bf(o);
    if (lane == 0) WSP(float, OFF_SSQM)[t * 8 + h] = ss;
    }
}

DI void ph_mla_norm_fix(const Params& p, int bid, int nb) {
    for (int gid = bid * 256 + tidx(); gid < NT * 48; gid += nb * 256) {
    const int t = gid / 48, c8 = (gid % 48) * 8;
    const float* sq = WSP(float, OFF_SSQM) + t * 8;
    const float rn = rsqrtf((sq[0] + sq[1] + sq[2] + sq[3] + sq[4] + sq[5]) * (1.f / 384.f) + EPS);
    bf* m = WSP(bf, OFF_MIX) + (size_t)t * 1024 + 640 + c8;
    float v[8];
#pragma unroll
    for (int j = 0; j < 8; ++j) v[j] = bf2f(m[j]) * rn;
    store8(m, v);
    }
}

DI void ph_p4_gemm_naive(const Params& p, int l, int bid, int nb, unsigned char* smem) {
    float* sA = (float*)smem; float* sB = sA + 16 * 68;
    if (bid == 0 && tidx() < 32) WSP(int, OFF_CTL)[CTL_CNT + tidx()] = 0;
    for (int u = bid; u < 4096; u += nb) {
    const int mt = u / 16, nt = u % 16;
    const bf* A = WSP(bf, OFF_MIX) + (size_t)mt * 64 * D;
    const bf* Bt = WSP(bf, OFF_WOUT) + (size_t)l * 1024 * 1024 + (size_t)(nt * 64) * 1024;
    const float* xin = (l == 0 ? p.in[I_X] : WSP(float, OFF_XFA)) + (size_t)mt * 64 * D + nt * 64;
    float* x1 = p.out + (size_t)mt * 64 * D + nt * 64;
    bf* xb1 = WSP(bf, OFF_XB) + (size_t)mt * 64 * D + nt * 64;
    const float* g2 = p.in[I_N2G] + l * 1024 + nt * 64;
    ngemm_tile<true>(1024, [=](int r, int k) { return bf2f(A[(size_t)r * D + k]); }, [=](int k, int c) { return bf2f(Bt[(size_t)c * 1024 + k]); },
               [=](int r, int c, float v) { const float x = xin[(size_t)r * D + c] + v; x1[(size_t)r * D + c] = x; xb1[(size_t)r * D + c] = f2bf(x * g2[c]); }, sA, sB);
    }
}

DI void ph_router(const Params& p, int l, int bid, int nb) {
    const int lane = tidx() & 63, gw = bid * 4 + (tidx() >> 6), nw = nb * 4;
    const float* WR = WSP(float, OFF_WR) + (size_t)l * 36 * 1024;
    int* cnt = WSP(int, OFF_CTL) + CTL_CNT;
    int* list = WSP(int, OFF_LIST);
    float* gatew = WSP(float, OFF_GATEW);
    for (int t = gw; t < NT; t += nw) {
        const float* x = p.out + (size_t)t * D;
        float4 xv[4]; float ss = 0.f;
#pragma unroll
        for (int i = 0; i < 4; ++i) { xv[i] = *(const float4*)(x + lane * 4 + 256 * i); ss += xv[i].x * xv[i].x + xv[i].y * xv[i].y + xv[i].z * xv[i].z + xv[i].w * xv[i].w; }
        ss = wave_sum(ss);
        const float rinv = rsqrtf(ss * (1.f / 1024.f) + EPS);
        float lg[4];
#pragma unroll
        for (int j = 0; j < 4; ++j) {
            float a = 0.f;
#pragma unroll
            for (int i = 0; i < 4; ++i) { const float4 w = *(const float4*)(WR + (size_t)j * 1024 + lane * 4 + 256 * i); a += xv[i].x * w.x + xv[i].y * w.y + xv[i].z * w.z + xv[i].w * w.w; }
            lg[j] = wave_sum(a) * rinv + p.in[I_RGB][l * 4 + j];
        }
        int g = 0; float gm = lg[0];
#pragma unroll
        for (int j = 1; j < 4; ++j) if (lg[j] > gm) { gm = lg[j]; g = j; }
        float gs = 0.f;
#pragma unroll
        for (int j = 0; j < 4; ++j) gs += __expf(lg[j] - gm);
        const float pg_top = 1.f / gs;
        float e[8];
#pragma unroll
        for (int j = 0; j < 8; ++j) {
            const float* wrow = WR + (size_t)(4 + g * 8 + j) * 1024;
            float a = 0.f;
#pragma unroll
            for (int i = 0; i < 4; ++i) { const float4 w = *(const float4*)(wrow + lane * 4 + 256 * i); a += xv[i].x * w.x + xv[i].y * w.y + xv[i].z * w.z + xv[i].w * w.w; }
            e[j] = wave_sum(a) * rinv + p.in[I_REB][l * 32 + g * 8 + j];
        }
        int i1 = 0; float v1 = e[0];
#pragma unroll
        for (int i = 1; i < 8; ++i) if (e[i] > v1) { v1 = e[i]; i1 = i; }
        int i2 = -1; float v2 = -INFINITY;
#pragma unroll
        for (int i = 0; i < 8; ++i) if (i != i1 && e[i] > v2) { v2 = e[i]; i2 = i; }
        const float p1 = 1.f, p2 = __expf(v2 - v1);
        const float g1 = pg_top * p1 / (p1 + p2), g2 = pg_top * p2 / (p1 + p2);
        if (lane == 0) {
            const int e1 = g * 8 + i1, e2 = g * 8 + i2;
            const int pos1 = atomicAdd(&cnt[e1], 1); list[e1 * 16384 + pos1] = t * 2;
            const int pos2 = atomicAdd(&cnt[e2], 1); list[e2 * 16384 + pos2] = t * 2 + 1;
            gatew[t * 2] = g1; gatew[t * 2 + 1] = g2;
            WSP(float, OFF_RINV2)[t] = rinv;
        }
    }
}

DI void ph_moe_up_naive(const Params& p, int l, int bid, int nb, unsigned char* smem) {
    float* sA = (float*)smem; float* sB = sA + 16 * 68; int* sTok = (int*)(sB + 16 * 68);
    for (int u = bid; u < 32 * 256 * 8; u += nb) {
    const int nt = u & 7, rb = (u >> 3) & 255, e = u >> 11;
    const int* cnt = WSP(int, OFF_CTL) + CTL_CNT;
    const int n = cnt[e];
    if (rb * 64 >= n) continue;
    int base = 0; for (int i = 0; i < e; ++i) base += cnt[i];
    if (tidx() < 64) { const int r = rb * 64 + tidx(); sTok[tidx()] = r < n ? (WSP(int, OFF_LIST)[e * 16384 + r] >> 1) : -1; }
    __syncthreads();
    const bf* XB = WSP(bf, OFF_XB);
    const float* W = (nt < 4 ? p.in[I_W1] : p.in[I_W3]) + (size_t)(l * 32 + e) * 1024 * 256 + (nt & 3) * 64;
    const float* rinv2 = WSP(float, OFF_RINV2);
    float* H = WSP(float, OFF_H13) + (size_t)(base + rb * 64) * 512 + nt * 64;
    const int* tk = sTok;
    ngemm_tile<false>(1024, [=](int r, int k) { const int t = tk[r]; return t >= 0 ? bf2f(XB[(size_t)t * D + k]) : 0.f; }, [=](int k, int c) { return bf2f(f2bf(W[(size_t)k * 256 + c])); },
               [=](int r, int c, float v) { const int t = tk[r]; if (t >= 0) H[(size_t)r * 512 + c] = v * rinv2[t]; }, sA, sB);
    }
}

DI void ph_moe_act_naive(const Params& p, int bid, int nb) {
    for (int gid = bid * 256 + tidx(); gid < 32768 * 32; gid += nb * 256) {
    const int row = gid >> 5, c8 = (gid & 31) * 8;
    const float* H = WSP(float, OFF_H13) + (size_t)row * 512;
    float v[8];
#pragma unroll
    for (int j = 0; j < 8; ++j) { const float a = H[c8 + j], b = H[256 + c8 + j]; v[j] = a * sigmoidf_(a) * b; }
    store8(WSP(bf, OFF_ACT) + (size_t)row * 256 + c8, v);
    }
}

DI void ph_moe_down_naive(const Params& p, int l, int bid, int nb, unsigned char* smem) {
    float* sA = (float*)smem; float* sB = sA + 16 * 68; int* sEnt = (int*)(sB + 16 * 68);
    for (int u = bid; u < 32 * 256 * 16; u += nb) {
    const int nt = u & 15, rb = (u >> 4) & 255, e = u >> 12;
    const int* cnt = WSP(int, OFF_CTL) + CTL_CNT;
    const int n = cnt[e];
    if (rb * 64 >= n) continue;
    int base = 0; for (int i = 0; i < e; ++i) base += cnt[i];
    if (tidx() < 64) { const int r = rb * 64 + tidx(); sEnt[tidx()] = r < n ? WSP(int, OFF_LIST)[e * 16384 + r] : -1; }
    __syncthreads();
    const bf* A = WSP(bf, OFF_ACT) + (size_t)(base + rb * 64) * 256;
    const float* W = p.in[I_W2] + (size_t)(l * 32 + e) * 256 * 1024 + nt * 64;
    const float* gatew = WSP(float, OFF_GATEW);
    bf* Y = WSP(bf, OFF_Y);
    const int* en = sEnt;
    ngemm_tile<false>(256, [=](int r, int k) { return en[r] >= 0 ? bf2f(A[(size_t)r * 256 + k]) : 0.f; }, [=](int k, int c) { return bf2f(f2bf(W[(size_t)k * 1024 + c])); },
               [=](int r, int c, float v) { const int en_ = en[r]; if (en_ >= 0) Y[((size_t)(en_ & 1) * NT + (en_ >> 1)) * D + nt * 64 + c] = f2bf(v * gatew[en_]); }, sA, sB);
    }
}

DI void ph_combine(const Params& p, int last, int bid, int nb) {
    const int lane = tidx() & 63, gw = bid * 4 + (tidx() >> 6), nw = nb * 4;
    const bf* Y = WSP(bf, OFF_Y);
    float* xo = last ? p.out : WSP(float, OFF_XFA);
    const float* x1p = last ? WSP(float, OFF_XFA) : p.out;
    bf* xb = WSP(bf, OFF_XB);
    for (int t = gw; t < NT; t += nw) {
        float ss = 0.f;
#pragma unroll
        for (int i = 0; i < 2; ++i) {
            const int c = (lane + 64 * i) * 8;
            const float4 a = *(const float4*)(x1p + (size_t)t * D + c), b = *(const float4*)(x1p + (size_t)t * D + c + 4);
            const uint4 y0 = *(const uint4*)(Y + (size_t)t * D + c), y1 = *(const uint4*)(Y + ((size_t)NT + t) * D + c);
            float v[8] = {a.x, a.y, a.z, a.w, b.x, b.y, b.z, b.w};
            const unsigned u0[4] = {y0.x, y0.y, y0.z, y0.w}, u1[4] = {y1.x, y1.y, y1.z, y1.w};
#pragma unroll
            for (int e = 0; e < 4; ++e) { v[2 * e] += lo16(u0[e]) + lo16(u1[e]); v[2 * e + 1] += hi16(u0[e]) + hi16(u1[e]); }
#pragma unroll
            for (int j = 0; j < 8; ++j) ss += v[j] * v[j];
            *(float4*)(xo + (size_t)t * D + c) = make_float4(v[0], v[1], v[2], v[3]);
            *(float4*)(xo + (size_t)t * D + c + 4) = make_float4(v[4], v[5], v[6], v[7]);
            if (!last) store8(xb + (size_t)t * D + c, v);
        }
        ss = wave_sum(ss);
        if (!last && lane == 0) WSP(float, OFF_RINV1)[t] = rsqrtf(ss * (1.f / 1024.f) + EPS);
    }
}


#define XB_TMO      128
#define XB_XCNT(j)  (256  + 64 * (j))
#define XB_XSUB(j)  (1280 + 64 * (j))
#define XB_XGEN(j)  (2304 + 64 * (j))
#define XB_TOP      3328
#define XB_TOPGEN   3392
#define XCD_BAR_WORDS 3456
#define XB_SPIN_CAP (1u << 22)
#define LAS __attribute__((address_space(3)))
constexpr size_t OFF_BAR = OFF_CTL + 16384;
static_assert(16384 + XCD_BAR_WORDS * 4 <= 65536, "ctl region");

DI unsigned xb_ld(unsigned* p) { return __hip_atomic_load(p, __ATOMIC_RELAXED, __HIP_MEMORY_SCOPE_AGENT); }
DI unsigned xb_add(unsigned* p, unsigned v) { return __hip_atomic_fetch_add(p, v, __ATOMIC_RELAXED, __HIP_MEMORY_SCOPE_AGENT); }
DI unsigned xb_xcc_id() { return (unsigned)__builtin_amdgcn_s_getreg((3 << 11) | 20) & 0xFu; }
#define XB_SPIN(cond, bar) do { unsigned _sp = 0; while (cond) { __builtin_amdgcn_s_sleep(1); \
    if ((++_sp & 255u) == 0u) { if (xb_ld(&(bar)[XB_TMO])) break; if (_sp > XB_SPIN_CAP) { atomicAdd(&(bar)[XB_TMO], 1u); break; } } } } while (0)

struct XcdBarrier { unsigned* bar; unsigned x; volatile LAS unsigned* st; };

DI XcdBarrier xcd_barrier_post(unsigned* bar, volatile LAS unsigned* st) {
    XcdBarrier b; b.bar = bar; b.x = xb_xcc_id(); b.st = st;
    if (tidx() == 0) (void)xb_add(&bar[XB_XCNT(b.x)], 1u);
    return b;
}
DI void xcd_barrier_complete(unsigned* bar, unsigned x, unsigned& nloc, unsigned& nx) {
    const unsigned G = gridDim.x * gridDim.y * gridDim.z;
    unsigned sum, cnt, mine, sp = 0u;
    for (;;) {
        sum = 0u; cnt = 0u; mine = 0u;
#pragma unroll
        for (unsigned j = 0; j < 16; ++j) { const unsigned c = xb_ld(&bar[XB_XCNT(j)]); sum += c; cnt += (c > 0u) ? 1u : 0u; mine = (j == x) ? c : mine; }
        if (sum == G) break;
        __builtin_amdgcn_s_sleep(1);
        if ((++sp & 255u) == 0u) { if (xb_ld(&bar[XB_TMO])) break; if (sp > XB_SPIN_CAP) { atomicAdd(&bar[XB_TMO], 1u); break; } }
    }
    nloc = mine > 0u ? mine : 1u; nx = cnt > 0u ? cnt : 1u;
}
DI void xcd_barrier(const XcdBarrier& b) {
    asm volatile("s_waitcnt vmcnt(0)" ::: "memory");
    __syncthreads();
    if (tidx() == 0) {
        unsigned zoff = 0; asm volatile("" : "+s"(zoff));
        unsigned* bar = b.bar + zoff;
        const unsigned bx = b.x + zoff;
        __builtin_amdgcn_s_waitcnt(0);
        unsigned nloc = b.st[0], nx = b.st[1];
        if (nloc == 0u) { xcd_barrier_complete(bar, bx, nloc, nx); b.st[0] = nloc; b.st[1] = nx; }
        const unsigned old = xb_add(&bar[XB_XSUB(bx)], 1u);
        const unsigned gen = old / nloc;
        if (old + 1u == (gen + 1u) * nloc) {
            __builtin_amdgcn_fence(__ATOMIC_RELEASE, "agent");
            asm volatile("s_waitcnt vmcnt(0)" ::: "memory");
            const unsigned og = xb_add(&bar[XB_TOP], 1u);
            const unsigned tg = og / nx;
            if (og + 1u == (tg + 1u) * nx) xb_add(&bar[XB_TOPGEN], 1u);
            else XB_SPIN(xb_ld(&bar[XB_TOPGEN]) == tg, bar);
            __builtin_amdgcn_fence(__ATOMIC_ACQUIRE, "agent");
            xb_add(&bar[XB_XGEN(bx)], 1u);
            asm volatile("s_waitcnt vmcnt(0)" ::: "memory");
        } else {
            XB_SPIN(xb_ld(&bar[XB_XGEN(bx)]) == gen, bar);
            __builtin_amdgcn_fence(__ATOMIC_ACQUIRE, "agent");
            asm volatile("s_waitcnt vmcnt(0)" ::: "memory");
        }
    }
    __syncthreads();
}

#define USE_CG_SYNC 0
#ifndef PROBE
#define PROBE 0
#endif
#define FAST_P1 1
#define FAST_ATTN 1
#define FAST_P4 1
#define FAST_MOE 1
#define FAST_MLAUP 1
constexpr int SMEM_BYTES = GEMM_SMEM + 64;
#if USE_CG_SYNC
#define GRID_SYNC() grid.sync()
#else
#define GRID_SYNC() do { TSTART(5); xcd_barrier(xbar); TSTOP(5); } while (0)
#define GRID_SYNCN(k) do { TSTART(5); TSTART(20 + (k)); xcd_barrier(xbar); TSTOP(20 + (k)); TSTOP(5); } while (0)
#endif

__global__ void __launch_bounds__(256, 2) mega_fwd(Params p) {
    extern __shared__ __attribute__((aligned(16))) unsigned char smem[];
#if USE_CG_SYNC
    cg::grid_group grid = cg::this_grid();
#else
    if (tidx() < 16) ((unsigned*)(smem + GEMM_SMEM))[tidx()] = 0u;
    __syncthreads();
    XcdBarrier xbar = xcd_barrier_post((unsigned*)(p.ws + OFF_BAR), (volatile LAS unsigned*)(smem + GEMM_SMEM));
#endif
    const int bid = blockIdx.x, nb = gridDim.x;
        TSTART(39);
    ph_prep_weights(p, bid, nb, smem);
    ph_prep_misc(p, bid, nb);
    ph_prep_x(p, bid, nb);
    GRID_SYNCN(0);
        TSTOP(39);
#if PROBE == 9
    for (int i = 0; i < 20; ++i) GRID_SYNC();
#endif
#if PROBE == 8
    ph_prep_weights(p, bid, nb, smem); ph_prep_misc(p, bid, nb); ph_prep_x(p, bid, nb); GRID_SYNC();
#endif
    for (int l = 0; l < 2; ++l) {
        TSTART(31);
        ph_p1<0>(p, l, bid, nb, smem);
        GRID_SYNCN(1);
        TSTOP(31);
#if PROBE == 1
        ph_p1<0>(p, l, bid, nb, smem); GRID_SYNC();
#endif
#if PROBE >= 12 && PROBE <= 16
        ph_p1<PROBE>(p, l, bid, nb, smem); GRID_SYNC();
#endif
        TSTART(32);
        ph_p2(p, l, smem);
        GRID_SYNCN(2);
        TSTOP(32);
        TSTART(33);
        ph_p3<0>(p, l, l, smem);
        GRID_SYNCN(3);
        TSTOP(33);
#if PROBE >= 30 && PROBE < 40
        ph_p3<PROBE - 30>(p, l, 2 + l, smem); GRID_SYNC();
#endif
        TSTART(34);
        ph_p4(p, l, bid, nb, smem);
        GRID_SYNCN(4);
        TSTOP(34);
#if PROBE == 4
        ph_p4(p, l, bid, nb, smem); GRID_SYNC();
#endif
        TSTART(35);
        ph_router_fast(p, l, bid, nb, smem);
        GRID_SYNCN(5);
        TSTOP(35);
#if PROBE == 5
        if (bid == 0 && tidx() < 32) WSP(int, OFF_CTL)[CTL_CNT + tidx() * 32] = 0;
        GRID_SYNC();
        ph_router_fast(p, l, bid, nb, smem); GRID_SYNC();
#endif
        TSTART(36);
        ph_moe_up(p, l, bid, nb, smem);
        GRID_SYNCN(6);
        TSTOP(36);
        TSTART(37);
        ph_moe_down(p, l, bid, nb, smem);
        GRID_SYNCN(7);
        TSTOP(37);
#if PROBE == 6
        ph_moe_up(p, l, bid, nb, smem); GRID_SYNC(); ph_moe_down(p, l, bid, nb, smem); GRID_SYNC();
#endif
#if PROBE == 61
        ph_moe_up(p, l, bid, nb, smem); GRID_SYNC();
#endif
#if PROBE == 62
        ph_moe_down(p, l, bid, nb, smem); GRID_SYNC();
#endif
        TSTART(38);
        ph_combine(p, l == 1, bid, nb);
        if (l == 0) GRID_SYNCN(8);
        TSTOP(38);
#if PROBE == 7
        if (l == 0) { ph_combine(p, 0, bid, nb); GRID_SYNC(); }
#endif
    }
#if TPROBE
    if (blockIdx.x == TBLK && threadIdx.x == 0) {
        const unsigned long long dt = *(volatile unsigned long long*)tp_smem * TAMP, t0 = __builtin_amdgcn_s_memrealtime();
        while (__builtin_amdgcn_s_memrealtime() - t0 < dt) __builtin_amdgcn_s_sleep(8);
    }
#endif
}

extern "C" void kernel_launch(void* const* d_in, const int* in_sizes, int n_in, void* d_out, int out_size, void* d_ws, size_t ws_size, hipStream_t stream) {
    if (n_in != N_IN || ws_size < WS_TOTAL || out_size != NT * D) { fprintf(stderr, "kernel_launch: bad sizes n_in %d ws %zu (need %zu) out %d\n", n_in, ws_size, (size_t)WS_TOTAL, out_size); return; }
    static int grid_blocks = 0;
    if (!grid_blocks) {
        int dev = 0, cus = 0, per_cu = 0;
        (void)hipGetDevice(&dev);
        (void)hipDeviceGetAttribute(&cus, hipDeviceAttributeMultiprocessorCount, dev);
        (void)hipFuncSetAttribute((const void*)mega_fwd, hipFuncAttributeMaxDynamicSharedMemorySize, SMEM_BYTES);
        (void)hipOccupancyMaxActiveBlocksPerMultiprocessor(&per_cu, (const void*)mega_fwd, 256, SMEM_BYTES);
        if (per_cu < 1) { fprintf(stderr, "kernel_launch: occupancy query says %d blocks per CU\n", per_cu); return; }
        if (per_cu > 2) per_cu = 2;
        grid_blocks = cus * per_cu;
    }
    Params p{};
    for (int i = 0; i < N_IN; ++i) p.in[i] = (const float*)d_in[i];
    p.out = (float*)d_out; p.ws = (unsigned char*)d_ws;
    (void)hipMemsetAsync((unsigned char*)d_ws + OFF_CTL, 0, 65536, stream);
    void* args[] = {&p};
    hipError_t e = hipLaunchCooperativeKernel((const void*)mega_fwd, dim3(grid_blocks), dim3(256), args, SMEM_BYTES, stream);
    if (e != hipSuccess) fprintf(stderr, "cooperative launch failed: %s (grid %d)\n", hipGetErrorString(e), grid_blocks);
}
```

```cpp
#include <hip/hip_runtime.h>
#include <hip/hip_cooperative_groups.h>
namespace cg = cooperative_groups;
#include <cstdio>
#include <cstdint>

#define DI __device__ __forceinline__
#define TPROBE 0
#define TAMP 8
#define TBLK 0
typedef unsigned short bf;

constexpr int NB = 4, S = 4096, D = 1024, NT = NB * S, NPROJ = 2048;
constexpr float EPS = 1e-6f;
enum { I_X = 0, I_N1G, I_WIN, I_CONVW, I_CONVB, I_WA, I_BA, I_WX, I_BX, I_LAM, I_LOUTG, I_DQG, I_DKG, I_LQ1, I_LK1, I_LQ2, I_LK2,
       I_SUBG, I_CQG, I_CKVG, I_WUQ, I_WUKV, I_MQG, I_MKG, I_MOUTG, I_WOUT, I_N2G, I_RGW, I_RGB, I_REW, I_REB, I_W1, I_W3, I_W2, N_IN };

struct Params { const float* in[N_IN]; float* out; unsigned char* ws; };

constexpr size_t AL(size_t x) { return (x + 255) & ~(size_t)255; }
constexpr size_t OFF_WIN = 0;
constexpr size_t OFF_WOUT = OFF_WIN + (size_t)2 * 2048 * 1024 * 2;
constexpr size_t OFF_WUQ = OFF_WOUT + (size_t)2 * 1024 * 1024 * 2;
constexpr size_t OFF_WUKV = OFF_WUQ + (size_t)2 * 768 * 192 * 2;
constexpr size_t OFF_WAX = OFF_WUKV + (size_t)2 * 768 * 128 * 2;
constexpr size_t OFF_WR = OFF_WAX + (size_t)2 * 2 * 4 * 64 * 64 * 2;
constexpr size_t OFF_ROPE = AL(OFF_WR + (size_t)2 * 64 * 1024 * 2);
constexpr size_t OFF_CTL = OFF_ROPE + (size_t)4096 * 32 * 4;
constexpr size_t OFF_RINV1 = OFF_CTL + 65536;
constexpr size_t OFF_RINV2 = OFF_RINV1 + (size_t)NT * 4;
constexpr size_t OFF_SSQ2 = OFF_RINV2 + (size_t)NT * 4;
constexpr size_t OFF_SSQM = OFF_SSQ2 + (size_t)NT * 8 * 4;
constexpr size_t OFF_TOT = OFF_SSQM + (size_t)NT * 8 * 4;
constexpr size_t OFF_GATEW = OFF_TOT + (size_t)4 * 64 * 2 * 256 * 4;
constexpr size_t OFF_LIST = OFF_GATEW + (size_t)NT * 2 * 4;
constexpr size_t OFF_XFA = OFF_LIST + (size_t)32 * 16384 * 4;
constexpr size_t OFF_XB = OFF_XFA + (size_t)NT * D * 4;
constexpr size_t OFF_MIX = OFF_XB + (size_t)NT * D * 2;
constexpr size_t OFF_STAGE = OFF_MIX + (size_t)NT * D * 2;
constexpr size_t OFF_LX = OFF_STAGE;
constexpr size_t OFF_GG = OFF_LX + (size_t)NT * 256 * 2;
constexpr size_t OFF_DQ = OFF_GG + (size_t)NT * 256 * 2;
constexpr size_t OFF_DK = OFF_DQ + (size_t)NT * 384 * 2;
constexpr size_t OFF_DVT = OFF_DK + (size_t)NT * 384 * 2;
constexpr size_t OFF_CQ = OFF_DVT + (size_t)NT * 384 * 2;
constexpr size_t OFF_CKV = OFF_CQ + (size_t)NT * 192 * 2;
constexpr size_t OFF_KR = OFF_CKV + (size_t)NT * 128 * 2;
constexpr size_t OFF_MQ = OFF_KR + (size_t)NT * 32 * 2;
constexpr size_t OFF_MK = OFF_MQ + (size_t)NT * 576 * 2;
constexpr size_t OFF_MVT = OFF_MK + (size_t)NT * 576 * 2;
constexpr size_t OFF_STAGE_END = OFF_MVT + (size_t)NT * 384 * 2;
constexpr size_t OFF_Y = OFF_STAGE;
constexpr size_t OFF_ACT = OFF_Y + (size_t)2 * NT * D * 2;
constexpr size_t OFF_H13 = OFF_Y;
constexpr size_t WS_TOTAL = OFF_STAGE_END;
static_assert(OFF_ACT + (size_t)(32768 + 128) * 256 * 2 <= OFF_STAGE_END, "alias");
constexpr int CTL_CNT = 0;
constexpr int CTL_LAM = 1024 + 4 * 256;
constexpr int CTL_Q = 1024;

#define WSP(T, off) ((T*)(p.ws + (off)))
#define X1PTR(l) ((l) == 0 ? p.out : WSP(float, OFF_XFA))
#define EWPTR(l) ((bf*)((l) == 0 ? (unsigned char*)WSP(float, OFF_XFA) : (unsigned char*)p.out))
constexpr size_t EW_W3 = (size_t)32 * 262144, EW_W2 = (size_t)64 * 262144;

DI int tidx() { int t = threadIdx.x; asm volatile("" : "+v"(t)); return t; }
DI unsigned xcc_id() { return (unsigned)__builtin_amdgcn_s_getreg((3 << 11) | 20) & 0xFu; }
#if TPROBE
#define TSTART(id) do { if ((id) == TPROBE && blockIdx.x == TBLK && threadIdx.x == 0) *(volatile unsigned long long*)(tp_smem + 8) = __builtin_amdgcn_s_memrealtime(); } while (0)
#define TSTOP(id) do { if ((id) == TPROBE && blockIdx.x == TBLK && threadIdx.x == 0) { volatile unsigned long long* q_ = (volatile unsigned long long*)tp_smem; q_[0] = q_[0] + (__builtin_amdgcn_s_memrealtime() - q_[1]); } } while (0)
#else
#define TSTART(id) do {} while (0)
#define TSTOP(id) do {} while (0)
#endif
extern __shared__ __attribute__((aligned(16))) unsigned char g_smem_[];
#define tp_smem (g_smem_ + 76832)
DI float bf2f(bf v) { return __uint_as_float(((unsigned)v) << 16); }
DI bf f2bf(float f) { unsigned u = __float_as_uint(f); u += 0x7fffu + ((u >> 16) & 1u); return (bf)(u >> 16); }
typedef __bf16 hwbf16x2 __attribute__((ext_vector_type(2)));
typedef float f32x2 __attribute__((ext_vector_type(2)));
DI unsigned pack2(float a, float b) { f32x2 v = {a, b}; return __builtin_bit_cast(unsigned, __builtin_convertvector(v, hwbf16x2)); }
DI float lo16(unsigned u) { return __uint_as_float(u << 16); }
DI float hi16(unsigned u) { return __uint_as_float(u & 0xffff0000u); }
DI float wave_sum(float v) { for (int o = 32; o > 0; o >>= 1) v += __shfl_xor(v, o); return v; }
DI float wave_max(float v) { for (int o = 32; o > 0; o >>= 1) v = fmaxf(v, __shfl_xor(v, o)); return v; }
DI float gelu_tanh(float x) {
    const float y2 = 1.5957691216057308f * (x + 0.044715f * x * x * x);
    return x - x * __builtin_amdgcn_rcpf(__expf(y2) + 1.f);
}
DI float sigmoidf_(float x) { return 1.f / (1.f + __expf(-x)); }
DI float lambda_init(int l) { return l == 0 ? 0.2f : 0.35550906757f; }
DI void store8(bf* dst, const float* v) { uint4 u; u.x = pack2(v[0], v[1]); u.y = pack2(v[2], v[3]); u.z = pack2(v[4], v[5]); u.w = pack2(v[6], v[7]); *(uint4*)dst = u; }

template <class SCOL, class GAIN>
DI void tr_tile(const float* src, int lds_, bf* dst, int K, int n0, int k0, SCOL scol, GAIN gain, float* tile) {
    const int tid = tidx();
    const int nn = tid & 63;
    const int sc = scol(n0 + nn);
#pragma unroll
    for (int i = 0; i < 16; ++i) {
        const int kk = (tid >> 6) + 4 * i;
        float v = 0.f;
        if (sc >= 0) v = src[(size_t)(k0 + kk) * lds_ + sc] * gain(k0 + kk);
        tile[kk * 65 + nn] = v;
    }
    __syncthreads();
#pragma unroll
    for (int i = 0; i < 2; ++i) {
        const int id = tid + 256 * i, n = id >> 3, kc = (id & 7) * 8;
        float v[8];
#pragma unroll
        for (int j = 0; j < 8; ++j) v[j] = tile[(kc + j) * 65 + n];
        store8(dst + (size_t)(n0 + n) * K + k0 + kc, v);
    }
    __syncthreads();
}

DI int win_col(int n) {
    if (n < 1856) return n;
    if (n < 1888) return 1984 + (n - 1856);
    if (n < 1920) return -1;
    return 1856 + (n - 1920);
}

constexpr int PW_WIN = 2 * 32 * 16;
constexpr int PW_WOUT = 2 * 16 * 16;
constexpr int PW_WUQ = 2 * 12 * 3;
constexpr int PW_WUKV = 2 * 12 * 2;
constexpr int PW_WAX = 2 * 2 * 4;
constexpr int PW_TOTAL = PW_WIN + PW_WOUT + PW_WUQ + PW_WUKV + PW_WAX;

DI void prep_weights_unit(const Params& p, int u, float* tile) {
    if (u < PW_WIN) {
        const int l = u / 512, r = u % 512, nt = r / 16, kt = r % 16;
        const float* g = p.in[I_N1G] + l * 1024;
        tr_tile(p.in[I_WIN] + (size_t)l * 1024 * 2016, 2016, WSP(bf, OFF_WIN) + (size_t)l * 2048 * 1024, 1024, nt * 64, kt * 64,
                [](int n) { return win_col(n); }, [g](int k) { return g[k]; }, tile);
        return;
    }
    u -= PW_WIN;
    if (u < PW_WOUT) {
        const int l = u / 256, r = u % 256, nt = r / 16, kt = r % 16;
        const float* g_lru = p.in[I_LOUTG] + l * 256; const float* g_sub = p.in[I_SUBG] + l * 64; const float* g_mla = p.in[I_MOUTG] + l * 384;
        const float li = 1.f - lambda_init(l);
        tr_tile(p.in[I_WOUT] + (size_t)l * 1024 * 1024, 1024, WSP(bf, OFF_WOUT) + (size_t)l * 1024 * 1024, 1024, nt * 64, kt * 64,
                [](int n) { return n; },
                [=](int k) { return k < 256 ? g_lru[k] : (k < 640 ? g_sub[(k - 256) & 63] * li : g_mla[k - 640]); }, tile);
        return;
    }
    u -= PW_WOUT;
    if (u < PW_WUQ) {
        const int l = u / 36, r = u % 36, nt = r / 3, kt = r % 3;
        const float* g = p.in[I_CQG] + l * 192;
        tr_tile(p.in[I_WUQ] + (size_t)l * 192 * 576, 576, WSP(bf, OFF_WUQ) + (size_t)l * 768 * 192, 192, nt * 64, kt * 64,
                [](int n) { return (n & 127) < 96 ? (n >> 7) * 96 + (n & 127) : -1; }, [g](int k) { return g[k]; }, tile);
        return;
    }
    u -= PW_WUQ;
    if (u < PW_WUKV) {
        const int l = u / 24, r = u % 24, nt = r / 2, kt = r % 2;
        const float* g = p.in[I_CKVG] + l * 128;
        tr_tile(p.in[I_WUKV] + (size_t)l * 128 * 768, 768, WSP(bf, OFF_WUKV) + (size_t)l * 768 * 128, 128, nt * 64, kt * 64,
                [](int n) { return n; }, [g](int k) { return g[k]; }, tile);
        return;
    }
    u -= PW_WUKV;
    {
        const int l = u / 8, which = (u / 4) & 1, blk = u & 3;
        const float* src = (which ? p.in[I_WX] : p.in[I_WA]) + (size_t)(l * 4 + blk) * 4096;
        tr_tile(src, 64, WSP(bf, OFF_WAX) + (size_t)((l * 2 + which) * 4 + blk) * 4096, 64, 0, 0,
                [](int n) { return n; }, [](int) { return 1.f; }, tile);
    }
}

DI void ph_prep_weights(const Params& p, int bid, int nb, unsigned char* smem) {
    float* tile = (float*)smem;
    for (int u = bid; u < PW_TOTAL; u += nb) prep_weights_unit(p, u, tile);
}

DI void ph_prep_misc(const Params& p, int bid, int nb) {
    const int gid = bid * 256 + tidx(), gsz = nb * 256;
    bf* wr = WSP(bf, OFF_WR);
    for (int i = gid; i < 2 * 64 * 1024; i += gsz) {
        const int l = i >> 16, j = (i >> 10) & 63, k = i & 1023;
        float w = 0.f;
        if (j < 4) w = p.in[I_RGW][(size_t)(l * 1024 + k) * 4 + j];
        else if (j < 36) w = p.in[I_REW][(size_t)(l * 1024 + k) * 32 + (j - 4)];
        wr[i] = f2bf(w);
    }
    float* rope = WSP(float, OFF_ROPE);
    for (int i = gid; i < 4096 * 16; i += gsz) {
        const int s = i >> 4, f = i & 15;
        const float inv_freq = (float)exp2(-(double)f / 16.0 * 13.287712379549449);
        const float angf = (float)s * inv_freq;
        double a = (double)angf;
        const double twopi = 6.283185307179586476925;
        a -= twopi * rint(a / twopi);
        const double hh = 0.5 * a, h2 = hh * hh;
        double sn = 1.0, cs = 1.0, ts = 1.0, tc = 1.0;
#pragma unroll
        for (int n = 1; n <= 10; ++n) {
            tc *= -h2 / (double)((2 * n - 1) * (2 * n));
            ts *= -h2 / (double)((2 * n) * (2 * n + 1));
            cs += tc; sn += ts;
        }
        sn *= hh;
        rope[s * 32 + f] = (float)(cs * cs - sn * sn);
        rope[s * 32 + 16 + f] = (float)(2.0 * sn * cs);
    }
    if (gid < 32) WSP(int, OFF_CTL)[CTL_CNT + gid * 32] = 0;
    if (gid < 2) {
        float d1 = 0.f, d2 = 0.f;
        for (int i = 0; i < 32; ++i) { d1 += p.in[I_LQ1][gid * 32 + i] * p.in[I_LK1][gid * 32 + i]; d2 += p.in[I_LQ2][gid * 32 + i] * p.in[I_LK2][gid * 32 + i]; }
        WSP(float, OFF_CTL)[CTL_LAM + gid] = expf(d1) - expf(d2) + lambda_init(gid);
        float gq = 0.f, gk = 0.f;
        for (int i = 0; i < 32; ++i) { gq = fmaxf(gq, fabsf(p.in[I_DQG][gid * 32 + i])); gk = fmaxf(gk, fabsf(p.in[I_DKG][gid * 32 + i])); }
        WSP(float, OFF_CTL)[CTL_LAM + 2 + gid] = 32.f * gq * gk * 0.17677669529663687f * 1.4426950408889634f * 1.02f;
        float mq = 0.f, mk = 0.f;
        for (int i = 0; i < 96; ++i) { mq = fmaxf(mq, fabsf(p.in[I_MQG][gid * 96 + i])); mk = fmaxf(mk, fabsf(p.in[I_MKG][gid * 96 + i])); }
        WSP(float, OFF_CTL)[CTL_LAM + 4 + gid] = 96.f * mq * mk * 0.10206207261596575f * 1.4426950408889634f * 1.02f;
    }
}

DI void ph_prep_x(const Params& p, int bid, int nb) {
    const int lane = tidx() & 63, gw = bid * 4 + (tidx() >> 6), nw = nb * 4;
    const float* x = p.in[I_X];
    bf* xb = WSP(bf, OFF_XB);
    float* rinv = WSP(float, OFF_RINV1);
    for (int t = gw; t < NT; t += nw) {
        float ss = 0.f;
#pragma unroll
        for (int i = 0; i < 2; ++i) {
            const int c = (lane + 64 * i) * 8;
            const float4 a = *(const float4*)(x + (size_t)t * D + c), b = *(const float4*)(x + (size_t)t * D + c + 4);
            float v[8] = {a.x, a.y, a.z, a.w, b.x, b.y, b.z, b.w};
#pragma unroll
            for (int j = 0; j < 8; ++j) ss += v[j] * v[j];
            store8(xb + (size_t)t * D + c, v);
        }
        ss = wave_sum(ss);
        if (lane == 0) rinv[t] = rsqrtf(ss * (1.f / 1024.f) + EPS);
    }
}

template <bool BT, class LA, class LB, class EPI>
DI void ngemm_tile(int K, LA la, LB lb, EPI epi, float* sA, float* sB) {
    const int tid = tidx(), ty = tid >> 4, tx = tid & 15;
    float acc[4][4];
#pragma unroll
    for (int i = 0; i < 4; ++i)
#pragma unroll
        for (int j = 0; j < 4; ++j) acc[i][j] = 0.f;
    for (int k0 = 0; k0 < K; k0 += 16) {
#pragma unroll
        for (int i = 0; i < 4; ++i) {
            const int e = tid + 256 * i;
            sA[(e & 15) * 68 + (e >> 4)] = la(e >> 4, k0 + (e & 15));
            if (BT) sB[(e & 15) * 68 + (e >> 4)] = lb(k0 + (e & 15), e >> 4);
            else sB[(e >> 6) * 68 + (e & 63)] = lb(k0 + (e >> 6), e & 63);
        }
        __syncthreads();
#pragma unroll
        for (int kk = 0; kk < 16; ++kk) {
            const float4 a = *(const float4*)(sA + kk * 68 + ty * 4), b = *(const float4*)(sB + kk * 68 + tx * 4);
            const float av[4] = {a.x, a.y, a.z, a.w}, bv[4] = {b.x, b.y, b.z, b.w};
#pragma unroll
            for (int i = 0; i < 4; ++i)
#pragma unroll
                for (int j = 0; j < 4; ++j) acc[i][j] += av[i] * bv[j];
        }
        __syncthreads();
    }
#pragma unroll
    for (int i = 0; i < 4; ++i)
#pragma unroll
        for (int j = 0; j < 4; ++j) epi(ty * 4 + i, tx * 4 + j, acc[i][j]);
}

DI void ph_p1_gemm_naive(const Params& p, int l, int chunk, int bid, int nb, unsigned char* smem) {
    float* sA = (float*)smem; float* sB = sA + 16 * 68;
    for (int u = bid; u < 2048; u += nb) {
    const int mt = u / 8, nt = u % 8;
    const bf* A = WSP(bf, OFF_XB) + (size_t)mt * 64 * D;
    const bf* Bt = WSP(bf, OFF_WIN) + (size_t)l * 2048 * 1024 + (size_t)(chunk * 512 + nt * 64) * 1024;
    const float* rinv = WSP(float, OFF_RINV1) + mt * 64;
    float* C = WSP(float, OFF_MIX) + (size_t)mt * 64 * 512 + nt * 64;
    ngemm_tile<true>(1024, [=](int r, int k) { return bf2f(A[(size_t)r * D + k]); }, [=](int k, int c) { return bf2f(Bt[(size_t)c * 1024 + k]); },
               [=](int r, int c, float v) { C[(size_t)r * 512 + c] = v * rinv[r]; }, sA, sB);
    }
}

template <class ACC>
DI void route_tile(const Params& p, int l, int mt, int nt, ACC T) {
    const int tid = tidx();
    const int t0 = mt * 128, b = t0 >> 12, s0 = t0 & 4095;
    if (nt < 4) {
        bf* dst = WSP(bf, nt < 2 ? OFF_LX : OFF_GG);
        const int cb = (nt & 1) * 128;
#pragma unroll
        for (int it = 0; it < 8; ++it) {
            const int id = it * 256 + tid, r = id >> 4, c8 = (id & 15) * 8;
            float v[8];
#pragma unroll
            for (int j = 0; j < 8; ++j) { v[j] = T(r, c8 + j); if (nt >= 2) v[j] = gelu_tanh(v[j]); }
            store8(dst + (size_t)(t0 + r) * 256 + cb + c8, v);
        }
    } else if (nt < 10) {
        const bool isk = nt >= 7;
        const int g0 = (nt - (isk ? 7 : 4)) * 128;
        const float* gain = (isk ? p.in[I_DKG] : p.in[I_DQG]) + l * 32;
        bf* dst = WSP(bf, isk ? OFF_DK : OFF_DQ);
        const int c8 = (tid & 15) * 8, col = g0 + c8, h = col >> 6, m = (col >> 5) & 1, d0 = col & 31;
        float gn[8];
#pragma unroll
        for (int j = 0; j < 8; ++j) gn[j] = gain[d0 + j];
        bf* drow = dst + ((size_t)((b * 6 + h) * 2 + m) * S + s0) * 32 + d0;
#pragma unroll
        for (int it = 0; it < 8; ++it) {
            const int r = it * 16 + (tid >> 4);
            float v[8], ss = 0.f;
#pragma unroll
            for (int j = 0; j < 8; ++j) { v[j] = T(r, c8 + j); ss += v[j] * v[j]; }
            ss += __shfl_xor(ss, 1); ss += __shfl_xor(ss, 2);
            const float rn = rsqrtf(ss * (1.f / 32.f) + EPS);
#pragma unroll
            for (int j = 0; j < 8; ++j) v[j] = v[j] * rn * gn[j];
            store8(drow + (size_t)r * 32, v);
        }
    } else if (nt < 13) {
        const int g0 = (nt - 10) * 128;
        bf* dst = WSP(bf, OFF_DVT);
#pragma unroll
        for (int it = 0; it < 8; ++it) {
            const int id = it * 256 + tid, c = id & 127, rc = id >> 7;
            float v[8];
#pragma unroll
            for (int j = 0; j < 8; ++j) v[j] = T(8 * rc + j, c);
            const int col = g0 + c, h = col >> 6, d = col & 63;
            store8(dst + ((size_t)(b * 6 + h) * 64 + d) * S + s0 + 8 * rc, v);
        }
    } else {
        const int c8 = (tid & 15) * 8;
        bf* drow; size_t ld; bool act = true;
        if (nt == 13) { drow = WSP(bf, OFF_CQ) + c8; ld = 192; }
        else if (nt == 15) { drow = WSP(bf, OFF_CKV) + c8; ld = 128; }
        else if (c8 < 64) { drow = WSP(bf, OFF_CQ) + 128 + c8; ld = 192; }
        else { drow = WSP(bf, OFF_KR) + (c8 - 64); ld = 32; act = c8 < 96; }
#pragma unroll
        for (int it = 0; it < 8; ++it) {
            const int r = it * 16 + (tid >> 4);
            float v[8];
#pragma unroll
            for (int j = 0; j < 8; ++j) v[j] = T(r, c8 + j);
            if (act) store8(drow + (size_t)(t0 + r) * ld, v);
        }
    }
}

DI void ph_p1_route_naive(const Params& p, int l, int chunk, int bid, int nb) {
    for (int u = bid; u < 512; u += nb) {
    const int mt = u / 4, ntl = u % 4;
    const float* C = WSP(float, OFF_MIX) + (size_t)mt * 128 * 512 + ntl * 128;
    route_tile(p, l, mt, chunk * 4 + ntl, [=](int r, int c) { return C[(size_t)r * 512 + c]; });
    }
}


typedef short bf16x8 __attribute__((ext_vector_type(8)));
typedef short s16x4 __attribute__((ext_vector_type(4)));
typedef float f32x16 __attribute__((ext_vector_type(16)));
typedef __attribute__((address_space(3))) s16x4 lds_s16x4;
#define MFMA32(a, b, c) __builtin_amdgcn_mfma_f32_32x32x16_bf16((a), (b), (c), 0, 0, 0)
constexpr int G_A_BYTES = 16384, G_B_BYTES = 20480;
constexpr int G_OFF_B = 2 * G_A_BYTES;
constexpr int G_LOOP_BYTES = 2 * G_A_BYTES + 2 * G_B_BYTES;
constexpr int G_OFF_AUX = G_LOOP_BYTES;
constexpr int GEMM_SMEM = G_LOOP_BYTES + 3072;

DI unsigned cvt_pk_bf16(float a, float b) { return pack2(a, b); }

struct RowLoader {
    const bf* base; size_t ld;
    DI uint4 load(int i, int kt) const { return *(const uint4*)(base + (size_t)(32 * i) * ld + kt * 64); }
};
struct GatherLoader {
    const bf* rp[4];
    DI uint4 load(int i, int kt) const { return rp[i] ? *(const uint4*)(rp[i] + kt * 64) : make_uint4(0, 0, 0, 0); }
};
struct TrLoader {
    const float* base; size_t ldn;
    DI float4 load(int i, int kt) const { return *(const float4*)(base + (size_t)(kt * 64 + 8 * i) * ldn); }
};
struct TrLoaderBf {
    const bf* base; size_t ldn;
    DI uint4 load(int i, int kt) const { return *(const uint4*)(base + (size_t)(kt * 64 + 16 * i) * ldn); }
};

template <int BMODE, class AL, class BL>
DI void g_issue(uint4 (&ra)[4], uint4 (&rb0)[4], float4 (&rb1)[8], const AL& al, const BL& bl, int kt) {
#pragma unroll
    for (int i = 0; i < 4; ++i) ra[i] = al.load(i, kt);
    if constexpr (BMODE == 0 || BMODE == 2) {
#pragma unroll
        for (int i = 0; i < 4; ++i) rb0[i] = bl.load(i, kt);
    } else {
#pragma unroll
        for (int i = 0; i < 8; ++i) rb1[i] = bl.load(i, kt);
    }
}
template <int BMODE>
DI void g_commit(const uint4 (&ra)[4], const uint4 (&rb0)[4], const float4 (&rb1)[8], unsigned char* dA, unsigned char* dB, int a_wr, int b_wr1) {
#pragma unroll
    for (int i = 0; i < 4; ++i) *(uint4*)(dA + a_wr + i * 4096) = ra[i];
    if constexpr (BMODE == 0) {
#pragma unroll
        for (int i = 0; i < 4; ++i) *(uint4*)(dB + a_wr + i * 4096) = rb0[i];
    } else if constexpr (BMODE == 2) {
        const int b_wr2 = (tidx() >> 4) * 320 + (tidx() & 15) * 16;
#pragma unroll
        for (int i = 0; i < 4; ++i) *(uint4*)(dB + b_wr2 + i * 5120) = rb0[i];
    } else {
#pragma unroll
        for (int i = 0; i < 8; ++i) *(uint2*)(dB + b_wr1 + i * 2560) = make_uint2(cvt_pk_bf16(rb1[i].x, rb1[i].y), cvt_pk_bf16(rb1[i].z, rb1[i].w));
    }
}
template <int BMODE, int GPV = 0>
DI void g_compute(f32x16 (&acc)[2][2], const unsigned char* sA, const unsigned char* sB, int a_rd, int b_rd0, int b_rd1, int h, int sw) {
    if (GPV == 14) { a_rd = 0; b_rd0 = 0; sw = 0; h = 0; }
#pragma unroll
    for (int ks = 0; ks < 4; ++ks) {
        const int co = ((2 * ks + h) ^ sw) << 4;
        bf16x8 a[2], b[2];
#pragma unroll
        for (int mi = 0; mi < 2; ++mi) a[mi] = *(const bf16x8*)(sA + a_rd + mi * 4096 + co);
        if constexpr (BMODE == 0) {
#pragma unroll
            for (int ni = 0; ni < 2; ++ni) b[ni] = *(const bf16x8*)(sB + b_rd0 + ni * 4096 + co);
        } else {
#pragma unroll
            for (int ni = 0; ni < 2; ++ni) {
                const s16x4 lo = __builtin_amdgcn_ds_read_tr16_b64_v4i16((lds_s16x4*)(sB + b_rd1 + ks * 5120 + ni * 64));
                const s16x4 hi = __builtin_amdgcn_ds_read_tr16_b64_v4i16((lds_s16x4*)(sB + b_rd1 + ks * 5120 + 1280 + ni * 64));
                b[ni] = __builtin_shufflevector(lo, hi, 0, 1, 2, 3, 4, 5, 6, 7);
            }
        }
        if (GPV == 16) { asm volatile("" :: "v"(a[0]), "v"(a[1]), "v"(b[0]), "v"(b[1])); continue; }
#pragma unroll
        for (int mi = 0; mi < 2; ++mi)
#pragma unroll
            for (int ni = 0; ni < 2; ++ni) acc[mi][ni] = MFMA32(a[mi], b[ni], acc[mi][ni]);
    }
}
#define GREGS uint4 raA[4], rbA[4], raB[4], rbB[4]; float4 rfA[8], rfB[8]
#define GREGS_P raA, rbA, rfA, raB, rbB, rfB
#define GREGS_T uint4 (&raA)[4], uint4 (&rbA)[4], float4 (&rfA)[8], uint4 (&raB)[4], uint4 (&rbB)[4], float4 (&rfB)[8]
template <int BMODE, class AL, class BL>
DI void g_prefetch(GREGS_T, const AL& al, const BL& bl, int nk) {
    g_issue<BMODE>(raA, rbA, rfA, al, bl, 0);
    __builtin_amdgcn_sched_barrier(0);
    g_issue<BMODE>(raB, rbB, rfB, al, bl, min(1, nk - 1));
    __builtin_amdgcn_sched_barrier(0);
}
struct NoMid { DI void operator()(f32x16 (&)[2][2], int) const {} };
template <int BMODE, class AL, class BL, class MID, int GPV = 0>
DI void gemm_run(f32x16 (&acc)[2][2], int nk, const AL& al, const BL& bl, unsigned char* smem, GREGS_T, const MID& mid) {
    const int tid = tidx(), lane = tid & 63, wv = tid >> 6, wr = wv >> 1, wc = wv & 1;
    const int r31 = lane & 31, h = lane >> 5, sw = (r31 >> 1) & 7;
    const int a_wr = (tid >> 3) * 128 + (((tid & 7) ^ ((tid >> 4) & 7)) << 4);
    const int b_wr1 = (tid >> 5) * 320 + (tid & 31) * 8;
    const int a_rd = (wr * 64 + r31) * 128, b_rd0 = (wc * 64 + r31) * 128;
    const int b_rd1 = (8 * h + ((lane & 15) >> 2)) * 320 + (wc * 64 + 16 * ((lane >> 4) & 1) + 4 * (lane & 3)) * 2;
    unsigned char* const sA0 = smem; unsigned char* const sA1 = smem + G_A_BYTES;
    unsigned char* const sB0 = smem + G_OFF_B; unsigned char* const sB1 = smem + G_OFF_B + G_B_BYTES;
    g_commit<BMODE>(raA, rbA, rfA, sA0, sB0, a_wr, b_wr1);
    __syncthreads();
#pragma unroll 1
    for (int kt = 0; kt < nk; kt += 2) {
        TSTART(40);
        g_issue<BMODE>(raA, rbA, rfA, al, bl, min(kt + 2, nk - 1));
        __builtin_amdgcn_sched_barrier(0);
        TSTOP(40);
        TSTART(41);
        g_compute<BMODE, GPV>(acc, sA0, sB0, a_rd, b_rd0, b_rd1, h, sw);
        mid(acc, kt);
        __builtin_amdgcn_sched_barrier(0);
        TSTOP(41);
        TSTART(42);
        if (GPV != 15) g_commit<BMODE>(raB, rbB, rfB, sA1, sB1, a_wr, b_wr1);
        __builtin_amdgcn_sched_barrier(0);
        TSTOP(42);
        TSTART(43);
        __syncthreads();
        TSTOP(43);
        if (kt + 1 >= nk) break;
        g_issue<BMODE>(raB, rbB, rfB, al, bl, min(kt + 3, nk - 1));
        __builtin_amdgcn_sched_barrier(0);
        g_compute<BMODE, GPV>(acc, sA1, sB1, a_rd, b_rd0, b_rd1, h, sw);
        mid(acc, kt + 1);
        if (GPV != 15) g_commit<BMODE>(raA, rbA, rfA, sA0, sB0, a_wr, b_wr1);
        __syncthreads();
    }
}

DI void acc_zero(f32x16 (&acc)[2][2]) {
#pragma unroll
    for (int mi = 0; mi < 2; ++mi)
#pragma unroll
        for (int ni = 0; ni < 2; ++ni)
#pragma unroll
            for (int r = 0; r < 16; ++r) acc[mi][ni][r] = 0.f;
}
DI void acc_stage(const f32x16 (&acc)[2][2], float* sC) {
    const int lane = tidx() & 63, wv = tidx() >> 6, wr = wv >> 1, wc = wv & 1, r31 = lane & 31, h = lane >> 5;
#pragma unroll
    for (int mi = 0; mi < 2; ++mi)
#pragma unroll
        for (int ni = 0; ni < 2; ++ni)
#pragma unroll
            for (int r = 0; r < 16; ++r)
                sC[(wr * 64 + mi * 32 + (r & 3) + 8 * (r >> 2) + 4 * h) * 128 + wc * 64 + ni * 32 + r31] = acc[mi][ni][r];
    __syncthreads();
}

template <int GPV>
DI void ph_p1(const Params& p, int l, int bid, int nb, unsigned char* smem) {
    const int tid = tidx();
    const bf* XB = WSP(bf, OFF_XB) + (size_t)(tid >> 3) * 1024 + (tid & 7) * 8;
    const bf* W = WSP(bf, OFF_WIN) + (size_t)l * 2048 * 1024 + (size_t)(tid >> 3) * 1024 + (tid & 7) * 8;
    const float* rinv = WSP(float, OFF_RINV1);
    float* sC = (float*)smem; float* sRV = (float*)(smem + G_OFF_AUX);
    if (bid >= 2048) return;
    GREGS;
#define P1_NT(u) ((((u) & 15) + 5 * ((u) >> 9)) & 15)
    RowLoader al{XB + (size_t)((bid >> 4) * 128) * 1024, 1024}, bl{W + (size_t)(P1_NT(bid) * 128) * 1024, 1024};
    float rvn = rinv[(bid >> 4) * 128 + (tid & 127)];
    g_prefetch<0>(GREGS_P, al, bl, 16);
    for (int u = bid; u < 2048; u += nb) {
        const int mt = u >> 4, nt = P1_NT(u);
        if (tid < 128) sRV[tid] = rvn;
        f32x16 acc[2][2];
        acc_zero(acc);
        TSTART(1);
        gemm_run<0, RowLoader, RowLoader, NoMid, GPV>(acc, 16, al, bl, smem, GREGS_P, NoMid());
        TSTOP(1);
        TSTART(2);
        if (GPV == 0) acc_stage(acc, sC); else asm volatile("" :: "v"(acc[0][0]), "v"(acc[0][1]), "v"(acc[1][0]), "v"(acc[1][1]));
        const int un = u + nb < 2048 ? u + nb : u;
        al.base = XB + (size_t)((un >> 4) * 128) * 1024; bl.base = W + (size_t)(P1_NT(un) * 128) * 1024;
        rvn = rinv[(un >> 4) * 128 + (tid & 127)];
        g_prefetch<0>(GREGS_P, al, bl, 16);
        if (GPV == 0) route_tile(p, l, mt, nt, [=](int r, int c) { return sC[r * 128 + c] * sRV[r]; });
        __syncthreads();
        TSTOP(2);
    }
}

struct RowLoaderRot {
    const bf* base; size_t ld;
    DI uint4 load(int i, int kt) const { return *(const uint4*)(base + (size_t)(32 * i) * ld + ((kt + 10) & 15) * 64); }
};
struct MlaScale {
    const float* sRN; int rowbase;
    DI void operator()(f32x16 (&acc)[2][2], int kt) const {
        if (kt != 5) return;
#pragma unroll
        for (int mi = 0; mi < 2; ++mi)
#pragma unroll
            for (int r = 0; r < 16; ++r) {
                const float sc = sRN[rowbase + mi * 32 + (r & 3) + 8 * (r >> 2)];
                acc[mi][0][r] *= sc; acc[mi][1][r] *= sc;
            }
    }
};
DI void ph_p4(const Params& p, int l, int bid, int nb, unsigned char* smem) {
    const int tid = tidx(), lane = tid & 63, wv = tid >> 6, wr = wv >> 1, h = lane >> 5;
    if (bid == 0 && tid < 32) WSP(int, OFF_CTL)[CTL_CNT + tid * 32] = 0;
    const bf* MIX = WSP(bf, OFF_MIX) + (size_t)(tid >> 3) * 1024 + (tid & 7) * 8;
    const bf* W = WSP(bf, OFF_WOUT) + (size_t)l * 1024 * 1024 + (size_t)(tid >> 3) * 1024 + (tid & 7) * 8;
    const float* xin = l == 0 ? p.in[I_X] : WSP(float, OFF_XFA);
    float* x1p = X1PTR(l);
    const float* g2 = p.in[I_N2G] + l * 1024;
    bf* xb1 = WSP(bf, OFF_XB);
    float* sC = (float*)smem; float* sRN = (float*)(smem + G_OFF_AUX);
    if (bid >= 1024) return;
    GREGS;
    RowLoaderRot al{MIX + (size_t)((bid >> 3) * 128) * 1024, 1024}, bl{W + (size_t)((bid & 7) * 128) * 1024, 1024};
    float4 sqa; float2 sqb;
    { const float* sq = WSP(float, OFF_SSQM) + (size_t)((bid >> 3) * 128 + (tid & 127)) * 8; sqa = *(const float4*)sq; sqb = *(const float2*)(sq + 4); }
    g_prefetch<0>(GREGS_P, al, bl, 16);
    for (int u = bid; u < 1024; u += nb) {
        const int mt = u >> 3, nt = u & 7;
        if (tid < 128) sRN[tid] = rsqrtf((sqa.x + sqa.y + sqa.z + sqa.w + sqb.x + sqb.y) * (1.f / 384.f) + EPS);
        f32x16 acc[2][2];
        acc_zero(acc);
        gemm_run<0>(acc, 16, al, bl, smem, GREGS_P, MlaScale{sRN, wr * 64 + 4 * h});
        acc_stage(acc, sC);
        const int un = u + nb < 1024 ? u + nb : u;
        al.base = MIX + (size_t)((un >> 3) * 128) * 1024; bl.base = W + (size_t)((un & 7) * 128) * 1024;
        { const float* sq = WSP(float, OFF_SSQM) + (size_t)((un >> 3) * 128 + (tid & 127)) * 8; sqa = *(const float4*)sq; sqb = *(const float2*)(sq + 4); }
        g_prefetch<0>(GREGS_P, al, bl, 16);
        const float4 ga = *(const float4*)(g2 + nt * 128 + (tid & 15) * 8), gb = *(const float4*)(g2 + nt * 128 + (tid & 15) * 8 + 4);
#pragma unroll 4
        for (int it = 0; it < 8; ++it) {
            const int id = it * 256 + tid, r = id >> 4, c8 = (id & 15) * 8;
            const size_t o = (size_t)(mt * 128 + r) * 1024 + nt * 128 + c8;
            const float4 x0 = *(const float4*)(xin + o), x1 = *(const float4*)(xin + o + 4);
            const float4 c0 = *(const float4*)(sC + r * 128 + c8), c1 = *(const float4*)(sC + r * 128 + c8 + 4);
            float v[8] = {x0.x + c0.x, x0.y + c0.y, x0.z + c0.z, x0.w + c0.w, x1.x + c1.x, x1.y + c1.y, x1.z + c1.z, x1.w + c1.w};
            *(float4*)(x1p + o) = make_float4(v[0], v[1], v[2], v[3]);
            *(float4*)(x1p + o + 4) = make_float4(v[4], v[5], v[6], v[7]);
            float ss = 0.f;
#pragma unroll
            for (int j = 0; j < 8; ++j) ss += v[j] * v[j];
            ss += __shfl_xor(ss, 1); ss += __shfl_xor(ss, 2); ss += __shfl_xor(ss, 4); ss += __shfl_xor(ss, 8);
            if ((id & 15) == 0) WSP(float, OFF_SSQ2)[(size_t)(mt * 128 + r) * 8 + nt] = ss;
            const float gg[8] = {ga.x, ga.y, ga.z, ga.w, gb.x, gb.y, gb.z, gb.w};
#pragma unroll
            for (int j = 0; j < 8; ++j) v[j] *= gg[j];
            store8(xb1 + o, v);
        }
        __syncthreads();
    }
}

DI void ph_router_fast(const Params& p, int l, int bid, int nb, unsigned char* smem) {
    const int tid = tidx(), lane = tid & 63, w = tid >> 6, r31 = lane & 31, h = lane >> 5;
    const bf* WR = WSP(bf, OFF_WR) + (size_t)l * 64 * 1024;
    const bf* XB = WSP(bf, OFF_XB);
    float* sP = (float*)smem;
    int* cnt = WSP(int, OFF_CTL) + CTL_CNT;
    int* list = WSP(int, OFF_LIST);
    float* gatew = WSP(float, OFF_GATEW);
    for (int u = bid; u < NT / 32; u += nb) {
        const int t0 = u * 32;
        f32x16 acc[2];
#pragma unroll
        for (int mi = 0; mi < 2; ++mi)
#pragma unroll
            for (int r = 0; r < 16; ++r) acc[mi][r] = 0.f;
        const bf* xa = XB + (size_t)(t0 + r31) * 1024 + w * 256 + 8 * h;
        const bf* wa = WR + (size_t)r31 * 1024 + w * 256 + 8 * h;
#pragma unroll 4
        for (int ks = 0; ks < 16; ++ks) {
            const bf16x8 xb = *(const bf16x8*)(xa + 16 * ks);
            const bf16x8 a0 = *(const bf16x8*)(wa + 16 * ks), a1 = *(const bf16x8*)(wa + 32 * 1024 + 16 * ks);
            acc[0] = MFMA32(a0, xb, acc[0]);
            acc[1] = MFMA32(a1, xb, acc[1]);
        }
#pragma unroll
        for (int mi = 0; mi < 2; ++mi)
#pragma unroll
            for (int r = 0; r < 16; ++r) sP[(w * 64 + mi * 32 + (r & 3) + 8 * (r >> 2) + 4 * h) * 33 + r31] = acc[mi][r];
        __syncthreads();
        if (tid < 32) {
            const int t = t0 + tid;
            const float* sq = WSP(float, OFF_SSQ2) + (size_t)t * 8;
            const float rinv = rsqrtf((sq[0] + sq[1] + sq[2] + sq[3] + sq[4] + sq[5] + sq[6] + sq[7]) * (1.f / 1024.f) + EPS);
            float lg[4];
#pragma unroll
            for (int j = 0; j < 4; ++j) lg[j] = (sP[j * 33 + tid] + sP[(64 + j) * 33 + tid] + sP[(128 + j) * 33 + tid] + sP[(192 + j) * 33 + tid]) * rinv + p.in[I_RGB][l * 4 + j];
            int g = 0; float gm = lg[0];
#pragma unroll
            for (int j = 1; j < 4; ++j) if (lg[j] > gm) { gm = lg[j]; g = j; }
            float gs = 0.f;
#pragma unroll
            for (int j = 0; j < 4; ++j) gs += __expf(lg[j] - gm);
            const float pg_top = 1.f / gs;
            float e[8];
#pragma unroll
            for (int j = 0; j < 8; ++j) {
                const int jj = 4 + g * 8 + j;
                e[j] = (sP[jj * 33 + tid] + sP[(64 + jj) * 33 + tid] + sP[(128 + jj) * 33 + tid] + sP[(192 + jj) * 33 + tid]) * rinv + p.in[I_REB][l * 32 + g * 8 + j];
            }
            int i1 = 0; float v1 = e[0];
#pragma unroll
            for (int i = 1; i < 8; ++i) if (e[i] > v1) { v1 = e[i]; i1 = i; }
            int i2 = -1; float v2 = -INFINITY;
#pragma unroll
            for (int i = 0; i < 8; ++i) if (i != i1 && e[i] > v2) { v2 = e[i]; i2 = i; }
            const float p2 = __expf(v2 - v1);
            const float g1 = pg_top / (1.f + p2), g2 = pg_top * p2 / (1.f + p2);
            const int e1 = g * 8 + i1, e2 = g * 8 + i2;
            int* sCnt = (int*)(smem + 40960); int* sBase = sCnt + 32;
            sCnt[tid] = 0;
            const int rk1 = atomicAdd(&sCnt[e1], 1);
            const int rk2 = atomicAdd(&sCnt[e2], 1);
            const int mine = sCnt[tid];
            if (mine > 0) sBase[tid] = atomicAdd(&cnt[tid * 32], mine);
            list[e1 * 16384 + sBase[e1] + rk1] = t * 2;
            list[e2 * 16384 + sBase[e2] + rk2] = t * 2 + 1;
            gatew[t * 2] = g1; gatew[t * 2 + 1] = g2;
            WSP(float, OFF_RINV2)[t] = rinv;
        }
        __syncthreads();
    }
}

DI void moe_sched_init(const Params& p, int* aux) {
    if (tidx() == 0) {
        const int* cnt = WSP(int, OFF_CTL) + CTL_CNT;
        int rb = 0, base = 0;
        for (int e = 0; e < 32; ++e) { const int c = cnt[e * 32]; aux[e] = c; aux[32 + e] = rb; aux[65 + e] = base; rb += (c + 127) >> 7; base += c; }
        aux[64] = rb; aux[97] = base;
    }
    __syncthreads();
}
struct MoeUnit { int e, base; };
DI MoeUnit moe_unit(const Params& p, const int* aux, int rbg, int* sEnt, int which) {
    int e = 0;
    while (aux[33 + e] <= rbg) ++e;
    const int rb = rbg - aux[32 + e];
    const int n = aux[e] - rb * 128;
    if (tidx() < 128) {
        const int en = (int)tidx() < n ? WSP(int, OFF_LIST)[e * 16384 + rb * 128 + tidx()] : -1;
        sEnt[tidx()] = en;
        ((float*)sEnt)[128 + tidx()] = en >= 0 ? (which ? WSP(float, OFF_GATEW)[en] : WSP(float, OFF_RINV2)[en >> 1]) : 0.f;
    }
    __syncthreads();
    MoeUnit mu; mu.e = e; mu.base = aux[65 + e] + rb * 128;
    return mu;
}
DI GatherLoader moe_up_aload(const Params& p, const int* sEnt) {
    const int tid = tidx();
    GatherLoader al;
#pragma unroll
    for (int i = 0; i < 4; ++i) { const int en = sEnt[(tid >> 3) + 32 * i]; al.rp[i] = en >= 0 ? WSP(bf, OFF_XB) + (size_t)(en >> 1) * 1024 + (tid & 7) * 8 : nullptr; }
    return al;
}
DI TrLoaderBf moe_up_bload(const Params& p, int l, int e, int q) {
    const int tid = tidx(), n8 = tid & 15;
    return TrLoaderBf{EWPTR(l) + (n8 < 8 ? 0 : EW_W3) + (size_t)e * 262144 + (size_t)(tid >> 4) * 256 + q * 64 + (n8 & 7) * 8, 256};
}

DI void ph_moe_up(const Params& p, int l, int bid, int nb, unsigned char* smem) {
    const int tid = tidx();
    int* aux = (int*)(smem + G_OFF_AUX); int* sEnt0 = aux + 128;
    float* sC = (float*)smem;
    moe_sched_init(p, aux);
    const int units = aux[64] * 4;
    bf* ACT = WSP(bf, OFF_ACT);
    if (bid >= units) return;
    GREGS;
    int par = 0;
    MoeUnit mu = moe_unit(p, aux, bid >> 2, sEnt0, 0);
    GatherLoader al = moe_up_aload(p, sEnt0);
    TrLoaderBf bl = moe_up_bload(p, l, mu.e, bid & 3);
    g_prefetch<2>(GREGS_P, al, bl, 16);
    for (int u = bid; u < units; u += nb) {
        const int q = u & 3;
        const int* sEnt = sEnt0 + par * 256;
        f32x16 acc[2][2];
        acc_zero(acc);
        gemm_run<2>(acc, 16, al, bl, smem, GREGS_P, NoMid());
        acc_stage(acc, sC);
        const int un = u + nb < units ? u + nb : u;
        int* sEntN = sEnt0 + (par ^ 1) * 256;
        const MoeUnit mun = moe_unit(p, aux, un >> 2, sEntN, 0);
        al = moe_up_aload(p, sEntN); bl = moe_up_bload(p, l, mun.e, un & 3);
        g_prefetch<2>(GREGS_P, al, bl, 16);
#pragma unroll 2
        for (int it = 0; it < 4; ++it) {
            const int id = it * 256 + tid, r = id >> 3, c8 = (id & 7) * 8;
            const int en = sEnt[r];
            if (en >= 0) {
                const float rs = ((const float*)sEnt)[128 + r];
                float v[8];
#pragma unroll
                for (int j = 0; j < 8; ++j) { const float a = sC[r * 128 + c8 + j] * rs, b = sC[r * 128 + 64 + c8 + j] * rs; v[j] = a * sigmoidf_(a) * b; }
                store8(ACT + (size_t)(mu.base + r) * 256 + q * 64 + c8, v);
            }
        }
        __syncthreads();
        mu = mun; par ^= 1;
    }
}

DI void ph_moe_down(const Params& p, int l, int bid, int nb, unsigned char* smem) {
    const int tid = tidx();
    int* aux = (int*)(smem + G_OFF_AUX); int* sEnt0 = aux + 128;
    float* sC = (float*)smem;
    moe_sched_init(p, aux);
    const int units = aux[64] * 8;
    const bf* ACT = WSP(bf, OFF_ACT) + (size_t)(tid >> 3) * 256 + (tid & 7) * 8;
    const bf* W2 = EWPTR(l) + EW_W2 + (size_t)(tid >> 4) * 1024 + (tid & 15) * 8;
    bf* Y = WSP(bf, OFF_Y);
    if (bid >= units) return;
    GREGS;
    int par = 0;
    MoeUnit mu = moe_unit(p, aux, bid >> 3, sEnt0, 1);
    RowLoader al{ACT + (size_t)mu.base * 256, 256};
    TrLoaderBf bl{W2 + (size_t)mu.e * 262144 + (bid & 7) * 128, 1024};
    g_prefetch<2>(GREGS_P, al, bl, 4);
    for (int u = bid; u < units; u += nb) {
        const int nt = u & 7;
        const int* sEnt = sEnt0 + par * 256;
        f32x16 acc[2][2];
        acc_zero(acc);
        gemm_run<2>(acc, 4, al, bl, smem, GREGS_P, NoMid());
        acc_stage(acc, sC);
        const int un = u + nb < units ? u + nb : u;
        const MoeUnit mun = moe_unit(p, aux, un >> 3, sEnt0 + (par ^ 1) * 256, 1);
        al.base = ACT + (size_t)mun.base * 256; bl.base = W2 + (size_t)mun.e * 262144 + (un & 7) * 128;
        g_prefetch<2>(GREGS_P, al, bl, 4);
#pragma unroll 2
        for (int it = 0; it < 8; ++it) {
            const int id = it * 256 + tid, r = id >> 4, c8 = (id & 15) * 8;
            const int en = sEnt[r];
            if (en >= 0) {
                const float gw = ((const float*)sEnt)[128 + r];
                float v[8];
#pragma unroll
                for (int j = 0; j < 8; ++j) v[j] = sC[r * 128 + c8 + j] * gw;
                store8(Y + ((size_t)(en & 1) * NT + (en >> 1)) * 1024 + nt * 128 + c8, v);
            }
        }
        __syncthreads();
        mu = mun; par ^= 1;
    }
}

template <bool ISQ>
DI void mla_up_rms(const Params& p, int t0, float* sRN) {
    constexpr int KD = ISQ ? 192 : 128, NCH = KD / 16;
    const int tid = tidx(), r = tid >> 1, half = tid & 1;
    const uint4* src = (const uint4*)((ISQ ? WSP(bf, OFF_CQ) : WSP(bf, OFF_CKV)) + (size_t)(t0 + r) * KD + half * (KD / 2));
    uint4 v[NCH];
#pragma unroll
    for (int i = 0; i < NCH; ++i) v[i] = src[i];
    float ss = 0.f;
#pragma unroll
    for (int i = 0; i < NCH; ++i) { const unsigned w[4] = {v[i].x, v[i].y, v[i].z, v[i].w};
#pragma unroll
        for (int e = 0; e < 4; ++e) { const float a = lo16(w[e]), c = hi16(w[e]); ss += a * a + c * c; } }
    ss += __shfl_xor(ss, 1);
    if (!half) sRN[r] = rsqrtf(ss * (1.f / (float)KD) + EPS);
}
DI void acc_stage132(const f32x16 (&acc)[2][2], float* sC) {
    const int lane = tidx() & 63, wv = tidx() >> 6, wr = wv >> 1, wc = wv & 1, r31 = lane & 31, h = lane >> 5;
#pragma unroll
    for (int mi = 0; mi < 2; ++mi)
#pragma unroll
        for (int ni = 0; ni < 2; ++ni)
#pragma unroll
            for (int r = 0; r < 16; ++r)
                sC[(wr * 64 + mi * 32 + (r & 3) + 8 * (r >> 2) + 4 * h) * 132 + wc * 64 + ni * 32 + r31] = acc[mi][ni][r];
    __syncthreads();
}
template <bool ISQ>
DI void mla_up_epi(const Params& p, int l, int mt, int hd, const float* sC, const float* sRN, float* sPart) {
    const int tid = tidx(), r = tid & 127, hh = tid >> 7;
    const int t0 = mt * 128, b = t0 >> 12, s0 = t0 & 4095, t = t0 + r;
    const float* gain = (ISQ ? p.in[I_MQG] : p.in[I_MKG]) + l * 96;
    const float rl = sRN[r];
    const float* row = sC + r * 132;
    bf* dst = WSP(bf, ISQ ? OFF_MQ : OFF_MK) + ((size_t)(b * 6 + hd) * S + s0 + r) * 96;
    float v[64];
    float4 cs4[4], sn4[4];
    float ss = 0.f;
    if (hh == 0) {
#pragma unroll
        for (int i = 0; i < 16; ++i) { const float4 a = *(const float4*)(row + 4 * i); v[4 * i] = a.x * rl; v[4 * i + 1] = a.y * rl; v[4 * i + 2] = a.z * rl; v[4 * i + 3] = a.w * rl; }
#pragma unroll
        for (int i = 0; i < 64; ++i) ss += v[i] * v[i];
    } else {
        const float* rp_ = WSP(float, OFF_ROPE) + (size_t)(s0 + r) * 32;
#pragma unroll
        for (int i = 0; i < 4; ++i) { cs4[i] = *(const float4*)(rp_ + 4 * i); sn4[i] = *(const float4*)(rp_ + 16 + 4 * i); }
        if (ISQ) {
#pragma unroll
            for (int i = 0; i < 8; ++i) { const float4 a = *(const float4*)(row + 64 + 4 * i); v[4 * i] = a.x * rl; v[4 * i + 1] = a.y * rl; v[4 * i + 2] = a.z * rl; v[4 * i + 3] = a.w * rl; }
        } else {
            const uint4* kr = (const uint4*)(WSP(bf, OFF_KR) + (size_t)t * 32);
#pragma unroll
            for (int i = 0; i < 4; ++i) { const uint4 k = kr[i]; v[8 * i] = lo16(k.x); v[8 * i + 1] = hi16(k.x); v[8 * i + 2] = lo16(k.y); v[8 * i + 3] = hi16(k.y);
                                          v[8 * i + 4] = lo16(k.z); v[8 * i + 5] = hi16(k.z); v[8 * i + 6] = lo16(k.w); v[8 * i + 7] = hi16(k.w); }
        }
#pragma unroll
        for (int i = 0; i < 32; ++i) ss += v[i] * v[i];
    }
    sPart[hh * 128 + r] = ss;
    __syncthreads();
    const float rn = rsqrtf((ss + sPart[(hh ^ 1) * 128 + r]) * (1.f / 96.f) + EPS);
    if (hh == 0) {
#pragma unroll
        for (int c = 0; c < 8; ++c) {
            const float4 g0 = *(const float4*)(gain + 8 * c), g1 = *(const float4*)(gain + 8 * c + 4);
            float o[8] = {v[8 * c] * rn * g0.x, v[8 * c + 1] * rn * g0.y, v[8 * c + 2] * rn * g0.z, v[8 * c + 3] * rn * g0.w,
                          v[8 * c + 4] * rn * g1.x, v[8 * c + 5] * rn * g1.y, v[8 * c + 6] * rn * g1.z, v[8 * c + 7] * rn * g1.w};
            store8(dst + 8 * c, o);
        }
    } else {
        const float cs[16] = {cs4[0].x, cs4[0].y, cs4[0].z, cs4[0].w, cs4[1].x, cs4[1].y, cs4[1].z, cs4[1].w, cs4[2].x, cs4[2].y, cs4[2].z, cs4[2].w, cs4[3].x, cs4[3].y, cs4[3].z, cs4[3].w};
        const float sn[16] = {sn4[0].x, sn4[0].y, sn4[0].z, sn4[0].w, sn4[1].x, sn4[1].y, sn4[1].z, sn4[1].w, sn4[2].x, sn4[2].y, sn4[2].z, sn4[2].w, sn4[3].x, sn4[3].y, sn4[3].z, sn4[3].w};
        float o[32];
#pragma unroll
        for (int i = 0; i < 16; ++i) {
            const float x1 = v[i] * rn * gain[64 + i], x2 = v[16 + i] * rn * gain[80 + i];
            o[i] = x1 * cs[i] - x2 * sn[i]; o[16 + i] = x1 * sn[i] + x2 * cs[i];
        }
#pragma unroll
        for (int c = 0; c < 4; ++c) store8(dst + 64 + 8 * c, o + 8 * c);
    }
    if (!ISQ) {
        bf* mvt = WSP(bf, OFF_MVT);
#pragma unroll 2
        for (int it = 0; it < 4; ++it) {
            const int id = it * 256 + tid, c = id & 63, rc = id >> 6;
            float v[8];
#pragma unroll
            for (int jj = 0; jj < 8; ++jj) v[jj] = sC[(8 * rc + jj) * 132 + 64 + c] * sRN[8 * rc + jj];
            store8(mvt + ((size_t)(b * 6 + hd) * 64 + c) * S + s0 + 8 * rc, v);
        }
    }
}
DI void mla_up_loaders(const Params& p, int l, int u, RowLoader& al, RowLoader& bl) {
    const int tid = tidx(), mt = u / 12, j = u % 12;
    if (j < 6) {
        al = RowLoader{WSP(bf, OFF_CQ) + (size_t)(mt * 128 + (tid >> 3)) * 192 + (tid & 7) * 8, 192};
        bl = RowLoader{WSP(bf, OFF_WUQ) + (size_t)l * 768 * 192 + (size_t)(j * 128 + (tid >> 3)) * 192 + (tid & 7) * 8, 192};
    } else {
        al = RowLoader{WSP(bf, OFF_CKV) + (size_t)(mt * 128 + (tid >> 3)) * 128 + (tid & 7) * 8, 128};
        bl = RowLoader{WSP(bf, OFF_WUKV) + (size_t)l * 768 * 128 + (size_t)((j - 6) * 128 + (tid >> 3)) * 128 + (tid & 7) * 8, 128};
    }
}
DI void lru_tile_fast(const Params& p, int l, int b, int tile, int mode, unsigned char* smem) {
    const int tid = tidx(), c = tid, lane = tid & 63, n = tid >> 6, r31 = lane & 31, h = lane >> 5;
    unsigned char* sXC = smem; float* sA = (float*)(smem + 16384); bf* sG = (bf*)(smem + 49152);
    const bf* LX = WSP(bf, OFF_LX); const bf* GGp = WSP(bf, OFF_GG);
    const float cw0 = p.in[I_CONVW][(l * 4 + 0) * 256 + c], cw1 = p.in[I_CONVW][(l * 4 + 1) * 256 + c], cw2 = p.in[I_CONVW][(l * 4 + 2) * 256 + c],
                cw3 = p.in[I_CONVW][(l * 4 + 3) * 256 + c], cb = p.in[I_CONVB][l * 256 + c];
    float gba[2], gbx[2], gc8[2];
#pragma unroll
    for (int ni = 0; ni < 2; ++ni) {
        const int ch = 64 * n + 32 * ni + r31;
        gba[ni] = p.in[I_BA][l * 256 + ch]; gbx[ni] = p.in[I_BX][l * 256 + ch];
        gc8[ni] = 8.f * log1pf(__expf(-p.in[I_LAM][l * 256 + ch]));
    }
    bf16x8 wb[2][2][4];
#pragma unroll
    for (int g = 0; g < 2; ++g)
#pragma unroll
        for (int ni = 0; ni < 2; ++ni)
#pragma unroll
            for (int ks = 0; ks < 4; ++ks)
                wb[g][ni][ks] = *(const bf16x8*)(WSP(bf, OFF_WAX) + (size_t)(((l * 2 + g) * 4 + n) * 64 + 32 * ni + r31) * 64 + 16 * ks + 8 * h);
    const int tb = b * S + tile * 64;
    float xm3 = 0.f, xm2 = 0.f, xm1 = 0.f;
    if (tile > 0) { xm3 = bf2f(LX[(size_t)(tb - 3) * 256 + c]); xm2 = bf2f(LX[(size_t)(tb - 2) * 256 + c]); xm1 = bf2f(LX[(size_t)(tb - 1) * 256 + c]); }
    float hs = 0.f, aprod = 1.f;
    if (mode == 1) {
        const float* TOT = WSP(float, OFF_TOT) + (size_t)(b * 64) * 512;
#pragma unroll 8
        for (int i = 0; i < tile; ++i) hs = TOT[i * 512 + c] * hs + TOT[i * 512 + 256 + c];
    }
    const int xoff = (c & 7) * 2, xch = (c & 63) >> 3;
#pragma unroll 1
    for (int half = 0; half < 2; ++half) {
        const int t0 = tb + half * 32;
        float xc[32];
#pragma unroll
        for (int t = 0; t < 32; ++t) {
            const float x0 = bf2f(LX[(size_t)(t0 + t) * 256 + c]);
            xc[t] = cw0 * xm3 + cw1 * xm2 + cw2 * xm1 + cw3 * x0 + cb;
            xm3 = xm2; xm2 = xm1; xm1 = x0;
            *(bf*)(sXC + (n * 32 + t) * 128 + ((xch ^ ((t >> 1) & 7)) << 4) + xoff) = f2bf(xc[t]);
        }
        __syncthreads();
        f32x16 acc[2][2];
#pragma unroll
        for (int g = 0; g < 2; ++g)
#pragma unroll
            for (int ni = 0; ni < 2; ++ni)
#pragma unroll
                for (int r = 0; r < 16; ++r) acc[g][ni][r] = 0.f;
#pragma unroll
        for (int ks = 0; ks < 4; ++ks) {
            const bf16x8 a = *(const bf16x8*)(sXC + (n * 32 + r31) * 128 + (((2 * ks + h) ^ ((r31 >> 1) & 7)) << 4));
#pragma unroll
            for (int g = 0; g < 2; ++g)
#pragma unroll
                for (int ni = 0; ni < 2; ++ni) acc[g][ni] = MFMA32(a, wb[g][ni][ks], acc[g][ni]);
        }
#pragma unroll
        for (int ni = 0; ni < 2; ++ni)
#pragma unroll
            for (int r = 0; r < 16; ++r) {
                const int t = (r & 3) + 8 * (r >> 2) + 4 * h, ch = 64 * n + 32 * ni + r31;
                const float rg = sigmoidf_(acc[0][ni][r] + gba[ni]), ig = sigmoidf_(acc[1][ni][r] + gbx[ni]);
                const float la = -gc8[ni] * rg, y = 2.f * la;
                const float av = __expf(la);
                const float em = y > -0.3f ? y * (1.f + y * (0.5f + y * (0.16666667f + y * 0.041666668f))) : av * av - 1.f;
                sA[t * 256 + ch] = av;
                sG[t * 256 + ch] = f2bf(sqrtf(fmaxf(-em, 0.f)) * ig);
            }
        __syncthreads();
#pragma unroll
        for (int t = 0; t < 32; ++t) {
            const float a = sA[t * 256 + c];
            hs = a * hs + bf2f(sG[t * 256 + c]) * xc[t];
            aprod *= a;
            if (mode == 1) sA[t * 256 + c] = hs * bf2f(GGp[(size_t)(t0 + t) * 256 + c]);
        }
        __syncthreads();
        if (mode == 1) {
            bf* MIX = WSP(bf, OFF_MIX);
#pragma unroll 1
            for (int q = 0; q < 8; ++q) {
                const int t = n * 8 + q;
                const float4 y = *(const float4*)(sA + t * 256 + 4 * lane);
                const float rn = rsqrtf(wave_sum(y.x * y.x + y.y * y.y + y.z * y.z + y.w * y.w) * (1.f / 256.f) + EPS);
                uint2 pk; pk.x = pack2(y.x * rn, y.y * rn); pk.y = pack2(y.z * rn, y.w * rn);
                *(uint2*)(MIX + (size_t)(t0 + t) * 1024 + 4 * lane) = pk;
            }
            __syncthreads();
        }
    }
    if (mode == 0) {
        float* TOT = WSP(float, OFF_TOT) + (size_t)(b * 64 + tile) * 512;
        TOT[c] = aprod; TOT[256 + c] = hs;
    }
}

DI void ph_lru(const Params& p, int l, int mode, int bid, int nb, unsigned char* smem) {
    float* sXC = (float*)smem; float* sY = sXC + 16 * 256;
    for (int u = bid; u < 256; u += nb) lru_tile_fast(p, l, u >> 6, u & 63, mode, smem);
}


DI int pi_row(int r) { return (r & 0x13) | ((r & 4) << 1) | ((r & 8) >> 1); }
DI float fexp2(float x) { return __builtin_amdgcn_exp2f(x); }
DI float xhalf_max(float x) {
    const auto r = __builtin_amdgcn_permlane32_swap(__float_as_uint(x), __float_as_uint(x), false, false);
    return fmaxf(__uint_as_float(r[0]), __uint_as_float(r[1]));
}


template <int KD>
DI void att_issue(uint4& k0r, uint4& k1r, uint4& k2r, uint4& v0r, uint4& v1r, const bf* Kg, const bf* Vg, int j) {
    const int tid = tidx(), k0 = j * 64;
    const bf* src = Kg + (size_t)k0 * KD + tid * 8;
    k0r = *(const uint4*)(src);
    if (KD == 96) { k1r = *(const uint4*)(src + 2048); k2r = *(const uint4*)(src + 4096); }
    const bf* vs = Vg + (size_t)(tid >> 3) * S + k0 + (tid & 7) * 8;
    v0r = *(const uint4*)(vs); v1r = *(const uint4*)(vs + (size_t)32 * S);
}
template <int KD>
DI void att_commit(const uint4& k0r, const uint4& k1r, const uint4& k2r, const uint4& v0r, const uint4& v1r, unsigned char* base) {
    constexpr int KRS = KD == 96 ? 208 : 80, KOFF_V = 64 * KRS;
    const int tid = tidx();
    if (KD == 96) {
        const int i0 = tid, i1 = tid + 256, i2 = tid + 512;
        *(uint4*)(base + (i0 / 12) * 208 + (i0 % 12) * 16) = k0r;
        *(uint4*)(base + (i1 / 12) * 208 + (i1 % 12) * 16) = k1r;
        *(uint4*)(base + (i2 / 12) * 208 + (i2 % 12) * 16) = k2r;
    } else {
        *(uint4*)(base + (tid >> 2) * 80 + (tid & 3) * 16) = k0r;
    }
    const int d = tid >> 3, ch = tid & 7;
    const int voff = KOFF_V + d * 128 + ((ch ^ ((d >> 1) & 7)) << 4);
    *(uint4*)(base + voff) = v0r;
    *(uint4*)(base + voff + 4096) = v1r;
}

template <int KD, bool BIAS, int VAR, bool FIXED>
DI void attn_tile(const unsigned char* base, bool diag, float T, float slc, const bf16x8 (&qf)[KD / 16], f32x16 (&O)[2], float& mrun, float& lrun,
                  int krow, int vsw, int w, int r31, int h) {
    constexpr int KRS = KD == 96 ? 208 : 80, KOFF_V = 64 * KRS, NKS = KD / 16;
    constexpr float C = (KD == 96 ? 0.10206207261596575f : 0.17677669529663687f) * 1.4426950408889634f;
    TSTART(54);
    f32x16 sc[2];
    bf16x8 kf[2][NKS];
#pragma unroll
    for (int kb2 = 0; kb2 < 2; ++kb2) {
#pragma unroll
        for (int r = 0; r < 16; ++r) sc[kb2][r] = 0.f;
#pragma unroll
        for (int ks = 0; ks < NKS; ++ks) kf[kb2][ks] = *(const bf16x8*)(base + kb2 * 32 * KRS + krow + ks * 32);
    }
    __builtin_amdgcn_sched_barrier(0);
    if (VAR != 4) {
#pragma unroll
    for (int ks = 0; ks < NKS; ++ks)
#pragma unroll
        for (int kb2 = 0; kb2 < 2; ++kb2) sc[kb2] = MFMA32(kf[kb2][ks], qf[ks], sc[kb2]);
    } else { asm volatile("" :: "v"(kf[0][0]), "v"(kf[1][NKS - 1])); }
    bf16x8 vf[2][4];
#pragma unroll
    for (int db = 0; db < 2; ++db)
#pragma unroll
        for (int s4 = 0; s4 < 4; ++s4) vf[db][s4] = *(const bf16x8*)(base + KOFF_V + (32 * db + r31) * 128 + (((2 * s4 + h) ^ vsw) << 4));
    __builtin_amdgcn_sched_barrier(0);
    asm volatile("" : "+v"(sc[0]), "+v"(sc[1]));
    TSTOP(54);
    TSTART(55);
    if (BIAS) {
        if (!diag) {
            const float slh = bf2f(f2bf(slc));
            const unsigned bw = h ? 0u : pack2(slh, slc - slh);
            const bf16x8 bb = __builtin_bit_cast(bf16x8, make_uint4(bw, 0u, 0u, 0u));
#pragma unroll
            for (int kb2 = 0; kb2 < 2; ++kb2) {
                const float klf = (float)(32 * kb2 + pi_row(r31));
                const unsigned aw = h ? 0u : pack2(klf, klf);
                sc[kb2] = MFMA32(__builtin_bit_cast(bf16x8, make_uint4(aw, 0u, 0u, 0u)), bb, sc[kb2]);
            }
        } else {
            const int ql2 = 2 * ((w & 1) * 32 + r31);
#pragma unroll
            for (int kb2 = 0; kb2 < 2; ++kb2)
#pragma unroll
                for (int r = 0; r < 16; ++r) {
                    const int kl = 32 * kb2 + 16 * (r >> 3) + 8 * h + (r & 7);
                    sc[kb2][r] = fmaf(slc, (float)min(kl, ql2 - kl), sc[kb2][r]);
                }
        }
    }
    float mx = sc[0][0];
    if (VAR != 1 && !FIXED) {
#pragma unroll
    for (int kb2 = 0; kb2 < 2; ++kb2)
#pragma unroll
        for (int r = 0; r < 16; ++r) mx = fmaxf(mx, sc[kb2][r]);
    mx = xhalf_max(mx);
    }
    const float mnew = (VAR == 1 || FIXED) ? mrun : fmaxf(mrun, mx * C + T);
    const float alpha = (VAR == 1 || FIXED) ? 1.f : fexp2(mrun - mnew), off = T - mnew;
    float ls = 0.f;
    bf16x8 pf[4];
#pragma unroll
    for (int kb2 = 0; kb2 < 2; ++kb2)
#pragma unroll
        for (int s2 = 0; s2 < 2; ++s2) {
            float pv[8];
#pragma unroll
            for (int jj = 0; jj < 8; ++jj) { pv[jj] = VAR == 1 ? sc[kb2][8 * s2 + jj] : fexp2(fmaf(sc[kb2][8 * s2 + jj], C, off)); ls += pv[jj]; }
            uint4 pk; pk.x = pack2(pv[0], pv[1]); pk.y = pack2(pv[2], pv[3]); pk.z = pack2(pv[4], pv[5]); pk.w = pack2(pv[6], pv[7]);
            pf[2 * kb2 + s2] = __builtin_bit_cast(bf16x8, pk);
        }
    mrun = mnew; lrun = lrun * alpha + ls;
    asm volatile("" : "+v"(pf[0]), "+v"(pf[1]), "+v"(pf[2]), "+v"(pf[3]));
    TSTOP(55);
    TSTART(56);
    if (!FIXED) {
#pragma unroll
        for (int db = 0; db < 2; ++db)
#pragma unroll
            for (int r = 0; r < 16; ++r) O[db][r] *= alpha;
    }
    if (VAR != 4) {
#pragma unroll
    for (int s4 = 0; s4 < 4; ++s4)
#pragma unroll
        for (int db = 0; db < 2; ++db) O[db] = MFMA32(vf[db][s4], pf[s4], O[db]);
    } else { asm volatile("" :: "v"(vf[0][0]), "v"(vf[1][3]), "v"(pf[0]), "v"(pf[3])); }
    asm volatile("" : "+v"(O[0]), "+v"(O[1]));
    TSTOP(56);
}

template <int KD, bool BIAS, int VAR, bool FIXED>
DI void attn_pass(const bf* Kg, const bf* Vg, const bf* qrow, float sl2, float mfix, int qb, int jstart, unsigned char* smem, f32x16 (&O)[2], float& lsum) {
    constexpr int KRS = KD == 96 ? 208 : 80, KOFF_V = 64 * KRS, BUF = KOFF_V + 8192, NKS = KD / 16;
    constexpr float C = (KD == 96 ? 0.10206207261596575f : 0.17677669529663687f) * 1.4426950408889634f;
    const int tid = tidx(), lane = tid & 63, w = tid >> 6, r31 = lane & 31, h = lane >> 5;
    const int mychunk = 2 * qb + (w >> 1), nt = 2 * qb + 2;
    bf16x8 qf[NKS];
#pragma unroll
    for (int ks = 0; ks < NKS; ++ks) qf[ks] = *(const bf16x8*)(qrow + 16 * ks);
    float mrun = FIXED ? mfix + (BIAS ? sl2 * (float)((w & 1) * 32 + r31) : 0.f) : -1e30f, lrun = 0.f;
#pragma unroll
    for (int db = 0; db < 2; ++db)
#pragma unroll
        for (int r = 0; r < 16; ++r) O[db][r] = 0.f;
    uint4 ak0, ak1, ak2, av0, av1, bk0, bk1, bk2, bv0, bv1;
    ak1 = make_uint4(0, 0, 0, 0); ak2 = ak1; bk1 = ak1; bk2 = ak1;
    att_issue<KD>(ak0, ak1, ak2, av0, av1, Kg, Vg, jstart);
    att_issue<KD>(bk0, bk1, bk2, bv0, bv1, Kg, Vg, jstart + 1);
    att_commit<KD>(ak0, ak1, ak2, av0, av1, smem);
    __syncthreads();
    const int krow = pi_row(r31) * KRS + h * 16;
    const int vsw = (r31 >> 1) & 7;
    const float slc = sl2 * (1.f / C);
#pragma unroll 1
    for (int j = jstart; j < nt; j += 2) {
        TSTART(50);
        if (VAR != 2 && VAR != 3) att_issue<KD>(ak0, ak1, ak2, av0, av1, Kg, Vg, min(j + 2, nt - 1));
        __builtin_amdgcn_sched_barrier(0);
        TSTOP(50);
        TSTART(51);
        if (j <= mychunk) attn_tile<KD, BIAS, VAR, FIXED>(smem, j == mychunk, BIAS ? -sl2 * 64.f * (float)(mychunk - j) : 0.f, slc, qf, O, mrun, lrun, krow, vsw, w, r31, h);
        __builtin_amdgcn_sched_barrier(0);
        TSTOP(51);
        TSTART(52);
        if (VAR != 3) att_commit<KD>(bk0, bk1, bk2, bv0, bv1, smem + BUF);
        __builtin_amdgcn_sched_barrier(0);
        TSTOP(52);
        TSTART(53);
        __syncthreads();
        TSTOP(53);
        if (VAR != 2 && VAR != 3) att_issue<KD>(bk0, bk1, bk2, bv0, bv1, Kg, Vg, min(j + 3, nt - 1));
        if (j + 1 <= mychunk) attn_tile<KD, BIAS, VAR, FIXED>(smem + BUF, j + 1 == mychunk, BIAS ? -sl2 * 64.f * (float)(mychunk - j - 1) : 0.f, slc, qf, O, mrun, lrun, krow, vsw, w, r31, h);
        if (VAR != 3) att_commit<KD>(ak0, ak1, ak2, av0, av1, smem);
        __syncthreads();
    }
    lsum = lrun + __shfl_xor(lrun, 32);
}

DI void attn_store(const f32x16 (&o)[2], float osc, unsigned char* stg, bf* dst  ) {
    const int lane = tidx() & 63, r31 = lane & 31, h = lane >> 5;
#pragma unroll
    for (int db = 0; db < 2; ++db)
#pragma unroll
        for (int g = 0; g < 4; ++g) {
            uint2 pk; pk.x = pack2(o[db][4 * g] * osc, o[db][4 * g + 1] * osc); pk.y = pack2(o[db][4 * g + 2] * osc, o[db][4 * g + 3] * osc);
            *(uint2*)(stg + r31 * 144 + (32 * db + 8 * g + 4 * h) * 2) = pk;
        }
#pragma unroll
    for (int i = 0; i < 4; ++i) {
        const int id = lane + 64 * i, row = id >> 3, ch = id & 7;
        *(uint4*)(dst + (size_t)row * 1024 + ch * 8) = *(const uint4*)(stg + row * 144 + ch * 16);
    }
}
constexpr int ATT_STG = 2 * (64 * 208 + 8192);

template <int VAR>
DI void mla_unit(const Params& p, int l, int bh, int qb, unsigned char* smem) {
    const int lane = tidx() & 63, w = tidx() >> 6, r31 = lane & 31, h = lane >> 5;
    const int b = bh / 6, hd = bh % 6, q = qb * 128 + 32 * w + r31;
    f32x16 O[2]; float lsum;
    const float mfix = WSP(float, OFF_CTL)[CTL_LAM + 4 + l];
    const bf* Kp = WSP(bf, OFF_MK) + (size_t)bh * S * 96; const bf* Vp = WSP(bf, OFF_MVT) + (size_t)bh * 64 * S;
    const bf* Qp = WSP(bf, OFF_MQ) + ((size_t)bh * S + q) * 96 + 8 * h;
    if (mfix < 48.f) attn_pass<96, false, VAR, true>(Kp, Vp, Qp, 0.f, mfix, qb, 0, smem, O, lsum);
    else attn_pass<96, false, VAR, false>(Kp, Vp, Qp, 0.f, 0.f, qb, 0, smem, O, lsum);
    const float inv = 1.f / lsum;
    float ss = 0.f;
#pragma unroll
    for (int db = 0; db < 2; ++db)
#pragma unroll
        for (int r = 0; r < 16; ++r) { O[db][r] *= inv; ss += O[db][r] * O[db][r]; }
    ss += __shfl_xor(ss, 32);
    const int trow = b * S + qb * 128 + 32 * w;
    if (VAR == 0 && h == 0) WSP(float, OFF_SSQM)[(size_t)(trow + r31) * 8 + hd] = ss;
    attn_store(O, 1.f, smem + ATT_STG + w * (32 * 144), WSP(bf, VAR == 0 ? OFF_MIX : OFF_XB) + (size_t)trow * 1024 + 640 + hd * 64);
}

template <int VAR>
DI void diff_unit(const Params& p, int l, int bh, int qb, unsigned char* smem) {
    const int lane = tidx() & 63, w = tidx() >> 6, r31 = lane & 31, h = lane >> 5;
    const int b = bh / 6, hd = bh % 6, q = qb * 128 + 32 * w + r31;
    const float sl2 = exp2f(-8.f * (float)(hd + 1) / 6.f) * 1.4426950408889634f;
    const bf* Vg = WSP(bf, OFF_DVT) + (size_t)bh * 64 * S;
    const float smax2 = WSP(float, OFF_CTL)[CTL_LAM + 2 + l];
    const int ncut = (int)((160.f + 2.f * smax2) / (sl2 * 64.f)) + 2;
    const int jstart = max(0, 2 * qb - ncut) & ~1;
    f32x16 O1[2]; float l1;
    unsigned o0p[16];
    {
        float l0;
        const bf* Kp = WSP(bf, OFF_DK) + (size_t)(bh * 2) * S * 32; const bf* Qp = WSP(bf, OFF_DQ) + ((size_t)(bh * 2) * S + q) * 32 + 8 * h;
        if (smax2 < 48.f) attn_pass<32, true, VAR, true>(Kp, Vg, Qp, sl2, smax2, qb, jstart, smem, O1, l0);
        else attn_pass<32, true, VAR, false>(Kp, Vg, Qp, sl2, 0.f, qb, jstart, smem, O1, l0);
        const float inv = 1.f / l0;
#pragma unroll
        for (int db = 0; db < 2; ++db)
#pragma unroll
            for (int r = 0; r < 8; ++r) o0p[db * 8 + r] = pack2(O1[db][2 * r] * inv, O1[db][2 * r + 1] * inv);
    }
    {
        const bf* Kp = WSP(bf, OFF_DK) + (size_t)(bh * 2 + 1) * S * 32; const bf* Qp = WSP(bf, OFF_DQ) + ((size_t)(bh * 2 + 1) * S + q) * 32 + 8 * h;
        if (smax2 < 48.f) attn_pass<32, true, VAR, true>(Kp, Vg, Qp, sl2, smax2, qb, jstart, smem, O1, l1);
        else attn_pass<32, true, VAR, false>(Kp, Vg, Qp, sl2, 0.f, qb, jstart, smem, O1, l1);
    }
    const float lam1 = WSP(float, OFF_CTL)[CTL_LAM + l] / l1;
    float ss = 0.f;
#pragma unroll
    for (int db = 0; db < 2; ++db)
#pragma unroll
        for (int r = 0; r < 8; ++r) {
            const float v0 = lo16(o0p[db * 8 + r]) - lam1 * O1[db][2 * r], v1 = hi16(o0p[db * 8 + r]) - lam1 * O1[db][2 * r + 1];
            O1[db][2 * r] = v0; O1[db][2 * r + 1] = v1; ss += v0 * v0 + v1 * v1;
        }
    ss += __shfl_xor(ss, 32);
    const int trow = b * S + qb * 128 + 32 * w;
    attn_store(O1, rsqrtf(ss * (1.f / 64.f) + EPS), smem + ATT_STG + w * (32 * 144), WSP(bf, VAR == 0 ? OFF_MIX : OFF_XB) + (size_t)trow * 1024 + 256 + hd * 64);
}

DI int q_next(int* head, int* sU) {
    if (tidx() == 0) *sU = atomicAdd(head, 1);
    __syncthreads();
    const int u = *sU;
    __syncthreads();
    return u;
}
DI void ph_p2(const Params& p, int l, unsigned char* smem) {
    int* head = WSP(int, OFF_CTL) + CTL_Q + 5 * 256 + l * 32;
    int* sU = (int*)(smem + GEMM_SMEM + 16);
    float* sC = (float*)smem; float* sRN0 = (float*)(smem + G_OFF_AUX);
    constexpr int NLRU = 256, UNITS = NLRU + 128 * 12;
    int u = q_next(head, sU);
    while (u < NLRU) { lru_tile_fast(p, l, u >> 6, u & 63, 0, smem); u = q_next(head, sU); }
    if (u >= UNITS) return;
    GREGS;
    RowLoader al, bl;
    { const int m = u - NLRU;
      mla_up_loaders(p, l, m, al, bl);
      if (m % 12 < 6) mla_up_rms<true>(p, (m / 12) * 128, sRN0); else mla_up_rms<false>(p, (m / 12) * 128, sRN0);
      g_prefetch<0>(GREGS_P, al, bl, m % 12 < 6 ? 3 : 2); }
    int par = 0;
    for (;;) {
        const int m = u - NLRU, mt = m / 12, j = m % 12;
        const float* sRN = sRN0 + par * 128;
        f32x16 acc[2][2];
        acc_zero(acc);
        gemm_run<0>(acc, j < 6 ? 3 : 2, al, bl, smem, GREGS_P, NoMid());
        acc_stage132(acc, sC);
        const int un = q_next(head, sU);
        const int mn = (un < UNITS ? un : u) - NLRU;
        mla_up_loaders(p, l, mn, al, bl);
        if (mn % 12 < 6) mla_up_rms<true>(p, (mn / 12) * 128, sRN0 + (par ^ 1) * 128); else mla_up_rms<false>(p, (mn / 12) * 128, sRN0 + (par ^ 1) * 128);
        g_prefetch<0>(GREGS_P, al, bl, mn % 12 < 6 ? 3 : 2);
        if (j < 6) mla_up_epi<true>(p, l, mt, j, sC, sRN, sRN0 + 256); else mla_up_epi<false>(p, l, mt, j - 6, sC, sRN, sRN0 + 256);
        __syncthreads();
        if (un >= UNITS) break;
        u = un; par ^= 1;
    }
}

constexpr int P3_NCONV = 384;
constexpr int P3_QLEN = 192 + 32 + P3_NCONV;
template <int VAR>
DI void ph_p3(const Params& p, int l, int qslot, unsigned char* smem) {
    int* qheads = WSP(int, OFF_CTL) + CTL_Q + qslot * 256;
    int* sU = (int*)(smem + GEMM_SMEM + 16);
    float* sXC = (float*)smem; float* sY = sXC + 16 * 256;
    const int x0 = (int)(xcc_id() & 7u);
    int qi = 0;
    for (;;) {
        const int x = (x0 + qi) & 7;
        if (tidx() == 0) *sU = atomicAdd(qheads + x * 32, 1);
        __syncthreads();
        const int u = *sU;
        __syncthreads();
        if (u >= P3_QLEN) { if (++qi == 8) break; continue; }
        if (u >= 224) {
            if (VAR == 0) {
                const size_t e0 = ((size_t)(x * P3_NCONV + (u - 224))) * 8192 + (size_t)tidx() * 8;
                const int m = (int)(e0 >> 23);
                const float* src = (m == 0 ? p.in[I_W1] : (m == 1 ? p.in[I_W3] : p.in[I_W2])) + (size_t)l * 8388608 + (e0 & 8388607);
                bf* dst = EWPTR(l) + e0;
                float4 v[8];
#pragma unroll
                for (int i = 0; i < 4; ++i) { v[2 * i] = *(const float4*)(src + i * 2048); v[2 * i + 1] = *(const float4*)(src + i * 2048 + 4); }
#pragma unroll
                for (int i = 0; i < 4; ++i) {
                    const float f[8] = {v[2 * i].x, v[2 * i].y, v[2 * i].z, v[2 * i].w, v[2 * i + 1].x, v[2 * i + 1].y, v[2 * i + 1].z, v[2 * i + 1].w};
                    store8(dst + i * 2048, f);
                }
            }
        } else if (u < 96 || u >= 128) {
            const int a = u < 96 ? u : u - 32;
            const int qb = 31 - a / 6, c = a % 6, bh = x + 8 * (c % 3);
            if (c < 3) diff_unit<VAR>(p, l, bh, qb, smem);
            else mla_unit<VAR>(p, l, bh, qb, smem);
        } else {
            const int v = x * 32 + (u - 96);
            if (VAR == 0) lru_tile_fast(p, l, v >> 6, v & 63, 1, smem);
        }
    }
}

DI void ph_mla_up_naive(const Params& p, int l, int bid, int nb, unsigned char* smem) {
    float (*sCQ)[192] = (float (*)[192])smem; float (*sCKV)[128] = (float (*)[128])(smem + 4 * 192 * 4);
    float (*sQ)[576] = (float (*)[576])(smem + 4 * 320 * 4); float (*sKV)[768] = (float (*)[768])(smem + 4 * 896 * 4);
    const int tid = tidx(), lane = tid & 63, wv = tid >> 6;
    for (int u = bid; u < NT / 4; u += nb) {
    const int t0 = u * 4;
    {
        const int t = t0 + wv;
        const bf* cq = WSP(bf, OFF_CQ) + (size_t)t * 192; const bf* ckv = WSP(bf, OFF_CKV) + (size_t)t * 128;
        float a0 = bf2f(cq[lane]), a1 = bf2f(cq[lane + 64]), a2 = bf2f(cq[lane + 128]);
        float ss = wave_sum(a0 * a0 + a1 * a1 + a2 * a2);
        float rn = rsqrtf(ss * (1.f / 192.f) + EPS);
        sCQ[wv][lane] = a0 * rn; sCQ[wv][lane + 64] = a1 * rn; sCQ[wv][lane + 128] = a2 * rn;
        float b0 = bf2f(ckv[lane]), b1 = bf2f(ckv[lane + 64]);
        ss = wave_sum(b0 * b0 + b1 * b1);
        rn = rsqrtf(ss * (1.f / 128.f) + EPS);
        sCKV[wv][lane] = b0 * rn; sCKV[wv][lane + 64] = b1 * rn;
    }
    __syncthreads();
    const bf* WUQ = WSP(bf, OFF_WUQ) + (size_t)l * 768 * 192;
    const bf* WUKV = WSP(bf, OFF_WUKV) + (size_t)l * 768 * 128;
    for (int n = tid; n < 576; n += 256) {
        float acc[4] = {0.f, 0.f, 0.f, 0.f};
        for (int k = 0; k < 192; ++k) { const float w = bf2f(WUQ[(size_t)((n / 96) * 128 + n % 96) * 192 + k]);
#pragma unroll
            for (int q = 0; q < 4; ++q) acc[q] += sCQ[q][k] * w; }
#pragma unroll
        for (int q = 0; q < 4; ++q) sQ[q][n] = acc[q];
    }
    for (int n = tid; n < 768; n += 256) {
        float acc[4] = {0.f, 0.f, 0.f, 0.f};
        for (int k = 0; k < 128; ++k) { const float w = bf2f(WUKV[(size_t)n * 128 + k]);
#pragma unroll
            for (int q = 0; q < 4; ++q) acc[q] += sCKV[q][k] * w; }
#pragma unroll
        for (int q = 0; q < 4; ++q) sKV[q][n] = acc[q];
    }
    __syncthreads();
    if (tid < 48) {
        const int tok = tid / 12, h = (tid % 12) >> 1, which = tid & 1;
        const int t = t0 + tok, b = t >> 12, s = t & 4095;
        const float* rope = WSP(float, OFF_ROPE) + s * 32;
        const float* gain = (which ? p.in[I_MKG] : p.in[I_MQG]) + l * 96;
        const bf* kr = WSP(bf, OFF_KR) + (size_t)t * 32;
        bf* dst = WSP(bf, which ? OFF_MK : OFF_MQ) + ((size_t)(b * 6 + h) * S + s) * 96;
        float ss = 0.f;
        for (int d = 0; d < 96; ++d) {
            const float v = which ? (d < 64 ? sKV[tok][h * 128 + d] : bf2f(kr[d - 64])) : sQ[tok][h * 96 + d];
            ss += v * v;
        }
        const float rn = rsqrtf(ss * (1.f / 96.f) + EPS);
        for (int d = 0; d < 64; ++d) {
            const float v = which ? sKV[tok][h * 128 + d] : sQ[tok][h * 96 + d];
            dst[d] = f2bf(v * rn * gain[d]);
        }
        for (int i = 0; i < 16; ++i) {
            const float x1 = (which ? bf2f(kr[i]) : sQ[tok][h * 96 + 64 + i]) * rn * gain[64 + i];
            const float x2 = (which ? bf2f(kr[16 + i]) : sQ[tok][h * 96 + 80 + i]) * rn * gain[80 + i];
            const float cs = rope[i], sn = rope[16 + i];
            dst[64 + i] = f2bf(x1 * cs - x2 * sn);
            dst[80 + i] = f2bf(x1 * sn + x2 * cs);
        }
    }
    bf* mvt = WSP(bf, OFF_MVT);
    for (int e = tid; e < 4 * 384; e += 256) {
        const int tok = e / 384, r = e % 384, h = r >> 6, d = r & 63;
        const int t = t0 + tok, b = t >> 12, s = t & 4095;
        mvt[((size_t)(b * 6 + h) * 64 + d) * S + s] = f2bf(sKV[tok][h * 128 + 64 + d]);
    }
    __syncthreads();
    }
}

DI float rdlane(float v, int j) { return __int_as_float(__builtin_amdgcn_readlane(__float_as_int(v), j)); }

DI void ph_diff_attn_naive(const Params& p, int l, int bid, int nb) {
    for (int u = bid; u < NB * 6 * S / 4; u += nb) {
    const int lane = tidx() & 63, gw = u * 4 + (tidx() >> 6);
    const int q = gw & 4095, bh = gw >> 12, h = bh % 6, b = bh / 6;
    const bf* DQ = WSP(bf, OFF_DQ); const bf* DK = WSP(bf, OFF_DK); const bf* DVT = WSP(bf, OFF_DVT);
    float lam;
    {
        float d1 = 0.f, d2 = 0.f;
        for (int i = 0; i < 32; ++i) { d1 += p.in[I_LQ1][l * 32 + i] * p.in[I_LK1][l * 32 + i]; d2 += p.in[I_LQ2][l * 32 + i] * p.in[I_LK2][l * 32 + i]; }
        lam = expf(d1) - expf(d2) + lambda_init(l);
    }
    const float slope = exp2f(-8.f * (float)(h + 1) / 6.f);
    const float scale = 0.17677669529663687f;
    float q0[32], q1[32];
    {
        const bf* a = DQ + ((size_t)(bh * 2 + 0) * S + q) * 32; const bf* c = DQ + ((size_t)(bh * 2 + 1) * S + q) * 32;
#pragma unroll
        for (int d = 0; d < 32; ++d) { q0[d] = bf2f(a[d]); q1[d] = bf2f(c[d]); }
    }
    float m0 = -INFINITY, m1 = -INFINITY, l0 = 0.f, l1 = 0.f, o0 = 0.f, o1 = 0.f;
    const int nkb = (q >> 6) + 1;
    for (int kb = 0; kb < nkb; ++kb) {
        const int k = kb * 64 + lane;
        const uint4* ka = (const uint4*)(DK + ((size_t)(bh * 2 + 0) * S + k) * 32);
        const uint4* kc = (const uint4*)(DK + ((size_t)(bh * 2 + 1) * S + k) * 32);
        float s0 = 0.f, s1 = 0.f;
#pragma unroll
        for (int i = 0; i < 4; ++i) {
            const uint4 u = ka[i], w = kc[i];
            const unsigned uu[4] = {u.x, u.y, u.z, u.w}, ww[4] = {w.x, w.y, w.z, w.w};
#pragma unroll
            for (int e = 0; e < 4; ++e) {
                s0 += q0[i * 8 + e * 2] * lo16(uu[e]) + q0[i * 8 + e * 2 + 1] * hi16(uu[e]);
                s1 += q1[i * 8 + e * 2] * lo16(ww[e]) + q1[i * 8 + e * 2 + 1] * hi16(ww[e]);
            }
        }
        const float bias = -slope * fabsf((float)(q - k));
        s0 = s0 * scale + bias; s1 = s1 * scale + bias;
        const float n0 = fmaxf(m0, wave_max(s0)), n1 = fmaxf(m1, wave_max(s1));
        const float a0 = __expf(m0 - n0), a1 = __expf(m1 - n1);
        const float p0 = __expf(s0 - n0), p1 = __expf(s1 - n1);
        l0 = l0 * a0 + p0; l1 = l1 * a1 + p1; o0 *= a0; o1 *= a1; m0 = n0; m1 = n1;
        const uint4* vp = (const uint4*)(DVT + ((size_t)bh * 64 + lane) * S + kb * 64);
        uint4 v[8];
#pragma unroll
        for (int i = 0; i < 8; ++i) v[i] = vp[i];
#pragma unroll
        for (int i = 0; i < 8; ++i) {
            const unsigned vv[4] = {v[i].x, v[i].y, v[i].z, v[i].w};
#pragma unroll
            for (int e = 0; e < 4; ++e) {
                const int j = i * 8 + e * 2;
                const float va = lo16(vv[e]), vb = hi16(vv[e]);
                o0 += rdlane(p0, j) * va + rdlane(p0, j + 1) * vb;
                o1 += rdlane(p1, j) * va + rdlane(p1, j + 1) * vb;
            }
        }
    }
    const float L0 = wave_sum(l0), L1 = wave_sum(l1);
    const float o = o0 / L0 - lam * (o1 / L1);
    const float ss = wave_sum(o * o);
    WSP(bf, OFF_MIX)[(size_t)(b * S + q) * 1024 + 256 + h * 64 + lane] = f2bf(o * rsqrtf(ss * (1.f / 64.f) + EPS));
    }
}

DI void ph_mla_attn_naive(const Params& p, int l, int bid, int nb) {
    for (int u = bid; u < NB * 6 * S / 4; u += nb) {
    const int lane = tidx() & 63, gw = u * 4 + (tidx() >> 6);
    const int q = gw & 4095, bh = gw >> 12, h = bh % 6, b = bh / 6;
    const bf* MQ = WSP(bf, OFF_MQ); const bf* MK = WSP(bf, OFF_MK); const bf* MVT = WSP(bf, OFF_MVT);
    const float scale = 0.10206207261596575f;
    float qv[96];
    {
        const bf* a = MQ + ((size_t)bh * S + q) * 96;
#pragma unroll
        for (int d = 0; d < 96; ++d) qv[d] = bf2f(a[d]);
    }
    float m0 = -INFINITY, l0 = 0.f, o0 = 0.f;
    const int nkb = (q >> 6) + 1;
    for (int kb = 0; kb < nkb; ++kb) {
        const int k = kb * 64 + lane;
        const uint4* ka = (const uint4*)(MK + ((size_t)bh * S + k) * 96);
        float s0 = 0.f;
#pragma unroll
        for (int i = 0; i < 12; ++i) {
            const uint4 u = ka[i];
            const unsigned uu[4] = {u.x, u.y, u.z, u.w};
#pragma unroll
            for (int e = 0; e < 4; ++e) s0 += qv[i * 8 + e * 2] * lo16(uu[e]) + qv[i * 8 + e * 2 + 1] * hi16(uu[e]);
        }
        s0 *= scale;
        const float n0 = fmaxf(m0, wave_max(s0));
        const float a0 = __expf(m0 - n0), p0 = __expf(s0 - n0);
        l0 = l0 * a0 + p0; o0 *= a0; m0 = n0;
        const uint4* vp = (const uint4*)(MVT + ((size_t)bh * 64 + lane) * S + kb * 64);
        uint4 v[8];
#pragma unroll
        for (int i = 0; i < 8; ++i) v[i] = vp[i];
#pragma unroll
        for (int i = 0; i < 8; ++i) {
            const unsigned vv[4] = {v[i].x, v[i].y, v[i].z, v[i].w};
#pragma unroll
            for (int e = 0; e < 4; ++e) {
                const int j = i * 8 + e * 2;
                o0 += rdlane(p0, j) * lo16(vv[e]) + rdlane(p0, j + 1) * hi16(vv[e]);
            }
        }
    }
    const float o = o0 / wave_sum(l0);
    const float ss = wave_sum(o * o);
    const int t = b * S + q;
    WSP(bf, OFF_MIX)[(size_t)t * 1024 + 640 + h * 64 + lane] = f2bf(o);
    if (lane == 0) WSP(float, OFF_SSQM)[t * 8 + h] = ss;
    }
}

DI void ph_mla_norm_fix(const Params& p, int bid, int nb) {
    for (int gid = bid * 256 + tidx(); gid < NT * 48; gid += nb * 256) {
    const int t = gid / 48, c8 = (gid % 48) * 8;
    const float* sq = WSP(float, OFF_SSQM) + t * 8;
    const float rn = rsqrtf((sq[0] + sq[1] + sq[2] + sq[3] + sq[4] + sq[5]) * (1.f / 384.f) + EPS);
    bf* m = WSP(bf, OFF_MIX) + (size_t)t * 1024 + 640 + c8;
    float v[8];
#pragma unroll
    for (int j = 0; j < 8; ++j) v[j] = bf2f(m[j]) * rn;
    store8(m, v);
    }
}

DI void ph_p4_gemm_naive(const Params& p, int l, int bid, int nb, unsigned char* smem) {
    float* sA = (float*)smem; float* sB = sA + 16 * 68;
    if (bid == 0 && tidx() < 32) WSP(int, OFF_CTL)[CTL_CNT + tidx()] = 0;
    for (int u = bid; u < 4096; u += nb) {
    const int mt = u / 16, nt = u % 16;
    const bf* A = WSP(bf, OFF_MIX) + (size_t)mt * 64 * D;
    const bf* Bt = WSP(bf, OFF_WOUT) + (size_t)l * 1024 * 1024 + (size_t)(nt * 64) * 1024;
    const float* xin = (l == 0 ? p.in[I_X] : WSP(float, OFF_XFA)) + (size_t)mt * 64 * D + nt * 64;
    float* x1 = p.out + (size_t)mt * 64 * D + nt * 64;
    bf* xb1 = WSP(bf, OFF_XB) + (size_t)mt * 64 * D + nt * 64;
    const float* g2 = p.in[I_N2G] + l * 1024 + nt * 64;
    ngemm_tile<true>(1024, [=](int r, int k) { return bf2f(A[(size_t)r * D + k]); }, [=](int k, int c) { return bf2f(Bt[(size_t)c * 1024 + k]); },
               [=](int r, int c, float v) { const float x = xin[(size_t)r * D + c] + v; x1[(size_t)r * D + c] = x; xb1[(size_t)r * D + c] = f2bf(x * g2[c]); }, sA, sB);
    }
}

DI void ph_router(const Params& p, int l, int bid, int nb) {
    const int lane = tidx() & 63, gw = bid * 4 + (tidx() >> 6), nw = nb * 4;
    const float* WR = WSP(float, OFF_WR) + (size_t)l * 36 * 1024;
    int* cnt = WSP(int, OFF_CTL) + CTL_CNT;
    int* list = WSP(int, OFF_LIST);
    float* gatew = WSP(float, OFF_GATEW);
    for (int t = gw; t < NT; t += nw) {
        const float* x = p.out + (size_t)t * D;
        float4 xv[4]; float ss = 0.f;
#pragma unroll
        for (int i = 0; i < 4; ++i) { xv[i] = *(const float4*)(x + lane * 4 + 256 * i); ss += xv[i].x * xv[i].x + xv[i].y * xv[i].y + xv[i].z * xv[i].z + xv[i].w * xv[i].w; }
        ss = wave_sum(ss);
        const float rinv = rsqrtf(ss * (1.f / 1024.f) + EPS);
        float lg[4];
#pragma unroll
        for (int j = 0; j < 4; ++j) {
            float a = 0.f;
#pragma unroll
            for (int i = 0; i < 4; ++i) { const float4 w = *(const float4*)(WR + (size_t)j * 1024 + lane * 4 + 256 * i); a += xv[i].x * w.x + xv[i].y * w.y + xv[i].z * w.z + xv[i].w * w.w; }
            lg[j] = wave_sum(a) * rinv + p.in[I_RGB][l * 4 + j];
        }
        int g = 0; float gm = lg[0];
#pragma unroll
        for (int j = 1; j < 4; ++j) if (lg[j] > gm) { gm = lg[j]; g = j; }
        float gs = 0.f;
#pragma unroll
        for (int j = 0; j < 4; ++j) gs += __expf(lg[j] - gm);
        const float pg_top = 1.f / gs;
        float e[8];
#pragma unroll
        for (int j = 0; j < 8; ++j) {
            const float* wrow = WR + (size_t)(4 + g * 8 + j) * 1024;
            float a = 0.f;
#pragma unroll
            for (int i = 0; i < 4; ++i) { const float4 w = *(const float4*)(wrow + lane * 4 + 256 * i); a += xv[i].x * w.x + xv[i].y * w.y + xv[i].z * w.z + xv[i].w * w.w; }
            e[j] = wave_sum(a) * rinv + p.in[I_REB][l * 32 + g * 8 + j];
        }
        int i1 = 0; float v1 = e[0];
#pragma unroll
        for (int i = 1; i < 8; ++i) if (e[i] > v1) { v1 = e[i]; i1 = i; }
        int i2 = -1; float v2 = -INFINITY;
#pragma unroll
        for (int i = 0; i < 8; ++i) if (i != i1 && e[i] > v2) { v2 = e[i]; i2 = i; }
        const float p1 = 1.f, p2 = __expf(v2 - v1);
        const float g1 = pg_top * p1 / (p1 + p2), g2 = pg_top * p2 / (p1 + p2);
        if (lane == 0) {
            const int e1 = g * 8 + i1, e2 = g * 8 + i2;
            const int pos1 = atomicAdd(&cnt[e1], 1); list[e1 * 16384 + pos1] = t * 2;
            const int pos2 = atomicAdd(&cnt[e2], 1); list[e2 * 16384 + pos2] = t * 2 + 1;
            gatew[t * 2] = g1; gatew[t * 2 + 1] = g2;
            WSP(float, OFF_RINV2)[t] = rinv;
        }
    }
}

DI void ph_moe_up_naive(const Params& p, int l, int bid, int nb, unsigned char* smem) {
    float* sA = (float*)smem; float* sB = sA + 16 * 68; int* sTok = (int*)(sB + 16 * 68);
    for (int u = bid; u < 32 * 256 * 8; u += nb) {
    const int nt = u & 7, rb = (u >> 3) & 255, e = u >> 11;
    const int* cnt = WSP(int, OFF_CTL) + CTL_CNT;
    const int n = cnt[e];
    if (rb * 64 >= n) continue;
    int base = 0; for (int i = 0; i < e; ++i) base += cnt[i];
    if (tidx() < 64) { const int r = rb * 64 + tidx(); sTok[tidx()] = r < n ? (WSP(int, OFF_LIST)[e * 16384 + r] >> 1) : -1; }
    __syncthreads();
    const bf* XB = WSP(bf, OFF_XB);
    const float* W = (nt < 4 ? p.in[I_W1] : p.in[I_W3]) + (size_t)(l * 32 + e) * 1024 * 256 + (nt & 3) * 64;
    const float* rinv2 = WSP(float, OFF_RINV2);
    float* H = WSP(float, OFF_H13) + (size_t)(base + rb * 64) * 512 + nt * 64;
    const int* tk = sTok;
    ngemm_tile<false>(1024, [=](int r, int k) { const int t = tk[r]; return t >= 0 ? bf2f(XB[(size_t)t * D + k]) : 0.f; }, [=](int k, int c) { return bf2f(f2bf(W[(size_t)k * 256 + c])); },
               [=](int r, int c, float v) { const int t = tk[r]; if (t >= 0) H[(size_t)r * 512 + c] = v * rinv2[t]; }, sA, sB);
    }
}

DI void ph_moe_act_naive(const Params& p, int bid, int nb) {
    for (int gid = bid * 256 + tidx(); gid < 32768 * 32; gid += nb * 256) {
    const int row = gid >> 5, c8 = (gid & 31) * 8;
    const float* H = WSP(float, OFF_H13) + (size_t)row * 512;
    float v[8];
#pragma unroll
    for (int j = 0; j < 8; ++j) { const float a = H[c8 + j], b = H[256 + c8 + j]; v[j] = a * sigmoidf_(a) * b; }
    store8(WSP(bf, OFF_ACT) + (size_t)row * 256 + c8, v);
    }
}

DI void ph_moe_down_naive(const Params& p, int l, int bid, int nb, unsigned char* smem) {
    float* sA = (float*)smem; float* sB = sA + 16 * 68; int* sEnt = (int*)(sB + 16 * 68);
    for (int u = bid; u < 32 * 256 * 16; u += nb) {
    const int nt = u & 15, rb = (u >> 4) & 255, e = u >> 12;
    const int* cnt = WSP(int, OFF_CTL) + CTL_CNT;
    const int n = cnt[e];
    if (rb * 64 >= n) continue;
    int base = 0; for (int i = 0; i < e; ++i) base += cnt[i];
    if (tidx() < 64) { const int r = rb * 64 + tidx(); sEnt[tidx()] = r < n ? WSP(int, OFF_LIST)[e * 16384 + r] : -1; }
    __syncthreads();
    const bf* A = WSP(bf, OFF_ACT) + (size_t)(base + rb * 64) * 256;
    const float* W = p.in[I_W2] + (size_t)(l * 32 + e) * 256 * 1024 + nt * 64;
    const float* gatew = WSP(float, OFF_GATEW);
    bf* Y = WSP(bf, OFF_Y);
    const int* en = sEnt;
    ngemm_tile<false>(256, [=](int r, int k) { return en[r] >= 0 ? bf2f(A[(size_t)r * 256 + k]) : 0.f; }, [=](int k, int c) { return bf2f(f2bf(W[(size_t)k * 1024 + c])); },
               [=](int r, int c, float v) { const int en_ = en[r]; if (en_ >= 0) Y[((size_t)(en_ & 1) * NT + (en_ >> 1)) * D + nt * 64 + c] = f2bf(v * gatew[en_]); }, sA, sB);
    }
}

DI void ph_combine(const Params& p, int last, int bid, int nb) {
    const int lane = tidx() & 63, gw = bid * 4 + (tidx() >> 6), nw = nb * 4;
    const bf* Y = WSP(bf, OFF_Y);
    float* xo = last ? p.out : WSP(float, OFF_XFA);
    const float* x1p = last ? WSP(float, OFF_XFA) : p.out;
    bf* xb = WSP(bf, OFF_XB);
    for (int t = gw; t < NT; t += nw) {
        float ss = 0.f;
#pragma unroll
        for (int i = 0; i < 2; ++i) {
            const int c = (lane + 64 * i) * 8;
            const float4 a = *(const float4*)(x1p + (size_t)t * D + c), b = *(const float4*)(x1p + (size_t)t * D + c + 4);
            const uint4 y0 = *(const uint4*)(Y + (size_t)t * D + c), y1 = *(const uint4*)(Y + ((size_t)NT + t) * D + c);
            float v[8] = {a.x, a.y, a.z, a.w, b.x, b.y, b.z, b.w};
            const unsigned u0[4] = {y0.x, y0.y, y0.z, y0.w}, u1[4] = {y1.x, y1.y, y1.z, y1.w};
#pragma unroll
            for (int e = 0; e < 4; ++e) { v[2 * e] += lo16(u0[e]) + lo16(u1[e]); v[2 * e + 1] += hi16(u0[e]) + hi16(u1[e]); }
#pragma unroll
            for (int j = 0; j < 8; ++j) ss += v[j] * v[j];
            *(float4*)(xo + (size_t)t * D + c) = make_float4(v[0], v[1], v[2], v[3]);
            *(float4*)(xo + (size_t)t * D + c + 4) = make_float4(v[4], v[5], v[6], v[7]);
            if (!last) store8(xb + (size_t)t * D + c, v);
        }
        ss = wave_sum(ss);
        if (!last && lane == 0) WSP(float, OFF_RINV1)[t] = rsqrtf(ss * (1.f / 1024.f) + EPS);
    }
}


#define XB_TMO      128
#define XB_XCNT(j)  (256  + 64 * (j))
#define XB_XSUB(j)  (1280 + 64 * (j))
#define XB_XGEN(j)  (2304 + 64 * (j))
#define XB_TOP      3328
#define XB_TOPGEN   3392
#define XCD_BAR_WORDS 3456
#define XB_SPIN_CAP (1u << 22)
#define LAS __attribute__((address_space(3)))
constexpr size_t OFF_BAR = OFF_CTL + 16384;
static_assert(16384 + XCD_BAR_WORDS * 4 <= 65536, "ctl region");

DI unsigned xb_ld(unsigned* p) { return __hip_atomic_load(p, __ATOMIC_RELAXED, __HIP_MEMORY_SCOPE_AGENT); }
DI unsigned xb_add(unsigned* p, unsigned v) { return __hip_atomic_fetch_add(p, v, __ATOMIC_RELAXED, __HIP_MEMORY_SCOPE_AGENT); }
DI unsigned xb_xcc_id() { return (unsigned)__builtin_amdgcn_s_getreg((3 << 11) | 20) & 0xFu; }
#define XB_SPIN(cond, bar) do { unsigned _sp = 0; while (cond) { __builtin_amdgcn_s_sleep(1); \
    if ((++_sp & 255u) == 0u) { if (xb_ld(&(bar)[XB_TMO])) break; if (_sp > XB_SPIN_CAP) { atomicAdd(&(bar)[XB_TMO], 1u); break; } } } } while (0)

struct XcdBarrier { unsigned* bar; unsigned x; volatile LAS unsigned* st; };

DI XcdBarrier xcd_barrier_post(unsigned* bar, volatile LAS unsigned* st) {
    XcdBarrier b; b.bar = bar; b.x = xb_xcc_id(); b.st = st;
    if (tidx() == 0) (void)xb_add(&bar[XB_XCNT(b.x)], 1u);
    return b;
}
DI void xcd_barrier_complete(unsigned* bar, unsigned x, unsigned& nloc, unsigned& nx) {
    const unsigned G = gridDim.x * gridDim.y * gridDim.z;
    unsigned sum, cnt, mine, sp = 0u;
    for (;;) {
        sum = 0u; cnt = 0u; mine = 0u;
#pragma unroll
        for (unsigned j = 0; j < 16; ++j) { const unsigned c = xb_ld(&bar[XB_XCNT(j)]); sum += c; cnt += (c > 0u) ? 1u : 0u; mine = (j == x) ? c : mine; }
        if (sum == G) break;
        __builtin_amdgcn_s_sleep(1);
        if ((++sp & 255u) == 0u) { if (xb_ld(&bar[XB_TMO])) break; if (sp > XB_SPIN_CAP) { atomicAdd(&bar[XB_TMO], 1u); break; } }
    }
    nloc = mine > 0u ? mine : 1u; nx = cnt > 0u ? cnt : 1u;
}
DI void xcd_barrier(const XcdBarrier& b) {
    asm volatile("s_waitcnt vmcnt(0)" ::: "memory");
    __syncthreads();
    if (tidx() == 0) {
        unsigned zoff = 0; asm volatile("" : "+s"(zoff));
        unsigned* bar = b.bar + zoff;
        const unsigned bx = b.x + zoff;
        __builtin_amdgcn_s_waitcnt(0);
        unsigned nloc = b.st[0], nx = b.st[1];
        if (nloc == 0u) { xcd_barrier_complete(bar, bx, nloc, nx); b.st[0] = nloc; b.st[1] = nx; }
        const unsigned old = xb_add(&bar[XB_XSUB(bx)], 1u);
        const unsigned gen = old / nloc;
        if (old + 1u == (gen + 1u) * nloc) {
            __builtin_amdgcn_fence(__ATOMIC_RELEASE, "agent");
            asm volatile("s_waitcnt vmcnt(0)" ::: "memory");
            const unsigned og = xb_add(&bar[XB_TOP], 1u);
            const unsigned tg = og / nx;
            if (og + 1u == (tg + 1u) * nx) xb_add(&bar[XB_TOPGEN], 1u);
            else XB_SPIN(xb_ld(&bar[XB_TOPGEN]) == tg, bar);
            __builtin_amdgcn_fence(__ATOMIC_ACQUIRE, "agent");
            xb_add(&bar[XB_XGEN(bx)], 1u);
            asm volatile("s_waitcnt vmcnt(0)" ::: "memory");
        } else {
            XB_SPIN(xb_ld(&bar[XB_XGEN(bx)]) == gen, bar);
            __builtin_amdgcn_fence(__ATOMIC_ACQUIRE, "agent");
            asm volatile("s_waitcnt vmcnt(0)" ::: "memory");
        }
    }
    __syncthreads();
}

#define USE_CG_SYNC 0
#ifndef PROBE
#define PROBE 0
#endif
#define FAST_P1 1
#define FAST_ATTN 1
#define FAST_P4 1
#define FAST_MOE 1
#define FAST_MLAUP 1
static_assert(GEMM_SMEM + 32 == 76832, "tp_smem offset");
constexpr int SMEM_BYTES = GEMM_SMEM + 64;
#if USE_CG_SYNC
#define GRID_SYNC() grid.sync()
#else
#define GRID_SYNC() do { TSTART(5); xcd_barrier(xbar); TSTOP(5); } while (0)
#define GRID_SYNCN(k) do { TSTART(5); TSTART(20 + (k)); xcd_barrier(xbar); TSTOP(20 + (k)); TSTOP(5); } while (0)
#endif

__global__ void __launch_bounds__(256, 2) mega_fwd(Params p) {
    extern __shared__ __attribute__((aligned(16))) unsigned char smem[];
#if USE_CG_SYNC
    cg::grid_group grid = cg::this_grid();
#else
    if (tidx() < 16) ((unsigned*)(smem + GEMM_SMEM))[tidx()] = 0u;
    __syncthreads();
    XcdBarrier xbar = xcd_barrier_post((unsigned*)(p.ws + OFF_BAR), (volatile LAS unsigned*)(smem + GEMM_SMEM));
#endif
    const int bid = blockIdx.x, nb = gridDim.x;
        TSTART(39);
    ph_prep_weights(p, bid, nb, smem);
    ph_prep_misc(p, bid, nb);
    ph_prep_x(p, bid, nb);
    GRID_SYNCN(0);
        TSTOP(39);
#if PROBE == 9
    for (int i = 0; i < 20; ++i) GRID_SYNC();
#endif
#if PROBE == 8
    ph_prep_weights(p, bid, nb, smem); ph_prep_misc(p, bid, nb); ph_prep_x(p, bid, nb); GRID_SYNC();
#endif
    for (int l = 0; l < 2; ++l) {
        TSTART(31);
        ph_p1<0>(p, l, bid, nb, smem);
        GRID_SYNCN(1);
        TSTOP(31);
#if PROBE == 1
        ph_p1<0>(p, l, bid, nb, smem); GRID_SYNC();
#endif
#if PROBE >= 12 && PROBE <= 16
        ph_p1<PROBE>(p, l, bid, nb, smem); GRID_SYNC();
#endif
        TSTART(32);
        ph_p2(p, l, smem);
        GRID_SYNCN(2);
        TSTOP(32);
        TSTART(33);
        ph_p3<0>(p, l, l, smem);
        GRID_SYNCN(3);
        TSTOP(33);
#if PROBE >= 30 && PROBE < 40
        ph_p3<PROBE - 30>(p, l, 2 + l, smem); GRID_SYNC();
#endif
        TSTART(34);
        ph_p4(p, l, bid, nb, smem);
        GRID_SYNCN(4);
        TSTOP(34);
#if PROBE == 4
        ph_p4(p, l, bid, nb, smem); GRID_SYNC();
#endif
        TSTART(35);
        ph_router_fast(p, l, bid, nb, smem);
        GRID_SYNCN(5);
        TSTOP(35);
#if PROBE == 5
        if (bid == 0 && tidx() < 32) WSP(int, OFF_CTL)[CTL_CNT + tidx() * 32] = 0;
        GRID_SYNC();
        ph_router_fast(p, l, bid, nb, smem); GRID_SYNC();
#endif
        TSTART(36);
        ph_moe_up(p, l, bid, nb, smem);
        GRID_SYNCN(6);
        TSTOP(36);
        TSTART(37);
        ph_moe_down(p, l, bid, nb, smem);
        GRID_SYNCN(7);
        TSTOP(37);
#if PROBE == 6
        ph_moe_up(p, l, bid, nb, smem); GRID_SYNC(); ph_moe_down(p, l, bid, nb, smem); GRID_SYNC();
#endif
#if PROBE == 61
        ph_moe_up(p, l, bid, nb, smem); GRID_SYNC();
#endif
#if PROBE == 62
        ph_moe_down(p, l, bid, nb, smem); GRID_SYNC();
#endif
        TSTART(38);
        ph_combine(p, l == 1, bid, nb);
        if (l == 0) GRID_SYNCN(8);
        TSTOP(38);
#if PROBE == 7
        if (l == 0) { ph_combine(p, 0, bid, nb); GRID_SYNC(); }
#endif
    }
#if TPROBE
    if (blockIdx.x == TBLK && threadIdx.x == 0) {
        const unsigned long long dt = *(volatile unsigned long long*)tp_smem * TAMP, t0 = __builtin_amdgcn_s_memrealtime();
        while (__builtin_amdgcn_s_memrealtime() - t0 < dt) __builtin_amdgcn_s_sleep(8);
    }
#endif
}

extern "C" void kernel_launch(void* const* d_in, const int* in_sizes, int n_in, void* d_out, int out_size, void* d_ws, size_t ws_size, hipStream_t stream) {
    if (n_in != N_IN || ws_size < WS_TOTAL || out_size != NT * D) { fprintf(stderr, "kernel_launch: bad sizes n_in %d ws %zu (need %zu) out %d\n", n_in, ws_size, (size_t)WS_TOTAL, out_size); return; }
    static int grid_blocks = 0;
    if (!grid_blocks) {
        int dev = 0, cus = 0, per_cu = 0;
        (void)hipGetDevice(&dev);
        (void)hipDeviceGetAttribute(&cus, hipDeviceAttributeMultiprocessorCount, dev);
        (void)hipFuncSetAttribute((const void*)mega_fwd, hipFuncAttributeMaxDynamicSharedMemorySize, SMEM_BYTES);
        (void)hipOccupancyMaxActiveBlocksPerMultiprocessor(&per_cu, (const void*)mega_fwd, 256, SMEM_BYTES);
        if (per_cu < 1) { fprintf(stderr, "kernel_launch: occupancy query says %d blocks per CU\n", per_cu); return; }
        if (per_cu > 2) per_cu = 2;
        grid_blocks = cus * per_cu;
    }
    Params p{};
    for (int i = 0; i < N_IN; ++i) p.in[i] = (const float*)d_in[i];
    p.out = (float*)d_out; p.ws = (unsigned char*)d_ws;
    (void)hipMemsetAsync((unsigned char*)d_ws + OFF_CTL, 0, 65536, stream);
    void* args[] = {&p};
    hipError_t e = hipLaunchCooperativeKernel((const void*)mega_fwd, dim3(grid_blocks), dim3(256), args, SMEM_BYTES, stream);
    if (e != hipSuccess) fprintf(stderr, "cooperative launch failed: %s (grid %d)\n", hipGetErrorString(e), grid_blocks);
}
```
